# Optimizing an MI355X kernel written in HIP

```python
import math
import jax, jax.numpy as jnp
from jax import lax
import numpy as np

D_MODEL = 1024
BATCH = 8
SEQ = 2048
DEPTH = 4
DEC_BATCH = 128
DEC_SEQ = 8
PAST_LEN = 16384
PAGE_SIZE = 128

N_MIXERS = 2
N_HGRN = (DEPTH + 1) // 2
N_RWKV = DEPTH // 2
MIX_W = D_MODEL
HG_HEADS = 8
HG_DK = MIX_W // HG_HEADS
HG_DV = MIX_W // HG_HEADS
HG_CHUNK = 64
RW_N = 64
RW_HEADS = MIX_W // RW_N
RW_DECAY_LORA = 64
RW_ICL_LORA = 64
RW_VRES_LORA = 32
RW_LNX_EPS = 64e-5
MEM_LEN = 256
X_HEADS = 4
X_DH = 128
CROSS_W = X_HEADS * X_DH
BRANCH_W = MIX_W + CROSS_W
IN_COLS = 3 * MIX_W + CROSS_W + BRANCH_W
NORM_EPS = 1e-6
LOG_FLOOR = 1e-30

kernel_name = 'hgrn2_rwkv7_memxattn_decode_step'

F32 = jnp.float32


def rmsnorm(x, g):
    xf = x.astype(F32)
    xf = xf * lax.rsqrt(jnp.mean(xf * xf, axis=-1, keepdims=True) + NORM_EPS)
    return (xf * g.astype(F32)).astype(x.dtype)


def memory_kv(mem, g, w):
    kv = rmsnorm(mem, g) @ w
    k, v = jnp.split(kv, 2, axis=-1)
    B, M = mem.shape[0], mem.shape[1]
    return k.reshape(B, M, X_HEADS, X_DH), v.reshape(B, M, X_HEADS, X_DH)


def cross_attend(q, mk, mv):
    B, T = q.shape[0], q.shape[1]
    q = q.reshape(B, T, X_HEADS, X_DH)
    s = jnp.einsum('bthd,bmhd->bhtm', q, mk.astype(q.dtype)).astype(F32) * (X_DH ** -0.5)
    p = jax.nn.softmax(s, axis=-1).astype(q.dtype)
    o = jnp.einsum('bhtm,bmhd->bthd', p, mv.astype(q.dtype))
    return o.reshape(B, T, CROSS_W)


def hgrn2_scan(q, k, v, logf, s0):
    B, T, H, DK = q.shape
    C = math.gcd(T, HG_CHUNK)
    n = T // C

    def to_chunks(a):
        return a.reshape(B, n, C, H, a.shape[-1]).transpose(1, 0, 3, 2, 4)

    causal = jnp.tril(jnp.ones((C, C), dtype=bool))[:, :, None]

    def step(S, inp):
        qc, kc, vc, gc = inp
        b = jnp.cumsum(gc, axis=2)
        diff = b[:, :, :, None, :] - b[:, :, None, :, :]
        decay = jnp.where(causal, jnp.exp(jnp.where(causal, diff, 0.0)), 0.0)
        att = jnp.einsum('bhtsd,bhsd->bhts', qc[:, :, :, None, :] * decay, kc)
        o = jnp.einsum('bhts,bhse->bhte', att, vc) + jnp.einsum('bhtd,bhde->bhte', qc * jnp.exp(b), S)
        b_last = b[:, :, -1:, :]
        S = jnp.exp(b_last[:, :, 0, :])[..., None] * S + jnp.einsum('bhsd,bhse->bhde', kc * jnp.exp(b_last - b), vc)
        return S, o

    S, o = lax.scan(step, s0, (to_chunks(q), to_chunks(k), to_chunks(v), to_chunks(logf)))
    o = o.transpose(1, 0, 3, 2, 4).reshape(B, T, H, v.shape[-1])
    return o, S


def hgrn2_mixer(h, w_in_l, lb, onorm_g, s0):
    B, T, _ = h.shape
    proj = h @ w_in_l
    qz = proj[..., :MIX_W].astype(F32)
    fz = proj[..., MIX_W:2 * MIX_W].astype(F32)
    iv = proj[..., 2 * MIX_W:3 * MIX_W].astype(F32)
    rest = proj[..., 3 * MIX_W:]
    q = jax.nn.silu(qz)
    f = lb + (1.0 - lb) * jax.nn.sigmoid(fz)
    logf = jnp.log(jnp.maximum(f, LOG_FLOOR))
    k = (1.0 - lb) * jax.nn.sigmoid(-fz)
    hd = lambda t: t.reshape(B, T, HG_HEADS, -1)
    o, S = hgrn2_scan(hd(q), hd(k), hd(iv), hd(logf), s0.astype(F32))
    o = rmsnorm(o, onorm_g)
    return o.reshape(B, T, MIX_W).astype(h.dtype), rest, S.astype(s0.dtype)


def rwkv7_scan(r, w, k, v, a, b, s0):
    def step(S, inp):
        r_t, w_t, k_t, v_t, a_t, b_t = inp
        sa = jnp.einsum('bhij,bhj->bhi', S, a_t)
        S = S * w_t[:, :, None, :] + sa[..., None] * b_t[:, :, None, :] + v_t[..., None] * k_t[:, :, None, :]
        y = jnp.einsum('bhij,bhj->bhi', S, r_t)
        return S, y

    tm = lambda t: t.transpose(1, 0, 2, 3)
    S, y = lax.scan(step, s0, (tm(r), tm(w), tm(k), tm(v), tm(a), tm(b)))
    return tm(y), S


def rwkv7_mixer(h, prev, w_in_l, j, p, v_first, s0):
    B, T, D = h.shape
    h_prev = jnp.concatenate([prev[:, None, :].astype(h.dtype), h[:, :-1]], axis=1)
    dx = h_prev - h
    mu = p['rw_mu'][j].astype(h.dtype)
    xr = h + dx * mu[0]
    xw = h + dx * mu[1]
    xk = h + dx * mu[2]
    xv = h + dx * mu[3]
    xa = h + dx * mu[4]
    r = (xr @ w_in_l[:, :MIX_W]).astype(F32)
    k = (xk @ w_in_l[:, MIX_W:2 * MIX_W]).astype(F32)
    v = (xv @ w_in_l[:, 2 * MIX_W:3 * MIX_W]).astype(F32)
    rest = h @ w_in_l[:, 3 * MIX_W:]
    w = -jax.nn.softplus(-(p['rw_w0'][j] + jnp.tanh(xw @ p['rw_w1'][j]) @ p['rw_w2'][j]).astype(F32)) - 0.5
    decay = jnp.exp(-jnp.exp(w))
    if v_first is None:
        v_first = v
    else:
        m = j - 1
        v = v + (v_first - v) * jax.nn.sigmoid((p['rw_v0'][m] + (xv @ p['rw_v1'][m]) @ p['rw_v2'][m]).astype(F32))
    a = jax.nn.sigmoid((p['rw_a0'][j] + (xa @ p['rw_a1'][j]) @ p['rw_a2'][j]).astype(F32))
    hd = lambda t: t.reshape(B, T, RW_HEADS, RW_N)
    kk = hd(k * p['rw_kk'][j].astype(F32))
    kk = kk / jnp.maximum(jnp.sqrt(jnp.sum(kk * kk, axis=-1, keepdims=True)), 1e-12)
    k = k * (1.0 + (a - 1.0) * p['rw_ka'][j].astype(F32))
    rh, kh, vh = hd(r), hd(k), hd(v)
    y, S = rwkv7_scan(rh, hd(decay), kh, vh, -kk, kk * hd(a), s0.astype(F32))
    mean = jnp.mean(y, axis=-1, keepdims=True)
    var = jnp.mean(jnp.square(y - mean), axis=-1, keepdims=True)
    y = ((y - mean) * lax.rsqrt(var + RW_LNX_EPS)).reshape(B, T, D)
    y = y * p['rw_lnx_g'][j].astype(F32) + p['rw_lnx_b'][j].astype(F32)
    bonus = jnp.sum(rh * kh * p['rw_rk'][j].astype(F32), axis=-1, keepdims=True) * vh
    y = y + bonus.reshape(B, T, D)
    return y.astype(h.dtype), rest, S.astype(s0.dtype), h[:, -1], v_first


def trunk(x, mem_k, mem_v, s_hgrn, s_rwkv, s_shift, p):
    lbs = jax.nn.softmax(p['hg_lb'].astype(F32), axis=0)
    lbs = jnp.cumsum(lbs, axis=0) - lbs[0]
    new_h, new_r, new_s = [], [], []
    v_first = None
    for i in range(DEPTH):
        h = rmsnorm(x, p['norm_g'][i])
        j = i // N_MIXERS
        if i % N_MIXERS == 0:
            mix, rest, S = hgrn2_mixer(h, p['w_in'][i], lbs[j], p['hg_onorm_g'][j], s_hgrn[j])
            new_h.append(S)
        else:
            mix, rest, S, last, v_first = rwkv7_mixer(h, s_shift[j], p['w_in'][i], j, p, v_first, s_rwkv[j])
            new_r.append(S)
            new_s.append(last.astype(s_shift.dtype))
        xq = rest[..., :CROSS_W]
        gate = rest[..., CROSS_W:]
        xo = cross_attend(xq, mem_k[i], mem_v[i])
        branch = jnp.concatenate([mix, xo], axis=-1) * jax.nn.silu(gate)
        x = x + branch @ p['w_out'][i]
    y = rmsnorm(x, p['final_g'])
    return y, jnp.stack(new_h), jnp.stack(new_r), jnp.stack(new_s)


def setup_inputs(seed: int = 0) -> dict:
    key = jax.random.key(seed)
    ks = iter(jax.random.split(key, 40))
    nrm = lambda shape, scale: jax.random.normal(next(ks), shape, F32) * scale
    uni = lambda shape, lo, hi: jax.random.uniform(next(ks), shape, F32, lo, hi)
    return {
        'x_prompt': nrm((BATCH, SEQ, D_MODEL), 1.0),
        'x_sample': nrm((DEC_BATCH, DEC_SEQ, D_MODEL), 1.0),
        'mem_prompt': nrm((BATCH, MEM_LEN, D_MODEL), 1.0),
        'state_hgrn': nrm((N_HGRN, DEC_BATCH, HG_HEADS, HG_DK, HG_DV), 0.5),
        'state_rwkv': nrm((N_RWKV, DEC_BATCH, RW_HEADS, RW_N, RW_N), 0.3),
        'state_shift': nrm((N_RWKV, DEC_BATCH, D_MODEL), 1.0),
        'cache_mem_k': nrm((DEPTH, DEC_BATCH, MEM_LEN, X_HEADS, X_DH), 1.0),
        'cache_mem_v': nrm((DEPTH, DEC_BATCH, MEM_LEN, X_HEADS, X_DH), 1.0),
        'norm_g': 1.0 + nrm((DEPTH, D_MODEL), 0.02),
        'w_in': nrm((DEPTH, D_MODEL, IN_COLS), D_MODEL ** -0.5),
        'w_out': nrm((DEPTH, BRANCH_W, D_MODEL), BRANCH_W ** -0.5),
        'mem_norm_g': 1.0 + nrm((DEPTH, D_MODEL), 0.02),
        'w_mem_kv': nrm((DEPTH, D_MODEL, 2 * CROSS_W), D_MODEL ** -0.5),
        'hg_lb': nrm((N_HGRN, MIX_W), 0.1),
        'hg_onorm_g': 1.0 + nrm((N_HGRN, HG_DV), 0.02),
        'rw_mu': uni((N_RWKV, 5, D_MODEL), 0.0, 1.0),
        'rw_w0': uni((N_RWKV, D_MODEL), -4.0, 0.0),
        'rw_w1': nrm((N_RWKV, D_MODEL, RW_DECAY_LORA), D_MODEL ** -0.5),
        'rw_w2': nrm((N_RWKV, RW_DECAY_LORA, D_MODEL), 0.5 * RW_DECAY_LORA ** -0.5),
        'rw_a0': nrm((N_RWKV, D_MODEL), 0.1),
        'rw_a1': nrm((N_RWKV, D_MODEL, RW_ICL_LORA), D_MODEL ** -0.5),
        'rw_a2': nrm((N_RWKV, RW_ICL_LORA, D_MODEL), 0.5 * RW_ICL_LORA ** -0.5),
        'rw_v0': nrm((N_RWKV - 1, D_MODEL), 0.1),
        'rw_v1': nrm((N_RWKV - 1, D_MODEL, RW_VRES_LORA), D_MODEL ** -0.5),
        'rw_v2': nrm((N_RWKV - 1, RW_VRES_LORA, D_MODEL), 0.5 * RW_VRES_LORA ** -0.5),
        'rw_kk': 0.85 + nrm((N_RWKV, D_MODEL), 0.02),
        'rw_ka': 1.0 + nrm((N_RWKV, D_MODEL), 0.02),
        'rw_rk': nrm((N_RWKV, RW_HEADS, RW_N), 0.1),
        'rw_lnx_g': 1.0 + nrm((N_RWKV, D_MODEL), 0.02),
        'rw_lnx_b': nrm((N_RWKV, D_MODEL), 0.02),
        'final_g': 1.0 + nrm((D_MODEL,), 0.02),
    }


def reference(x_prompt, x_sample, mem_prompt, state_hgrn, state_rwkv, state_shift, cache_mem_k, cache_mem_v,
              norm_g, w_in, w_out, mem_norm_g, w_mem_kv, hg_lb, hg_onorm_g, rw_mu, rw_w0, rw_w1, rw_w2,
              rw_a0, rw_a1, rw_a2, rw_v0, rw_v1, rw_v2, rw_kk, rw_ka, rw_rk, rw_lnx_g, rw_lnx_b, final_g):
    p = dict(norm_g=norm_g, w_in=w_in, w_out=w_out, hg_lb=hg_lb, hg_onorm_g=hg_onorm_g, rw_mu=rw_mu,
             rw_w0=rw_w0, rw_w1=rw_w1, rw_w2=rw_w2, rw_a0=rw_a0, rw_a1=rw_a1, rw_a2=rw_a2,
             rw_v0=rw_v0, rw_v1=rw_v1, rw_v2=rw_v2, rw_kk=rw_kk, rw_ka=rw_ka, rw_rk=rw_rk,
             rw_lnx_g=rw_lnx_g, rw_lnx_b=rw_lnx_b, final_g=final_g)
    mk, mv = [], []
    for i in range(DEPTH):
        k_i, v_i = memory_kv(mem_prompt, mem_norm_g[i], w_mem_kv[i])
        mk.append(k_i)
        mv.append(v_i)
    mem_k_p = jnp.stack(mk)
    mem_v_p = jnp.stack(mv)
    B = x_prompt.shape[0]
    dt = x_prompt.dtype
    z_h = jnp.zeros((N_HGRN, B, HG_HEADS, HG_DK, HG_DV), dt)
    z_r = jnp.zeros((N_RWKV, B, RW_HEADS, RW_N, RW_N), dt)
    z_s = jnp.zeros((N_RWKV, B, D_MODEL), dt)
    y_prompt, sh_p, sr_p, ss_p = trunk(x_prompt, mem_k_p, mem_v_p, z_h, z_r, z_s, p)
    y_sample, sh_s, sr_s, ss_s = trunk(x_sample, cache_mem_k, cache_mem_v, state_hgrn, state_rwkv, state_shift, p)
    return (y_prompt, y_sample, sh_p, sr_p, ss_p, mem_k_p, mem_v_p, sh_s, sr_s, ss_s)
```

```cpp
#include <hip/hip_runtime.h>
#include <hip/hip_cooperative_groups.h>
#include <cstdio>
#include <cstdint>
namespace cg = cooperative_groups;

#ifndef COOP
#define COOP 1
#endif
#ifndef PROBE_SUB
#define PROBE_SUB 0
#endif
#ifndef PROBE_MASK
#define PROBE_MASK 0u
#endif

typedef unsigned short bfr;
typedef short bf16x8 __attribute__((ext_vector_type(8)));
typedef short bf16x4 __attribute__((ext_vector_type(4)));
typedef float f32x4 __attribute__((ext_vector_type(4)));
typedef unsigned u32x2 __attribute__((ext_vector_type(2)));
typedef unsigned u32x4 __attribute__((ext_vector_type(4)));

constexpr int NTOK = 17408, NPR = 16384, DM = 1024, INC = 5120, BRW = 1536;
constexpr int LDS_BYTES = 139264;
constexpr size_t O_YP = 0, O_SHP = 17825792, O_SRP = 19922944, O_SSP = 20971520, O_MK = 20987904, O_MV = 25182208,
                 O_SHS = 29376512, O_SRS = 62930944, O_SSS = 79708160;
constexpr size_t WS_CTRL = 0;
constexpr size_t WS_WTIN = 4096;
constexpr size_t WTIN_L = (size_t)5888 * 1024;
constexpr size_t WS_WTOUT = WS_WTIN + 4 * WTIN_L * 2;
constexpr size_t WS_WTMEM = WS_WTOUT + (size_t)4 * 1024 * 1536 * 2;
constexpr size_t WS_W2T = WS_WTMEM + (size_t)4 * 1024 * 1024 * 2;
constexpr size_t WS_MEMN = WS_W2T + (size_t)2 * 3072 * 256 * 2;
constexpr size_t WS_XRES = WS_MEMN + (size_t)4 * 2048 * 1024 * 2;
constexpr size_t HA_SZ = (size_t)NTOK * 1024;
constexpr size_t WS_HA = WS_XRES + (size_t)NTOK * 1024 * 4;
constexpr size_t WS_PROJ = WS_HA + 6 * HA_SZ * 2;
constexpr size_t WS_ALORA = WS_PROJ + (size_t)NTOK * INC * 2;
constexpr size_t WS_LUP = WS_ALORA + (size_t)NTOK * 256 * 2;
constexpr size_t WS_VFIRST = WS_LUP + (size_t)NTOK * 3072 * 2;
constexpr size_t WS_BRANCH = WS_VFIRST + HA_SZ * 2;
constexpr size_t WS_PART = WS_BRANCH + (size_t)NTOK * BRW * 2;
constexpr size_t WS_END = WS_PART + (size_t)5 * 1024 * 1024 * 4;

struct Params {
  const float* in[31];
  float* out;
  char* ws;
  int ph_lo, ph_hi;
};
enum { I_XP = 0, I_XS, I_MEM, I_SH, I_SR, I_SS, I_CK, I_CV, I_NG, I_WIN, I_WOUT, I_MNG, I_WMEM, I_LB, I_ONG, I_MU, I_W0, I_W1, I_W2,
       I_A0, I_A1, I_A2, I_V0, I_V1, I_V2, I_KK, I_KA, I_RK, I_LG, I_LBI, I_FG };

__device__ __forceinline__ unsigned cvt_pk(float lo, float hi) { unsigned r; asm("v_cvt_pk_bf16_f32 %0, %1, %2" : "=v"(r) : "v"(lo), "v"(hi)); return r; }
__device__ __forceinline__ bfr f2bf(float f) { return (bfr)(cvt_pk(f, 0.f) & 0xffff); }
__device__ __forceinline__ float bf2f(unsigned h) { return __uint_as_float(h << 16); }
__device__ __forceinline__ float bflo(unsigned w) { return __uint_as_float(w << 16); }
__device__ __forceinline__ float bfhi(unsigned w) { return __uint_as_float(w & 0xffff0000u); }
__device__ __forceinline__ float frcp(float x) { return __builtin_amdgcn_rcpf(x); }
__device__ __forceinline__ float sigmoidf_(float x) { return frcp(1.f + __expf(-x)); }
template <int CTRL> __device__ __forceinline__ float dppf(float x) {
  return __builtin_bit_cast(float, __builtin_amdgcn_update_dpp(0, __builtin_bit_cast(int, x), CTRL, 0xf, 0xf, true));
}
__device__ __forceinline__ float wave_sum(float v) {
  v += dppf<0xB1>(v); v += dppf<0x4E>(v); v += dppf<0x141>(v); v += dppf<0x140>(v);
  const int iv = __builtin_bit_cast(int, v);
  float r = __builtin_bit_cast(float, __builtin_amdgcn_readlane(iv, 0));
  r += __builtin_bit_cast(float, __builtin_amdgcn_readlane(iv, 16));
  r += __builtin_bit_cast(float, __builtin_amdgcn_readlane(iv, 32));
  r += __builtin_bit_cast(float, __builtin_amdgcn_readlane(iv, 48));
  return r;
}
__device__ __forceinline__ float bperm(float v, int srclane) { return __builtin_bit_cast(float, __builtin_amdgcn_ds_bpermute(srclane << 2, __builtin_bit_cast(int, v))); }
__device__ __forceinline__ float sum8(float v) {
  v += dppf<0xB1>(v);
  v += dppf<0x4E>(v);
  v += dppf<0x141>(v);
  return v;
}
__device__ __forceinline__ const float* pin(const Params& p, int i) { asm volatile("" : "+s"(i)); return p.in[i]; }
__device__ __forceinline__ const float* xin_row(const Params& p, int g) {
  return g < NPR ? pin(p, I_XP) + (size_t)g * DM : pin(p, I_XS) + (size_t)(g - NPR) * DM;
}

__device__ __forceinline__ int tidx() { int t = threadIdx.x; asm volatile("" : "+v"(t)); return t; }
__device__ __forceinline__ int bidx() { int b = blockIdx.x; asm volatile("" : "+s"(b)); return b; }
__device__ __forceinline__ int wperm(int n) { const int c = n & 31; return (n & ~31) + ((c >> 2) & 1) * 16 + (c >> 3) * 4 + (c & 3); }

__device__ __forceinline__ void transpose_job(const float* __restrict__ src, int Ks, int Ns, bfr* __restrict__ dst, int ldd, int rot) {
  extern __shared__ __attribute__((aligned(16))) char smem[];
  bfr* T = (bfr*)smem;
  const int tid = tidx();
  const int tn = Ns >> 6, ntile = (Ks >> 6) * tn;
  const int G = gridDim.x;
  for (int tile = (bidx() + rot) % G; tile < ntile; tile += G) {
    const int k0 = (tile / tn) << 6, n0 = (tile % tn) << 6;
    const int kl = tid >> 3, nc = (tid & 7) << 3;
    const float* s = src + (size_t)(k0 + kl) * Ns + n0 + nc;
    const float4 a = *(const float4*)s, b = *(const float4*)(s + 4);
    __syncthreads();
    T[(nc + 0) * 72 + kl] = f2bf(a.x); T[(nc + 1) * 72 + kl] = f2bf(a.y); T[(nc + 2) * 72 + kl] = f2bf(a.z); T[(nc + 3) * 72 + kl] = f2bf(a.w);
    T[(nc + 4) * 72 + kl] = f2bf(b.x); T[(nc + 5) * 72 + kl] = f2bf(b.y); T[(nc + 6) * 72 + kl] = f2bf(b.z); T[(nc + 7) * 72 + kl] = f2bf(b.w);
    __syncthreads();
    const int nl = tid >> 3, kc = (tid & 7) << 3;
    const u32x4 v = *(const u32x4*)(T + nl * 72 + kc);
    *(u32x4*)(dst + (size_t)wperm(n0 + nl) * ldd + k0 + kc) = v;
  }
}

__device__ __forceinline__ void prologue(const Params& p) {
  const int tid = tidx(), wid = tid >> 6, lane = tid & 63;
  const int G = gridDim.x;
  char* ws = p.ws;
  int rot = 0;
  for (int l = 0; l < 4; ++l) {
    transpose_job(pin(p, I_WIN) + (size_t)l * DM * INC, DM, INC, (bfr*)(ws + WS_WTIN) + l * WTIN_L, DM, rot); rot = (rot + G - (1280 % G)) % G;
    transpose_job(pin(p, I_WOUT) + (size_t)l * BRW * DM, BRW, DM, (bfr*)(ws + WS_WTOUT) + (size_t)l * DM * BRW, BRW, rot); rot = (rot + G - (384 % G)) % G;
    transpose_job(pin(p, I_WMEM) + (size_t)l * DM * DM, DM, DM, (bfr*)(ws + WS_WTMEM) + (size_t)l * DM * DM, DM, rot); rot = (rot + G - (256 % G)) % G;
  }
  const int gt = bidx() * 512 + tid, nth = G * 512;
  for (int j = 0; j < 2; ++j) {
    bfr* dst = (bfr*)(ws + WS_WTIN) + (size_t)(2 * j + 1) * WTIN_L + (size_t)5120 * 1024;
    const float* w1 = pin(p, I_W1) + (size_t)j * 1024 * 64;
    const float* a1 = pin(p, I_A1) + (size_t)j * 1024 * 64;
    const float* v1 = pin(p, I_V1);
    for (int it = gt; it < 768 * 128; it += nth) {
      const int n = it % 768, kc = it / 768;
      const int seg = n >> 8, c = n & 255;
      float v[8];
#pragma unroll
      for (int e = 0; e < 8; ++e) {
        const int k = kc * 8 + e;
        float x = 0.f;
        if (seg == 0) { if (c < 64) x = w1[k * 64 + c]; }
        else if (seg == 1) { if (c < 64) x = a1[k * 64 + c]; }
        else { if (j == 1 && c < 32) x = v1[k * 32 + c]; }
        v[e] = x;
      }
      u32x4 o; o.x = cvt_pk(v[0], v[1]); o.y = cvt_pk(v[2], v[3]); o.z = cvt_pk(v[4], v[5]); o.w = cvt_pk(v[6], v[7]);
      *(u32x4*)(dst + (size_t)wperm(n) * 1024 + kc * 8) = o;
    }
    bfr* d2 = (bfr*)(ws + WS_W2T) + (size_t)j * 3072 * 256;
    const float* w2 = pin(p, I_W2) + (size_t)j * 64 * 1024;
    const float* a2 = pin(p, I_A2) + (size_t)j * 64 * 1024;
    const float* v2 = pin(p, I_V2);
    for (int it = gt; it < 3072 * 32; it += nth) {
      const int n = it % 3072, kc = it / 3072;
      const int seg = n >> 10, c = n & 1023;
      float v[8];
#pragma unroll
      for (int e = 0; e < 8; ++e) {
        const int k = kc * 8 + e;
        float x = 0.f;
        if (seg == 0) { if (k < 64) x = w2[k * 1024 + c]; }
        else if (seg == 1) { if (k >= 64 && k < 128) x = a2[(k - 64) * 1024 + c]; }
        else { if (j == 1 && k >= 128 && k < 160) x = v2[(k - 128) * 1024 + c]; }
        v[e] = x;
      }
      u32x4 o; o.x = cvt_pk(v[0], v[1]); o.y = cvt_pk(v[2], v[3]); o.z = cvt_pk(v[4], v[5]); o.w = cvt_pk(v[6], v[7]);
      *(u32x4*)(d2 + (size_t)wperm(n) * 256 + kc * 8) = o;
    }
  }
  const int gw = bidx() * 8 + wid, nw = G * 8;
  for (int row = gw; row < 2048 + NTOK; row += nw) {
    const bool ismem = row < 2048;
    const float* src = ismem ? pin(p, I_MEM) + (size_t)row * DM : xin_row(p, row - 2048);
    float4 x[4]; float ss = 0.f;
#pragma unroll
    for (int i = 0; i < 4; ++i) { x[i] = *(const float4*)(src + lane * 4 + i * 256); ss += x[i].x * x[i].x + x[i].y * x[i].y + x[i].z * x[i].z + x[i].w * x[i].w; }
    ss = wave_sum(ss);
    const float rs = rsqrtf(ss * (1.f / 1024.f) + 1e-6f);
    if (ismem) {
      for (int l = 0; l < 4; ++l) {
        bfr* dst = (bfr*)(ws + WS_MEMN) + ((size_t)l * 2048 + row) * DM;
#pragma unroll
        for (int i = 0; i < 4; ++i) {
          const float4 g = *(const float4*)(pin(p, I_MNG) + l * DM + lane * 4 + i * 256);
          u32x2 o; o.x = cvt_pk(x[i].x * rs * g.x, x[i].y * rs * g.y); o.y = cvt_pk(x[i].z * rs * g.z, x[i].w * rs * g.w);
          *(u32x2*)(dst + lane * 4 + i * 256) = o;
        }
      }
    } else {
      float* xr = (float*)(ws + WS_XRES) + (size_t)(row - 2048) * DM;
#pragma unroll
      for (int i = 0; i < 4; ++i) *(float4*)(xr + lane * 4 + i * 256) = x[i];
      bfr* dst = (bfr*)(ws + WS_HA) + (size_t)(row - 2048) * DM;
#pragma unroll
      for (int i = 0; i < 4; ++i) {
        const float4 g = *(const float4*)(pin(p, I_NG) + lane * 4 + i * 256);
        u32x2 o; o.x = cvt_pk(x[i].x * rs * g.x, x[i].y * rs * g.y); o.y = cvt_pk(x[i].z * rs * g.z, x[i].w * rs * g.w);
        *(u32x2*)(dst + lane * 4 + i * 256) = o;
      }
    }
  }
}

__device__ __forceinline__ void load_xrow(const Params& p, const int g, const int lane, float4 (&x)[4]) {
  const float* s = (const float*)(p.ws + WS_XRES) + (size_t)g * DM;
#pragma unroll
  for (int i = 0; i < 4; ++i) x[i] = *(const float4*)(s + lane * 4 + i * 256);
  if (g >= NPR) {
#pragma unroll
    for (int k = 0; k < 5; ++k) {
      const float* q = (const float*)(p.ws + WS_PART) + ((size_t)k * 1024 + (g - NPR)) * DM;
#pragma unroll
      for (int i = 0; i < 4; ++i) { const float4 t = *(const float4*)(q + lane * 4 + i * 256); x[i].x += t.x; x[i].y += t.y; x[i].z += t.z; x[i].w += t.w; }
    }
  }
}
__device__ __forceinline__ void prep_phase(const Params& p, int l) {
  const int tid = tidx(), wid = tid >> 6, lane = tid & 63;
  const bool rw = (l & 1);
  const int j = l >> 1;
  const float* xres = (const float*)(p.ws + WS_XRES);
  bfr* hA = (bfr*)(p.ws + WS_HA);
  const float* ng = pin(p, I_NG) + l * DM;
  const float* mu = pin(p, I_MU) + (size_t)j * 5 * DM;
  const int gw = bidx() * 8 + wid, nw = gridDim.x * 8;
  for (int task = gw; task < NPR / 4 + 128; task += nw) {
    const int g0 = task < NPR / 4 ? task * 4 : NPR + (task - NPR / 4) * 8;
    const int nrows = task < NPR / 4 ? 4 : 8;
    float hp[16];
    if (rw) {
      const bool smp = g0 >= NPR;
      const int t0 = smp ? ((g0 - NPR) & 7) : (g0 & 2047);
      if (t0 == 0) {
        if (smp) {
          const float* s = pin(p, I_SS) + ((size_t)j * 128 + ((g0 - NPR) >> 3)) * DM;
#pragma unroll
          for (int i = 0; i < 4; ++i) { const float4 v = *(const float4*)(s + lane * 4 + i * 256); hp[i * 4] = v.x; hp[i * 4 + 1] = v.y; hp[i * 4 + 2] = v.z; hp[i * 4 + 3] = v.w; }
        } else {
#pragma unroll
          for (int i = 0; i < 16; ++i) hp[i] = 0.f;
        }
      } else {
        float4 x[4]; float ss = 0.f;
        load_xrow(p, g0 - 1, lane, x);
#pragma unroll
        for (int i = 0; i < 4; ++i) ss += x[i].x * x[i].x + x[i].y * x[i].y + x[i].z * x[i].z + x[i].w * x[i].w;
        ss = wave_sum(ss);
        const float rs = rsqrtf(ss * (1.f / 1024.f) + 1e-6f);
#pragma unroll
        for (int i = 0; i < 4; ++i) {
          const float4 g = *(const float4*)(ng + lane * 4 + i * 256);
          hp[i * 4] = x[i].x * rs * g.x; hp[i * 4 + 1] = x[i].y * rs * g.y; hp[i * 4 + 2] = x[i].z * rs * g.z; hp[i * 4 + 3] = x[i].w * rs * g.w;
        }
      }
    }
    for (int r = 0; r < nrows; ++r) {
      const int g = g0 + r;
      float4 x[4]; float ss = 0.f;
      load_xrow(p, g, lane, x);
      if (g >= NPR) {
        float* xw = (float*)(p.ws + WS_XRES) + (size_t)g * DM;
#pragma unroll
        for (int i = 0; i < 4; ++i) *(float4*)(xw + lane * 4 + i * 256) = x[i];
      }
#pragma unroll
      for (int i = 0; i < 4; ++i) ss += x[i].x * x[i].x + x[i].y * x[i].y + x[i].z * x[i].z + x[i].w * x[i].w;
      ss = wave_sum(ss);
      const float rs = rsqrtf(ss * (1.f / 1024.f) + 1e-6f);
      float h[16];
#pragma unroll
      for (int i = 0; i < 4; ++i) {
        const float4 gg = *(const float4*)(ng + lane * 4 + i * 256);
        h[i * 4] = x[i].x * rs * gg.x; h[i * 4 + 1] = x[i].y * rs * gg.y; h[i * 4 + 2] = x[i].z * rs * gg.z; h[i * 4 + 3] = x[i].w * rs * gg.w;
        u32x2 o; o.x = cvt_pk(h[i * 4], h[i * 4 + 1]); o.y = cvt_pk(h[i * 4 + 2], h[i * 4 + 3]);
        *(u32x2*)(hA + (size_t)g * DM + lane * 4 + i * 256) = o;
      }
      if (rw) {
#pragma unroll
        for (int m = 0; m < 5; ++m) {
          bfr* dst = hA + (size_t)(1 + m) * HA_SZ + (size_t)g * DM;
#pragma unroll
          for (int i = 0; i < 4; ++i) {
            const float4 mm = *(const float4*)(mu + m * DM + lane * 4 + i * 256);
            const float a0 = h[i * 4] + (hp[i * 4] - h[i * 4]) * mm.x, a1 = h[i * 4 + 1] + (hp[i * 4 + 1] - h[i * 4 + 1]) * mm.y;
            const float a2 = h[i * 4 + 2] + (hp[i * 4 + 2] - h[i * 4 + 2]) * mm.z, a3 = h[i * 4 + 3] + (hp[i * 4 + 3] - h[i * 4 + 3]) * mm.w;
            u32x2 o; o.x = cvt_pk(a0, a1); o.y = cvt_pk(a2, a3);
            *(u32x2*)(dst + lane * 4 + i * 256) = o;
          }
        }
        const bool smp = g >= NPR;
        const int t = smp ? ((g - NPR) & 7) : (g & 2047);
        if (t == (smp ? 7 : 2047)) {
          float* o = p.out + (smp ? O_SSS + ((size_t)j * 128 + ((g - NPR) >> 3)) * DM : O_SSP + ((size_t)j * 8 + (g >> 11)) * DM);
#pragma unroll
          for (int i = 0; i < 4; ++i) *(float4*)(o + lane * 4 + i * 256) = make_float4(h[i * 4], h[i * 4 + 1], h[i * 4 + 2], h[i * 4 + 3]);
        }
#pragma unroll
        for (int i = 0; i < 16; ++i) hp[i] = h[i];
      }
    }
  }
}

__device__ __forceinline__ void final_phase(const Params& p) {
  const int tid = tidx(), wid = tid >> 6, lane = tid & 63;
  const float* xres = (const float*)(p.ws + WS_XRES);
  const float* fg = pin(p, I_FG);
  const int gw = bidx() * 8 + wid, nw = gridDim.x * 8;
  for (int g = gw; g < NTOK; g += nw) {
    float4 x[4]; float ss = 0.f;
    load_xrow(p, g, lane, x);
#pragma unroll
    for (int i = 0; i < 4; ++i) ss += x[i].x * x[i].x + x[i].y * x[i].y + x[i].z * x[i].z + x[i].w * x[i].w;
    ss = wave_sum(ss);
    const float rs = rsqrtf(ss * (1.f / 1024.f) + 1e-6f);
    float* o = p.out + O_YP + (size_t)g * DM;
#pragma unroll
    for (int i = 0; i < 4; ++i) {
      const float4 gg = *(const float4*)(fg + lane * 4 + i * 256);
      *(float4*)(o + lane * 4 + i * 256) = make_float4(x[i].x * rs * gg.x, x[i].y * rs * gg.y, x[i].z * rs * gg.z, x[i].w * rs * gg.w);
    }
  }
}

constexpr int BM = 256, BK = 64, HALF = 128, HT = HALF * BK;
__device__ __forceinline__ int lds_byte(int r, int c) {
  int st = (r >> 4) * 2 + (c >> 5), rr = r & 15, cc = c & 31, ob = rr * 64 + cc * 2;
  return st * 1024 + (ob ^ (((ob >> 9) & 1) << 5));
}
__device__ __forceinline__ void stage_rc(int b, int& R, int& C) {
  int st = b / 1024, sb = b % 1024, swz = sb ^ (((sb >> 9) & 1) << 5);
  R = (st >> 1) * 16 + swz / 64; C = (st & 1) * 32 + (swz % 64) / 2;
}

enum { EM_PROJ = 0, EM_G1R, EM_MEM, EM_LUP, EM_OUT, EM_OUTA };

__device__ __forceinline__ void epilogue(const Params& p, const int mode, const int l, const f32x4 (&acc)[2][2][4][2],
                                         const int pm, const int pn, const int wr, const int wc, const int fr, const int fq) {
  const int j = (l & 255) >> 1;
#pragma unroll
  for (int ai = 0; ai < 2; ++ai)
#pragma unroll
    for (int m = 0; m < 4; ++m) {
      const int row = pm * BM + ai * HALF + wr * 64 + m * 16 + fr;
#pragma unroll
      for (int bj = 0; bj < 2; ++bj)
#pragma unroll
        for (int n = 0; n < 2; ++n) {
          const int col = pn * BM + bj * HALF + wc * 32 + fq * 8 + n * 4;
          const f32x4 v = acc[ai][bj][m][n];
          if (mode == EM_PROJ || (mode == EM_G1R && pn < 20)) {
            if (n == 0) {
              const f32x4 v1 = acc[ai][bj][m][1];
              u32x4 o; o.x = cvt_pk(v[0], v[1]); o.y = cvt_pk(v[2], v[3]); o.z = cvt_pk(v1[0], v1[1]); o.w = cvt_pk(v1[2], v1[3]);
              *(u32x4*)((bfr*)(p.ws + WS_PROJ) + (size_t)row * INC + col) = o;
            }
          } else if (mode == EM_G1R) {
            bfr* al = (bfr*)(p.ws + WS_ALORA) + (size_t)row * 256;
            const int c = col & 255;
            if (pn == 20) {
              if (c < 64) {
                float t[4];
#pragma unroll
                for (int e = 0; e < 4; ++e) { const float ex = __expf(2.f * v[e]); t[e] = 1.f - 2.f * frcp(ex + 1.f); }
                u32x2 o; o.x = cvt_pk(t[0], t[1]); o.y = cvt_pk(t[2], t[3]);
                *(u32x2*)(al + c) = o;
              }
            } else if (pn == 21) {
              const int lim = (l == 3) ? 128 : 256;
              if (64 + c < lim) {
                u32x2 o; o.x = 0u; o.y = 0u;
                if (c < 64) { o.x = cvt_pk(v[0], v[1]); o.y = cvt_pk(v[2], v[3]); }
                *(u32x2*)(al + 64 + c) = o;
              }
            } else {
              if (128 + c < 256) {
                u32x2 o; o.x = 0u; o.y = 0u;
                if (c < 32) { o.x = cvt_pk(v[0], v[1]); o.y = cvt_pk(v[2], v[3]); }
                *(u32x2*)(al + 128 + c) = o;
              }
            }
          } else if (mode == EM_MEM) {
            const int lm = pm >> 3, r2 = row & 2047;
            float* o = p.out + (col < 512 ? O_MK : O_MV) + ((size_t)lm * 2048 + r2) * 512 + (col & 511);
            *(f32x4*)o = v;
          } else if (mode == EM_LUP) {
            const int seg = col >> 10, c = col & 1023;
            float t[4];
            if (seg == 0) {
              const float4 b = *(const float4*)(pin(p, I_W0) + j * DM + c);
              const float bb[4] = {b.x, b.y, b.z, b.w};
#pragma unroll
              for (int e = 0; e < 4; ++e) {
                const float x = bb[e] + v[e];
                const float sp = fmaxf(-x, 0.f) + __logf(1.f + __expf(-fabsf(x)));
                t[e] = -__expf(-sp - 0.5f);
              }
            } else if (seg == 1) {
              const float4 b = *(const float4*)(pin(p, I_A0) + j * DM + c);
              t[0] = sigmoidf_(b.x + v[0]); t[1] = sigmoidf_(b.y + v[1]); t[2] = sigmoidf_(b.z + v[2]); t[3] = sigmoidf_(b.w + v[3]);
            } else {
              const float4 b = *(const float4*)(pin(p, I_V0) + c);
              t[0] = sigmoidf_(b.x + v[0]); t[1] = sigmoidf_(b.y + v[1]); t[2] = sigmoidf_(b.z + v[2]); t[3] = sigmoidf_(b.w + v[3]);
            }
            u32x2 o; o.x = cvt_pk(t[0], t[1]); o.y = cvt_pk(t[2], t[3]);
            *(u32x2*)((bfr*)(p.ws + WS_LUP) + (size_t)row * 3072 + col) = o;
          } else if (mode == EM_OUT) {
            float* xo = (float*)(p.ws + WS_XRES) + (size_t)row * DM + col;
            const f32x4 x = *(const f32x4*)xo;
            *(f32x4*)xo = x + v;
          } else {
            *(f32x4*)((float*)(p.ws + WS_PART) + ((size_t)((l >> 8) - 1) * 1024 + (row - NPR)) * DM + col) = v;
          }
        }
    }
}

__device__ __forceinline__ void gemm_unit(const Params& p, const bfr* __restrict__ A, const bfr* __restrict__ Bt, const int K, const int kt0, const int nt,
                                          const int pm, const int pn, const int mode, const int l) {
  extern __shared__ __attribute__((aligned(16))) char smem[];
  bfr* shm = (bfr*)smem;
#define SA(b, h) (shm + ((b) * 2 + (h)) * HT)
#define SB(b, h) (shm + (4 + (b) * 2 + (h)) * HT)
#define STAGE(P, BASE, br, kt) do { const bfr* _g = (BASE) + (size_t)(br) * K + (kt0 + (kt)) * BK + goff; \
    __builtin_amdgcn_global_load_lds((const unsigned*)_g, (unsigned*)((char*)(P) + tid * 16), 16, 0, 0); \
    __builtin_amdgcn_global_load_lds((const unsigned*)(_g + (size_t)64 * K), (unsigned*)((char*)(P) + tid * 16 + 8192), 16, 0, 0); } while (0)
#define LDA(dst, b, h) for (int m = 0; m < 4; ++m) for (int k = 0; k < 2; ++k) \
    dst[m][k] = *reinterpret_cast<const bf16x8*>((char*)SA(b, h) + lds_byte(wr * 64 + m * 16 + fr, k * 32 + fq * 8))
#define LDB(dst, b, h) for (int n = 0; n < 2; ++n) for (int k = 0; k < 2; ++k) \
    dst[n][k] = *reinterpret_cast<const bf16x8*>((char*)SB(b, h) + lds_byte(wc * 32 + n * 16 + fr, k * 32 + fq * 8))
#define MMA(ai, bj, At, Bt_) do { __builtin_amdgcn_s_setprio(1); \
    for (int m = 0; m < 4; ++m) for (int n = 0; n < 2; ++n) for (int k = 0; k < 2; ++k) \
      acc[ai][bj][m][n] = __builtin_amdgcn_mfma_f32_16x16x32_bf16(Bt_[n][k], At[m][k], acc[ai][bj][m][n], 0, 0, 0); \
    __builtin_amdgcn_s_setprio(0); } while (0)
#define WAIT_V(n) asm volatile("s_waitcnt vmcnt(" #n ")" ::: "memory")
#define WAIT_L(n) asm volatile("s_waitcnt lgkmcnt(" #n ")" ::: "memory")
#define BAR __builtin_amdgcn_s_barrier()
#define SCHED __builtin_amdgcn_sched_barrier(0)
  const int tid = tidx();
  const int brow = pm * BM, bcol = pn * BM;
  const int wid = tid >> 6, lane = tid & 63, wr = wid >> 2, wc = wid & 3, fr = lane & 15, fq = lane >> 4;
  int R0, C0; stage_rc(tid * 16, R0, C0);
  const int goff = R0 * K + C0;
  f32x4 acc[2][2][4][2] = {};
  bf16x8 At[4][2], B0[2][2], B1[2][2];
  STAGE(SB(0, 0), Bt, bcol, 0); STAGE(SA(0, 0), A, brow, 0);
  STAGE(SB(0, 1), Bt, bcol + HALF, 0); STAGE(SA(0, 1), A, brow + HALF, 0);
  if (wr == 1) BAR;
  WAIT_V(4); BAR;
  STAGE(SB(1, 0), Bt, bcol, 1); STAGE(SA(1, 0), A, brow, 1); STAGE(SB(1, 1), Bt, bcol + HALF, 1);
  WAIT_V(6); BAR;
  for (int t = 0; t < nt - 2; t += 2) {
    LDB(B0, 0, 0); SCHED; LDA(At, 0, 0); STAGE(SA(1, 1), A, brow + HALF, t + 1);
    WAIT_L(8); BAR; WAIT_L(0); MMA(0, 0, At, B0); BAR; SCHED;
    LDB(B1, 0, 1); STAGE(SB(0, 0), Bt, bcol, t + 2);
    BAR; WAIT_L(0); MMA(0, 1, At, B1); BAR;
    LDA(At, 0, 1); STAGE(SA(0, 0), A, brow, t + 2);
    BAR; WAIT_L(0); MMA(1, 0, At, B0); BAR; SCHED;
    STAGE(SB(0, 1), Bt, bcol + HALF, t + 2);
    WAIT_V(6); BAR; MMA(1, 1, At, B1); BAR;
    LDB(B0, 1, 0); SCHED; LDA(At, 1, 0); STAGE(SA(0, 1), A, brow + HALF, t + 2);
    WAIT_L(8); BAR; WAIT_L(0); MMA(0, 0, At, B0); BAR; SCHED;
    LDB(B1, 1, 1); STAGE(SB(1, 0), Bt, bcol, t + 3);
    BAR; WAIT_L(0); MMA(0, 1, At, B1); BAR;
    LDA(At, 1, 1); STAGE(SA(1, 0), A, brow, t + 3);
    BAR; WAIT_L(0); MMA(1, 0, At, B0); BAR; SCHED;
    STAGE(SB(1, 1), Bt, bcol + HALF, t + 3);
    WAIT_V(6); BAR; MMA(1, 1, At, B1); BAR;
  }
  { LDB(B0, 0, 0); LDA(At, 0, 0); STAGE(SA(1, 1), A, brow + HALF, nt - 1);
    BAR; WAIT_L(0); MMA(0, 0, At, B0); BAR;
    LDB(B1, 0, 1); BAR; WAIT_L(0); MMA(0, 1, At, B1); BAR;
    LDA(At, 0, 1); WAIT_V(4); BAR; WAIT_L(0); MMA(1, 0, At, B0); MMA(1, 1, At, B1); BAR; }
  { LDB(B0, 1, 0); LDA(At, 1, 0); WAIT_V(2); BAR; WAIT_L(0); MMA(0, 0, At, B0); BAR;
    LDB(B1, 1, 1); WAIT_V(0); BAR; WAIT_L(0); MMA(0, 1, At, B1); BAR;
    LDA(At, 1, 1); BAR; WAIT_L(0); MMA(1, 0, At, B0); MMA(1, 1, At, B1); BAR; }
  if (wr == 0) BAR;
  epilogue(p, mode, l, acc, pm, pn, wr, wc, fr, fq);
  WAIT_V(0);
#undef SA
#undef SB
}

__device__ __forceinline__ bool unit_order(int i, int c, int G, int nM, int nN, int& pm, int& pn) {
  const int nwg = nM * nN;
  const long L = (long)i * G + c; if (L >= nwg) return false;
  int wgid = (int)L; { const int q = nwg / 8, r = nwg % 8, xcd = wgid % 8, off = wgid / 8; wgid = (xcd < r ? xcd * (q + 1) : r * (q + 1) + (xcd - r) * q) + off; }
  const int nig = 8 * nN, gid = wgid / nig, fm = gid * 8, gsz = (nM - fm) < 8 ? (nM - fm) : 8;
  pm = fm + ((wgid % nig) % gsz); pn = (wgid % nig) / gsz; return true;
}

__device__ __forceinline__ void gemm_phase(const Params& p, const int kind, const int l) {
  const int G = gridDim.x;
  const int j = l >> 1;
  const bool rw = l & 1;
  char* ws = p.ws;
  const bfr* hA = (const bfr*)(ws + WS_HA);
  int nM = NTOK / BM, nN, K, mode;
  const bfr* Bt;
  if (kind == 0) { nN = rw ? (l == 3 ? 23 : 22) : 20; K = 1024; mode = rw ? EM_G1R : EM_PROJ; Bt = (const bfr*)(ws + WS_WTIN) + l * WTIN_L; }
  else if (kind == 1) { nN = (l == 3) ? 12 : 8; K = 256; mode = EM_LUP; Bt = (const bfr*)(ws + WS_W2T) + (size_t)j * 3072 * 256; }
  else { nN = 4; K = 1536; mode = EM_OUT; Bt = (const bfr*)(ws + WS_WTOUT) + (size_t)l * DM * BRW; }
  int pm, pn;
  const int nwg1 = nM * nN;
  const bool withmem = (kind == 0 && l == 0);
  const int c2 = (bidx() + G - (nwg1 % G)) % G;
  int seg = 0, i = 0;
  for (;;) {
    const bfr* A; const bfr* B = Bt; int KK = K, md = mode, kt0 = 0, nt = K / BK, lk = l;
    if (kind == 2) {
      const int t = bidx() + G * i;
      if (t >= 256 + 96) break;
      ++i;
      A = (const bfr*)(ws + WS_BRANCH);
      if (t < 256) { pm = (t & 7) * 8 + (t >> 5); pn = (t >> 3) & 3; }
      else { const int v = t - 256, rem = v % 24, ks = rem % 6; pm = 64 + v / 24; pn = rem / 6; kt0 = ks * 4; nt = 4; if (ks) { md = EM_OUTA; lk = l | (ks << 8); } }
    } else {
      bool ok;
      if (seg == 0) ok = unit_order(i, bidx(), G, nM, nN, pm, pn);
      else ok = unit_order(i, c2, G, 32, 4, pm, pn);
      if (!ok) { if (seg == 0 && withmem) { seg = 1; i = 0; continue; } break; }
      ++i;
      if (seg == 1) { A = (const bfr*)(ws + WS_MEMN); B = (const bfr*)(ws + WS_WTMEM) + (size_t)(pm >> 3) * DM * DM; KK = 1024; nt = 16; md = EM_MEM; }
      else if (kind == 0) {
        int sel = 0;
        if (rw) sel = pn < 4 ? 1 : pn < 8 ? 3 : pn < 12 ? 4 : pn < 20 ? 0 : pn == 20 ? 2 : pn == 21 ? 5 : 4;
        A = hA + (size_t)sel * HA_SZ;
      } else A = (const bfr*)(ws + WS_ALORA);
    }
    gemm_unit(p, A, B, KK, kt0, nt, pm, pn, md, lk);
  }
}

__device__ __forceinline__ void xattn_unit(const Params& p, const float* __restrict__ kb, const float* __restrict__ vb, const int g0, const int ntok, const int head) {
  extern __shared__ __attribute__((aligned(16))) char smem[];
  bfr* Ks = (bfr*)smem;
  bfr* Vt = Ks + 256 * 136;
  const int tid = tidx(), wid = tid >> 6, lane = tid & 63, fr = lane & 15, fq = lane >> 4;
#pragma unroll 4
  for (int i = 0; i < 16; ++i) {
    const int idx = tid + i * 512, row = idx >> 5, c4 = (idx & 31) << 2;
    const float4 v = *(const float4*)(kb + (size_t)row * 512 + c4);
    u32x2 o; o.x = cvt_pk(v.x, v.y); o.y = cvt_pk(v.z, v.w);
    *(u32x2*)(Ks + row * 136 + c4) = o;
  }
  {
    const int pp = lane & 7, dd = lane >> 3;
#pragma unroll 4
    for (int it = 0; it < 8; ++it) {
      const int wq = it * 8 + wid, mb = wq & 15, db = wq >> 4;
      const int m0 = mb * 16 + 2 * pp, d0 = db * 32 + dd * 4;
      const float4 a = *(const float4*)(vb + (size_t)m0 * 512 + d0);
      const float4 b = *(const float4*)(vb + (size_t)(m0 + 1) * 512 + d0);
      *(unsigned*)(Vt + (d0 + 0) * 260 + m0) = cvt_pk(a.x, b.x);
      *(unsigned*)(Vt + (d0 + 1) * 260 + m0) = cvt_pk(a.y, b.y);
      *(unsigned*)(Vt + (d0 + 2) * 260 + m0) = cvt_pk(a.z, b.z);
      *(unsigned*)(Vt + (d0 + 3) * 260 + m0) = cvt_pk(a.w, b.w);
    }
  }
  __syncthreads();
  if (wid * 16 < ntok) {
    const bfr* proj = (const bfr*)(p.ws + WS_PROJ);
    int tl = wid * 16 + fr; if (tl > ntok - 1) tl = ntok - 1;
    const bfr* qrow = proj + (size_t)(g0 + tl) * INC + 3072 + head * 128;
    bf16x8 qf[4];
#pragma unroll
    for (int ks = 0; ks < 4; ++ks) qf[ks] = *(const bf16x8*)(qrow + ks * 32 + fq * 8);
    f32x4 sc[16];
#pragma unroll
    for (int mt = 0; mt < 16; ++mt) {
      f32x4 a = {0.f, 0.f, 0.f, 0.f};
#pragma unroll
      for (int ks = 0; ks < 4; ++ks) {
        const bf16x8 kf = *(const bf16x8*)(Ks + (mt * 16 + fr) * 136 + ks * 32 + fq * 8);
        a = __builtin_amdgcn_mfma_f32_16x16x32_bf16(kf, qf[ks], a, 0, 0, 0);
      }
      sc[mt] = a;
    }
    float mx = -3.0e38f;
#pragma unroll
    for (int mt = 0; mt < 16; ++mt) mx = fmaxf(mx, fmaxf(fmaxf(sc[mt][0], sc[mt][1]), fmaxf(sc[mt][2], sc[mt][3])));
    mx = fmaxf(mx, bperm(mx, lane ^ 16)); mx = fmaxf(mx, bperm(mx, lane ^ 32));
    const float cs = 0.08838834764831845f * 1.4426950408889634f;
    float sum = 0.f;
#pragma unroll
    for (int mt = 0; mt < 16; ++mt)
#pragma unroll
      for (int e = 0; e < 4; ++e) { const float pe = exp2f((sc[mt][e] - mx) * cs); sc[mt][e] = pe; sum += pe; }
    sum += bperm(sum, lane ^ 16); sum += bperm(sum, lane ^ 32);
    const float inv = frcp(sum);
    bf16x8 pf[8];
#pragma unroll
    for (int u = 0; u < 8; ++u) {
      u32x4 w; w.x = cvt_pk(sc[2 * u][0], sc[2 * u][1]); w.y = cvt_pk(sc[2 * u][2], sc[2 * u][3]);
      w.z = cvt_pk(sc[2 * u + 1][0], sc[2 * u + 1][1]); w.w = cvt_pk(sc[2 * u + 1][2], sc[2 * u + 1][3]);
      pf[u] = __builtin_bit_cast(bf16x8, w);
    }
    const bool tvalid = (wid * 16 + fr) < ntok;
    const int g = g0 + tl;
    const bfr* gate = proj + (size_t)g * INC + 3584 + 1024 + head * 128;
    bfr* br = (bfr*)(p.ws + WS_BRANCH) + (size_t)g * BRW + 1024 + head * 128;
#pragma unroll
    for (int dt = 0; dt < 8; ++dt) {
      f32x4 a = {0.f, 0.f, 0.f, 0.f};
#pragma unroll
      for (int u = 0; u < 8; ++u) {
        const bfr* vr = Vt + (dt * 16 + fr) * 260 + fq * 4;
        u32x4 w;
        const u32x2 lo = *(const u32x2*)(vr + (2 * u) * 16), hi = *(const u32x2*)(vr + (2 * u + 1) * 16);
        w.x = lo.x; w.y = lo.y; w.z = hi.x; w.w = hi.y;
        a = __builtin_amdgcn_mfma_f32_16x16x32_bf16(__builtin_bit_cast(bf16x8, w), pf[u], a, 0, 0, 0);
      }
      if (tvalid) {
        const u32x2 gw = *(const u32x2*)(gate + dt * 16 + fq * 4);
        const float g0f = bflo(gw.x), g1f = bfhi(gw.x), g2f = bflo(gw.y), g3f = bfhi(gw.y);
        u32x2 o;
        o.x = cvt_pk(a[0] * inv * g0f * sigmoidf_(g0f), a[1] * inv * g1f * sigmoidf_(g1f));
        o.y = cvt_pk(a[2] * inv * g2f * sigmoidf_(g2f), a[3] * inv * g3f * sigmoidf_(g3f));
        *(u32x2*)(br + dt * 16 + fq * 4) = o;
      }
    }
  }
  __syncthreads();
}

struct HgRaw { u32x2 q, f, v, g; };
__device__ __forceinline__ void hg_load(HgRaw& r, const bfr* __restrict__ proj, const int g0, const int T, const int sbi, const int h,
                                        const int wid, const int fr, const int fq, const int tid) {
  const int t0 = sbi * 16;
  if (t0 + fr < T) {
    const bfr* pr = proj + (size_t)(g0 + t0 + fr) * INC + h * 128 + wid * 16 + fq * 4;
    r.q = *(const u32x2*)pr; r.f = *(const u32x2*)(pr + 1024); r.g = *(const u32x2*)(pr + 3584);
  }
  const int vt = tid >> 5, dv4 = (tid & 31) << 2;
  if (t0 + vt < T) r.v = *(const u32x2*)(proj + (size_t)(g0 + t0 + vt) * INC + 2048 + h * 128 + dv4);
}
constexpr int HG_SET = 16 * 136 * 2 + 128 * 16 * 2;

__device__ __forceinline__ void hgrn_unit(const Params& p, const int l, const bool smp, const int b, const int h) {
  extern __shared__ __attribute__((aligned(16))) char smem[];
  bfr* lds0 = (bfr*)smem;
  float* decb = (float*)(lds0 + 2 * HG_SET);
  float* redb = decb + 256;
  const int tid = tidx(), wid = tid >> 6, lane = tid & 63, fr = lane & 15, fq = lane >> 4;
  const int j = l >> 1;
  const bfr* proj = (const bfr*)(p.ws + WS_PROJ);
  bfr* branch = (bfr*)(p.ws + WS_BRANCH);
  const int g0 = smp ? NPR + b * 8 : b * 2048;
  const int T = smp ? 8 : 2048;
  const int nsub = (T + 15) >> 4;
  f32x4 S[8];
  if (smp) {
    const float* s0 = pin(p, I_SH) + (((size_t)j * 128 + b) * 8 + h) * 16384;
#pragma unroll
    for (int kt = 0; kt < 8; ++kt)
#pragma unroll
      for (int e = 0; e < 4; ++e) S[kt][e] = s0[(kt * 16 + fq * 4 + e) * 128 + wid * 16 + fr];
  } else {
#pragma unroll
    for (int kt = 0; kt < 8; ++kt) S[kt] = (f32x4){0.f, 0.f, 0.f, 0.f};
  }
  const int dkp = wid * 16 + fq * 4;
  float lb[4];
#pragma unroll
  for (int e = 0; e < 4; ++e) {
    if (j == 0) lb[e] = 0.f;
    else { const int c = h * 128 + dkp + e; lb[e] = sigmoidf_(pin(p, I_LB)[1024 + c] - pin(p, I_LB)[c]); }
  }
  float og[4];
#pragma unroll
  for (int e = 0; e < 4; ++e) og[e] = pin(p, I_ONG)[j * 128 + wid * 16 + fq * 4 + e];

  HgRaw raw[4];
#pragma unroll
  for (int u = 0; u < 4; ++u) { raw[u].q = raw[u].f = raw[u].v = raw[u].g = (u32x2){0u, 0u}; hg_load(raw[u], proj, g0, T, u, h, wid, fr, fq, tid); }
  u32x2 gsave[2] = {(u32x2){0u, 0u}, (u32x2){0u, 0u}};
  f32x4 oprev = {0.f, 0.f, 0.f, 0.f};

  for (int i4 = 0; i4 < nsub; i4 += 4) {
#pragma unroll
    for (int u = 0; u < 4; ++u) {
      const int i = i4 + u;
      if (i < nsub) {
        const int s = u & 1;
        bfr* Qs = lds0 + s * HG_SET; bfr* Kh = Qs + 16 * 136; bfr* Kt = Kh + 16 * 136; bfr* Vt = Kt + 128 * 16;
        float* dec = decb + s * 128; float* red = redb + s * 128;
        {
          const int sb = i * 16;
          const bool valid = (sb + fr) < T;
          float q[4], P[4], kv[4];
          const float qz[4] = {bflo(raw[u].q.x), bfhi(raw[u].q.x), bflo(raw[u].q.y), bfhi(raw[u].q.y)};
          const float fz[4] = {bflo(raw[u].f.x), bfhi(raw[u].f.x), bflo(raw[u].f.y), bfhi(raw[u].f.y)};
#pragma unroll
          for (int e = 0; e < 4; ++e) {
            const float sg = sigmoidf_(fz[e]);
            const float f = fmaxf(lb[e] + (1.f - lb[e]) * sg, 1e-30f);
            P[e] = valid ? f : 1.f;
            kv[e] = valid ? (1.f - lb[e]) * (1.f - sg) : 0.f;
            q[e] = valid ? qz[e] * sigmoidf_(qz[e]) : 0.f;
          }
#pragma unroll
          for (int e = 0; e < 4; ++e) {
            P[e] *= __builtin_bit_cast(float, __builtin_amdgcn_update_dpp(0x3f800000, __builtin_bit_cast(int, P[e]), 0x111, 0xf, 0xf, false));
            P[e] *= __builtin_bit_cast(float, __builtin_amdgcn_update_dpp(0x3f800000, __builtin_bit_cast(int, P[e]), 0x112, 0xf, 0xf, false));
            P[e] *= __builtin_bit_cast(float, __builtin_amdgcn_update_dpp(0x3f800000, __builtin_bit_cast(int, P[e]), 0x114, 0xf, 0xf, false));
            P[e] *= __builtin_bit_cast(float, __builtin_amdgcn_update_dpp(0x3f800000, __builtin_bit_cast(int, P[e]), 0x118, 0xf, 0xf, false));
          }
          float qt[4], kh[4], kt[4];
#pragma unroll
          for (int e = 0; e < 4; ++e) {
            const float Pl = bperm(P[e], lane | 15);
            const float inv = frcp(fmaxf(P[e], 1e-30f));
            qt[e] = q[e] * P[e]; kh[e] = kv[e] * inv; kt[e] = kh[e] * Pl;
          }
          if (fr == 15) *(f32x4*)(dec + dkp) = (f32x4){P[0], P[1], P[2], P[3]};
          const int kpos = (wid >> 1) * 32 + fq * 8 + (wid & 1) * 4;
          u32x2 o; o.x = cvt_pk(qt[0], qt[1]); o.y = cvt_pk(qt[2], qt[3]);
          *(u32x2*)(Qs + fr * 136 + kpos) = o;
          o.x = cvt_pk(kh[0], kh[1]); o.y = cvt_pk(kh[2], kh[3]);
          *(u32x2*)(Kh + fr * 136 + kpos) = o;
          { const unsigned k01 = cvt_pk(kt[0], kt[1]), k23 = cvt_pk(kt[2], kt[3]);
            Kt[(dkp + 0) * 16 + fr] = (bfr)(k01 & 0xffff); Kt[(dkp + 1) * 16 + fr] = (bfr)(k01 >> 16);
            Kt[(dkp + 2) * 16 + fr] = (bfr)(k23 & 0xffff); Kt[(dkp + 3) * 16 + fr] = (bfr)(k23 >> 16); }
          const int vt = tid >> 5, dv4 = (tid & 31) << 2;
          const bool vv = (sb + vt) < T;
          const unsigned vx = vv ? raw[u].v.x : 0u, vy = vv ? raw[u].v.y : 0u;
          Vt[(dv4 + 0) * 16 + vt] = (bfr)(vx & 0xffff); Vt[(dv4 + 1) * 16 + vt] = (bfr)(vx >> 16);
          Vt[(dv4 + 2) * 16 + vt] = (bfr)(vy & 0xffff); Vt[(dv4 + 3) * 16 + vt] = (bfr)(vy >> 16);
          gsave[s] = raw[u].g;
          hg_load(raw[u], proj, g0, T, i + 4, h, wid, fr, fq, tid);
        }
        __syncthreads();
        if (i > 0) {
          const float* redp = redb + (s ^ 1) * 128;
          float tot = 0.f;
#pragma unroll
          for (int w = 0; w < 8; ++w) tot += redp[fr * 8 + w];
          const float rs = rsqrtf(tot * (1.f / 128.f) + 1e-6f);
          const int tk = (i - 1) * 16 + fr;
          if (tk < T) {
            const u32x2 gw = gsave[s ^ 1];
            const float gg[4] = {bflo(gw.x), bfhi(gw.x), bflo(gw.y), bfhi(gw.y)};
            float r[4];
#pragma unroll
            for (int e = 0; e < 4; ++e) r[e] = oprev[e] * rs * og[e] * gg[e] * sigmoidf_(gg[e]);
            u32x2 o; o.x = cvt_pk(r[0], r[1]); o.y = cvt_pk(r[2], r[3]);
            *(u32x2*)(branch + (size_t)(g0 + tk) * BRW + h * 128 + wid * 16 + fq * 4) = o;
          }
        }
        {
          bf16x8 qp[4], kp[4];
#pragma unroll
          for (int uu = 0; uu < 4; ++uu) {
            qp[uu] = *(const bf16x8*)(Qs + fr * 136 + uu * 32 + fq * 8);
            kp[uu] = *(const bf16x8*)(Kh + fr * 136 + uu * 32 + fq * 8);
          }
          f32x4 at = {0.f, 0.f, 0.f, 0.f};
#pragma unroll
          for (int uu = 0; uu < 4; ++uu) at = __builtin_amdgcn_mfma_f32_16x16x32_bf16(kp[uu], qp[uu], at, 0, 0, 0);
#pragma unroll
          for (int e = 0; e < 4; ++e) if (fq * 4 + e > fr) at[e] = 0.f;
          u32x2 aw; aw.x = cvt_pk(at[0], at[1]); aw.y = cvt_pk(at[2], at[3]);
          const bf16x4 a4 = __builtin_bit_cast(bf16x4, aw);
          const bf16x4 vf = *(const bf16x4*)(Vt + (wid * 16 + fr) * 16 + fq * 4);
          const bf16x8 vf8 = {vf[0], vf[1], vf[2], vf[3], 0, 0, 0, 0}, a8 = {a4[0], a4[1], a4[2], a4[3], 0, 0, 0, 0};
          f32x4 oacc = __builtin_amdgcn_mfma_f32_16x16x32_bf16(vf8, a8, (f32x4){0.f, 0.f, 0.f, 0.f}, 0, 0, 0);
#pragma unroll
          for (int uu = 0; uu < 4; ++uu) {
            u32x4 w; w.x = cvt_pk(S[2 * uu][0], S[2 * uu][1]); w.y = cvt_pk(S[2 * uu][2], S[2 * uu][3]);
            w.z = cvt_pk(S[2 * uu + 1][0], S[2 * uu + 1][1]); w.w = cvt_pk(S[2 * uu + 1][2], S[2 * uu + 1][3]);
            oacc = __builtin_amdgcn_mfma_f32_16x16x32_bf16(__builtin_bit_cast(bf16x8, w), qp[uu], oacc, 0, 0, 0);
          }
#pragma unroll
          for (int kt = 0; kt < 8; ++kt) {
            const f32x4 d = *(const f32x4*)(dec + kt * 16 + fq * 4);
            const bf16x4 kf = *(const bf16x4*)(Kt + (kt * 16 + fr) * 16 + fq * 4);
            const bf16x8 kf8 = {kf[0], kf[1], kf[2], kf[3], 0, 0, 0, 0};
            S[kt] = __builtin_amdgcn_mfma_f32_16x16x32_bf16(kf8, vf8, S[kt] * d, 0, 0, 0);
          }
          float ss = oacc[0] * oacc[0] + oacc[1] * oacc[1] + oacc[2] * oacc[2] + oacc[3] * oacc[3];
          ss += bperm(ss, lane ^ 16); ss += bperm(ss, lane ^ 32);
          if (fq == 0) red[fr * 8 + wid] = ss;
          oprev = oacc;
        }
      }
    }
  }
  __syncthreads();
  {
    const int i = nsub - 1, s = i & 1;
    const float* redp = redb + s * 128;
    float tot = 0.f;
#pragma unroll
    for (int w = 0; w < 8; ++w) tot += redp[fr * 8 + w];
    const float rs = rsqrtf(tot * (1.f / 128.f) + 1e-6f);
    const int tk = i * 16 + fr;
    if (tk < T) {
      const u32x2 gw = gsave[s];
      const float gg[4] = {bflo(gw.x), bfhi(gw.x), bflo(gw.y), bfhi(gw.y)};
      float r[4];
#pragma unroll
      for (int e = 0; e < 4; ++e) r[e] = oprev[e] * rs * og[e] * gg[e] * sigmoidf_(gg[e]);
      u32x2 o; o.x = cvt_pk(r[0], r[1]); o.y = cvt_pk(r[2], r[3]);
      *(u32x2*)(branch + (size_t)(g0 + tk) * BRW + h * 128 + wid * 16 + fq * 4) = o;
    }
  }
  float* so = p.out + (smp ? O_SHS + (((size_t)j * 128 + b) * 8 + h) * 16384 : O_SHP + (((size_t)j * 8 + b) * 8 + h) * 16384);
#pragma unroll
  for (int kt = 0; kt < 8; ++kt)
#pragma unroll
    for (int e = 0; e < 4; ++e) so[(kt * 16 + fq * 4 + e) * 128 + wid * 16 + fr] = S[kt][e];
  __syncthreads();
}

#define LDS_BARRIER() do { asm volatile("s_waitcnt lgkmcnt(0)" ::: "memory"); __builtin_amdgcn_s_barrier(); asm volatile("" ::: "memory"); } while (0)
typedef float f32x2 __attribute__((ext_vector_type(2)));
struct RwRaw { u32x2 r, k, v, gt, ew, a, vg, vf; };
constexpr int RW_SET = 7 * 1024;
struct RwCtx {
  const bfr* proj; const bfr* lup; const bfr* vfsrc; bfr* vdst; bfr* branch;
  int vgoff, vfld;
  int g0, T, tsl, cq4, C4;
  f32x4 kkw, kaw, rkw, lng, lnb;
};
__device__ __forceinline__ float sum16(float v) {
  v += dppf<0xB1>(v); v += dppf<0x4E>(v); v += dppf<0x141>(v); v += dppf<0x140>(v);
  return v;
}
__device__ __forceinline__ f32x4 unpk4(const u32x2 w) { return (f32x4){bflo(w.x), bfhi(w.x), bflo(w.y), bfhi(w.y)}; }
__device__ __forceinline__ void rw_load(RwRaw& raw, const RwCtx& c, const int tile) {
  int tok = tile * 16 + c.tsl; tok = tok < c.T ? tok : c.T - 1;
  const size_t g = (size_t)(c.g0 + tok);
  const bfr* pr = c.proj + g * INC + c.C4;
  raw.r = *(const u32x2*)pr; raw.k = *(const u32x2*)(pr + 1024); raw.v = *(const u32x2*)(pr + 2048); raw.gt = *(const u32x2*)(pr + 3584);
  const bfr* pl = c.lup + g * 3072 + c.C4;
  raw.ew = *(const u32x2*)pl; raw.a = *(const u32x2*)(pl + 1024); raw.vg = *(const u32x2*)(pl + c.vgoff);
  raw.vf = *(const u32x2*)(c.vfsrc + g * c.vfld + c.C4);
}
__device__ __forceinline__ void rw_prep(const RwRaw& raw, f32x4& bon, f32x4& gt, float* __restrict__ L, const RwCtx& c, const int tile) {
  int tok = tile * 16 + c.tsl; tok = tok < c.T ? tok : c.T - 1;
  const int tt = tok & 15;
  const size_t g = (size_t)(c.g0 + tok);
  const f32x4 r = unpk4(raw.r), k = unpk4(raw.k), ew = unpk4(raw.ew), a = unpk4(raw.a);
  f32x4 v = unpk4(raw.v);
  *(u32x2*)(c.vdst + g * DM + c.C4) = raw.v;
  v = v + (unpk4(raw.vf) - v) * unpk4(raw.vg);
  f32x4 dcy; dcy[0] = __expf(ew[0]); dcy[1] = __expf(ew[1]); dcy[2] = __expf(ew[2]); dcy[3] = __expf(ew[3]);
  f32x4 kk = k * c.kkw;
  const float n2 = sum16((kk[0] * kk[0] + kk[1] * kk[1]) + (kk[2] * kk[2] + kk[3] * kk[3]));
  const float inv = __builtin_amdgcn_rsqf(fmaxf(n2, 1e-24f));
  kk = kk * inv;
  const f32x4 k2 = k * (1.f + (a - 1.f) * c.kaw);
  const f32x4 rk = r * k2 * c.rkw;
  const float sb = sum16((rk[0] + rk[1]) + (rk[2] + rk[3]));
  bon = v * sb;
  gt = unpk4(raw.gt);
  const int o = tt * 64 + c.cq4;
  *(f32x4*)(L + 0 * 1024 + o) = r; *(f32x4*)(L + 1 * 1024 + o) = dcy; *(f32x4*)(L + 2 * 1024 + o) = k2; *(f32x4*)(L + 3 * 1024 + o) = v;
  *(f32x4*)(L + 4 * 1024 + o) = -kk; *(f32x4*)(L + 5 * 1024 + o) = kk * a;
}
__device__ __forceinline__ void rw_post(const f32x4 bon, const f32x4 gt, const float* __restrict__ L, const RwCtx& c, const int tile) {
  int tok = tile * 16 + c.tsl; tok = tok < c.T ? tok : c.T - 1;
  const int tt = tok & 15;
  const size_t g = (size_t)(c.g0 + tok);
  const f32x4 y = *(const f32x4*)(L + 6 * 1024 + tt * 64 + c.cq4);
  const float mean = sum16((y[0] + y[1]) + (y[2] + y[3])) * (1.f / 64.f);
  const f32x4 d = y - mean;
  const float var = sum16((d[0] * d[0] + d[1] * d[1]) + (d[2] * d[2] + d[3] * d[3])) * (1.f / 64.f);
  f32x4 o = d * rsqrtf(var + 64e-5f) * c.lng + c.lnb + bon;
  o[0] *= gt[0] * sigmoidf_(gt[0]); o[1] *= gt[1] * sigmoidf_(gt[1]); o[2] *= gt[2] * sigmoidf_(gt[2]); o[3] *= gt[3] * sigmoidf_(gt[3]);
  u32x2 w; w.x = cvt_pk(o[0], o[1]); w.y = cvt_pk(o[2], o[3]);
  *(u32x2*)(c.branch + g * BRW + c.C4) = w;
}
struct RwVec { f32x4 r0, r1, w0, w1, k0, k1, a0, a1, b0, b1; float v; };
__device__ __forceinline__ void rw_ldvec(RwVec& x, const float* __restrict__ L, const int t, const int row, const int c0) {
  x.r0 = *(const f32x4*)(L + 0 * 1024 + t * 64 + c0); x.r1 = *(const f32x4*)(L + 0 * 1024 + t * 64 + c0 + 4);
  x.w0 = *(const f32x4*)(L + 1 * 1024 + t * 64 + c0); x.w1 = *(const f32x4*)(L + 1 * 1024 + t * 64 + c0 + 4);
  x.k0 = *(const f32x4*)(L + 2 * 1024 + t * 64 + c0); x.k1 = *(const f32x4*)(L + 2 * 1024 + t * 64 + c0 + 4);
  x.v = L[3 * 1024 + t * 64 + row];
  x.a0 = *(const f32x4*)(L + 4 * 1024 + t * 64 + c0); x.a1 = *(const f32x4*)(L + 4 * 1024 + t * 64 + c0 + 4);
  x.b0 = *(const f32x4*)(L + 5 * 1024 + t * 64 + c0); x.b1 = *(const f32x4*)(L + 5 * 1024 + t * 64 + c0 + 4);
}
template <int NST>
__device__ __forceinline__ void rw_scan(f32x2 (&S)[4], float* __restrict__ L, const int row, const int c0, const int cg) {
  RwVec cur, nxt;
  rw_ldvec(cur, L, 0, row, c0);
  float ys0 = 0.f, ys1 = 0.f;
#pragma unroll
  for (int t = 0; t < NST; ++t) {
    if (t + 1 < NST) rw_ldvec(nxt, L, t + 1, row, c0);
    const f32x2 av[4] = {{cur.a0[0], cur.a0[1]}, {cur.a0[2], cur.a0[3]}, {cur.a1[0], cur.a1[1]}, {cur.a1[2], cur.a1[3]}};
    const f32x2 wv[4] = {{cur.w0[0], cur.w0[1]}, {cur.w0[2], cur.w0[3]}, {cur.w1[0], cur.w1[1]}, {cur.w1[2], cur.w1[3]}};
    const f32x2 bv[4] = {{cur.b0[0], cur.b0[1]}, {cur.b0[2], cur.b0[3]}, {cur.b1[0], cur.b1[1]}, {cur.b1[2], cur.b1[3]}};
    const f32x2 kv[4] = {{cur.k0[0], cur.k0[1]}, {cur.k0[2], cur.k0[3]}, {cur.k1[0], cur.k1[1]}, {cur.k1[2], cur.k1[3]}};
    const f32x2 rv[4] = {{cur.r0[0], cur.r0[1]}, {cur.r0[2], cur.r0[3]}, {cur.r1[0], cur.r1[1]}, {cur.r1[2], cur.r1[3]}};
    const f32x2 vi2 = {cur.v, cur.v};
    f32x2 pa = S[0] * av[0] + S[1] * av[1];
    const f32x2 pb = S[2] * av[2] + S[3] * av[3];
    f32x2 n[4];
#pragma unroll
    for (int q = 0; q < 4; ++q) n[q] = S[q] * wv[q] + vi2 * kv[q];
    pa += pb;
    const float sa = sum8(pa[0] + pa[1]);
    const f32x2 sa2 = {sa, sa};
#pragma unroll
    for (int q = 0; q < 4; ++q) S[q] = sa2 * bv[q] + n[q];
    f32x2 ya = S[0] * rv[0] + S[1] * rv[1];
    const f32x2 yb = S[2] * rv[2] + S[3] * rv[3];
    ya += yb;
    const float y = sum8(ya[0] + ya[1]);
    if (cg == (t & 7)) { if (t < 8) ys0 = y; else ys1 = y; }
    cur = nxt;
  }
  L[6 * 1024 + cg * 64 + row] = ys0;
  if (NST > 8) L[6 * 1024 + (cg + 8) * 64 + row] = ys1;
}

__device__ __forceinline__ void rwkv_unit(const Params& p, const int l, const bool smp, const int b, const int head) {
  extern __shared__ __attribute__((aligned(16))) char smem[];
  float* L0 = (float*)smem;
  float* L1 = L0 + RW_SET;
  RwCtx c;
  const int tid = tidx();
  const int wid = tid >> 6, lane = tid & 63;
  const int j = l >> 1;
  c.proj = (const bfr*)(p.ws + WS_PROJ);
  c.lup = (const bfr*)(p.ws + WS_LUP);
  c.vfsrc = (j == 0) ? c.proj + 2048 : (const bfr*)(p.ws + WS_VFIRST);
  c.vfld = (j == 0) ? INC : DM;
  c.vgoff = (j == 0) ? 1024 : 2048;
  c.vdst = (j == 0) ? (bfr*)(p.ws + WS_VFIRST) : (bfr*)(p.ws + WS_HA + 2 * HA_SZ * 2);
  c.branch = (bfr*)(p.ws + WS_BRANCH);
  c.g0 = smp ? NPR + b * 8 : b * 2048;
  c.T = smp ? 8 : 2048;
  c.tsl = 2 * wid + ((lane >> 4) & 1);
  c.cq4 = (lane & 15) * 4;
  c.C4 = head * 64 + c.cq4;
  const int cg = lane & 7, row = wid * 8 + (lane >> 3), c0 = cg * 8;
  f32x2 S[4];
  if (smp) {
    const float* s0 = pin(p, I_SR) + ((((size_t)j * 128 + b) * 16 + head) * 64 + row) * 64 + c0;
    const float4 a = *(const float4*)s0, bq = *(const float4*)(s0 + 4);
    S[0] = (f32x2){a.x, a.y}; S[1] = (f32x2){a.z, a.w}; S[2] = (f32x2){bq.x, bq.y}; S[3] = (f32x2){bq.z, bq.w};
  } else {
    S[0] = S[1] = S[2] = S[3] = (f32x2){0.f, 0.f};
  }
  c.kkw = *(const f32x4*)(pin(p, I_KK) + j * DM + c.C4); c.kaw = *(const f32x4*)(pin(p, I_KA) + j * DM + c.C4); c.rkw = *(const f32x4*)(pin(p, I_RK) + j * DM + c.C4);
  c.lng = *(const f32x4*)(pin(p, I_LG) + j * DM + c.C4); c.lnb = *(const f32x4*)(pin(p, I_LBI) + j * DM + c.C4);
  RwRaw rawA, rawB;
  f32x4 bonA, bonB, gtA, gtB;
  if (smp) {
    rw_load(rawA, c, 0);
    rw_prep(rawA, bonA, gtA, L0, c, 0);
    LDS_BARRIER();
    rw_scan<8>(S, L0, row, c0, cg);
    LDS_BARRIER();
    rw_post(bonA, gtA, L0, c, 0);
  } else {
    const int ntile = 128;
    rw_load(rawA, c, 0); rw_load(rawB, c, 1);
    rw_prep(rawA, bonA, gtA, L0, c, 0); rw_load(rawA, c, 2);
    LDS_BARRIER();
    rw_scan<16>(S, L0, row, c0, cg); rw_prep(rawB, bonB, gtB, L1, c, 1); rw_load(rawB, c, 3);
    LDS_BARRIER();
    for (int i = 1; i < ntile - 1; i += 2) {
      rw_post(bonA, gtA, L0, c, i - 1); rw_scan<16>(S, L1, row, c0, cg); rw_prep(rawA, bonA, gtA, L0, c, i + 1); rw_load(rawA, c, i + 3);
      LDS_BARRIER();
      rw_post(bonB, gtB, L1, c, i); rw_scan<16>(S, L0, row, c0, cg); rw_prep(rawB, bonB, gtB, L1, c, i + 2); rw_load(rawB, c, i + 4);
      LDS_BARRIER();
    }
    rw_post(bonA, gtA, L0, c, ntile - 2); rw_scan<16>(S, L1, row, c0, cg);
    LDS_BARRIER();
    rw_post(bonB, gtB, L1, c, ntile - 1);
  }
  float* so = p.out + (smp ? O_SRS + ((((size_t)j * 128 + b) * 16 + head) * 64 + row) * 64 + c0 : O_SRP + ((((size_t)j * 8 + b) * 16 + head) * 64 + row) * 64 + c0);
  *(float4*)so = make_float4(S[0][0], S[0][1], S[1][0], S[1][1]); *(float4*)(so + 4) = make_float4(S[2][0], S[2][1], S[3][0], S[3][1]);
  __syncthreads();
}

__device__ __forceinline__ void mix_phase(const Params& p, const int l, const int rep) {
  __shared__ int s_item;
  unsigned* ctr = (unsigned*)(p.ws + WS_CTRL) + l + 4 * rep;
  const bool rw = l & 1;
  const int nP = rw ? 128 : 64, nS = rw ? 2048 : 1024;
  const int nitems = nP + nS + 1024;
  for (;;) {
    __syncthreads();
    if (tidx() == 0) s_item = (int)atomicAdd(ctr, 1u);
    __syncthreads();
    int it = s_item;
    if (rep > 0 && PROBE_SUB == 1) { if (it >= nP) break; }
    if (rep > 0 && PROBE_SUB == 2) { it += nP; if (it >= nP + nS) break; }
    if (rep > 0 && PROBE_SUB == 3) { it += nP + nS; }
    if (it >= nitems) break;
    if (it < nP + nS) {
      const bool smp = it >= nP;
      if (smp) it -= nP;
      if (rw) rwkv_unit(p, l, smp, it >> 4, it & 15); else hgrn_unit(p, l, smp, it >> 3, it & 7);
    } else {
      it -= nP + nS;
      const float* kb; const float* vb; int g0, ntok, head;
      if (it < 512) {
        const int b = it >> 6, blk = it & 15; head = (it >> 4) & 3;
        const size_t off = ((size_t)(l * 8 + b) * 256) * 512 + head * 128;
        kb = p.out + O_MK + off; vb = p.out + O_MV + off; g0 = b * 2048 + blk * 128; ntok = 128;
      } else {
        it -= 512;
        const int b = it >> 2; head = it & 3;
        const size_t off = ((size_t)(l * 128 + b) * 256) * 512 + head * 128;
        kb = pin(p, I_CK) + off; vb = pin(p, I_CV) + off; g0 = NPR + b * 8; ntok = 8;
      }
      xattn_unit(p, kb, vb, g0, ntok, head);
    }
  }
}

__device__ __forceinline__ void grid_barrier(unsigned* bar, const unsigned target) {
  asm volatile("s_waitcnt vmcnt(0)" ::: "memory");
  __syncthreads();
  if (threadIdx.x == 0) {
    __builtin_amdgcn_fence(__ATOMIC_RELEASE, "agent");
    asm volatile("s_waitcnt vmcnt(0)" ::: "memory");
    __hip_atomic_fetch_add(bar, 1u, __ATOMIC_RELAXED, __HIP_MEMORY_SCOPE_AGENT);
    unsigned spins = 0;
    while (__hip_atomic_load(bar, __ATOMIC_RELAXED, __HIP_MEMORY_SCOPE_AGENT) < target && ++spins < (1u << 24)) __builtin_amdgcn_s_sleep(2);
    __builtin_amdgcn_fence(__ATOMIC_ACQUIRE, "agent");
    asm volatile("s_waitcnt vmcnt(0)" ::: "memory");
  }
  __syncthreads();
}
__device__ __forceinline__ void run_phase(const Params& p, const int ph, const int rep) {
  int code;
  switch (ph) {
    case 0: code = 0; break;
    case 1: code = 1 | (0 << 4) | (0 << 8); break;
    case 2: code = 2 | (0 << 8); break;
    case 3: code = 1 | (2 << 4) | (0 << 8); break;
    case 4: code = 3 | (1 << 8); break;
    case 5: code = 1 | (0 << 4) | (1 << 8); break;
    case 6: code = 1 | (1 << 4) | (1 << 8); break;
    case 7: code = 2 | (1 << 8); break;
    case 8: code = 1 | (2 << 4) | (1 << 8); break;
    case 9: code = 3 | (2 << 8); break;
    case 10: code = 1 | (0 << 4) | (2 << 8); break;
    case 11: code = 2 | (2 << 8); break;
    case 12: code = 1 | (2 << 4) | (2 << 8); break;
    case 13: code = 3 | (3 << 8); break;
    case 14: code = 1 | (0 << 4) | (3 << 8); break;
    case 15: code = 1 | (1 << 4) | (3 << 8); break;
    case 16: code = 2 | (3 << 8); break;
    case 17: code = 1 | (2 << 4) | (3 << 8); break;
    default: code = 4; break;
  }
  const int type = code & 15, kind = (code >> 4) & 15, l = code >> 8;
  if (type == 0) prologue(p);
  else if (type == 1) gemm_phase(p, kind, l);
  else if (type == 2) mix_phase(p, l, rep);
  else if (type == 3) prep_phase(p, l);
  else final_phase(p);
}
constexpr int NPHASE = 19;

__global__ void __launch_bounds__(512) mega(Params p) {
  unsigned nbar = 0;
  for (int ph = p.ph_lo; ph <= p.ph_hi; ++ph) {
    const int nrep = ((PROBE_MASK >> ph) & 1u) ? 2 : 1;
    for (int rep = 0; rep < nrep; ++rep) {
      run_phase(p, ph, rep);
      if (ph < p.ph_hi || rep + 1 < nrep) {
        if (p.ph_hi < 0) cg::this_grid().sync();
        ++nbar; grid_barrier((unsigned*)(p.ws + WS_CTRL) + 32, nbar * gridDim.x);
      }
    }
  }
}

extern "C" void kernel_launch(void* const* d_in, const int* in_sizes, int n_in, void* d_out, int out_size, void* d_ws, size_t ws_size,
                              hipStream_t stream) {
  static int grid = 0;
  if (grid == 0) {
    if (n_in != 31 || ws_size < WS_END) { fprintf(stderr, "kernel_launch: unexpected n_in %d / ws %zu (need %zu)\n", n_in, ws_size, (size_t)WS_END); grid = -1; return; }
    int dev = 0, cus = 0, per_cu = 0;
    hipGetDevice(&dev);
    hipDeviceGetAttribute(&cus, hipDeviceAttributeMultiprocessorCount, dev);
    if (hipFuncSetAttribute((const void*)mega, hipFuncAttributeMaxDynamicSharedMemorySize, LDS_BYTES) != hipSuccess) { fprintf(stderr, "hipFuncSetAttribute failed\n"); grid = -1; return; }
    hipOccupancyMaxActiveBlocksPerMultiprocessor(&per_cu, (const void*)mega, 512, LDS_BYTES);
    if (per_cu < 1) { fprintf(stderr, "occupancy query says %d blocks/CU\n", per_cu); per_cu = 1; }
    (void)hipGetLastError();
    grid = cus * per_cu;
  }
  if (grid < 0) return;
  Params p{};
  for (int i = 0; i < 31; ++i) p.in[i] = (const float*)d_in[i];
  p.out = (float*)d_out; p.ws = (char*)d_ws;
  if (hipMemsetAsync((char*)d_ws + WS_CTRL, 0, 4096, stream) != hipSuccess) { fprintf(stderr, "kernel_launch: control-word memset failed\n"); return; }
#if COOP
  p.ph_lo = 0; p.ph_hi = NPHASE - 1;
  void* args[] = {&p};
  hipError_t e = hipLaunchCooperativeKernel((const void*)mega, dim3(grid), dim3(512), args, LDS_BYTES, stream);
  if (e != hipSuccess) fprintf(stderr, "cooperative launch failed: %s (grid %d)\n", hipGetErrorString(e), grid);
#else
  for (int ph = 0; ph < NPHASE; ++ph) {
    p.ph_lo = ph; p.ph_hi = ph;
    hipLaunchKernelGGL(mega, dim3(grid), dim3(512), LDS_BYTES, stream, p);
  }
#endif
}
```

```cpp
#include <hip/hip_runtime.h>
#include <hip/hip_cooperative_groups.h>
#include <cstdio>
#include <cstdint>
namespace cg = cooperative_groups;

#ifndef COOP
#define COOP 1
#endif
#ifndef PROBE_SUB
#define PROBE_SUB 0
#endif
#ifndef PROBE_MASK
#define PROBE_MASK 0u
#endif

typedef unsigned short bfr;
typedef short bf16x8 __attribute__((ext_vector_type(8)));
typedef short bf16x4 __attribute__((ext_vector_type(4)));
typedef float f32x4 __attribute__((ext_vector_type(4)));
typedef unsigned u32x2 __attribute__((ext_vector_type(2)));
typedef unsigned u32x4 __attribute__((ext_vector_type(4)));

constexpr int NTOK = 17408, NPR = 16384, DM = 1024, INC = 5120, BRW = 1536;
constexpr int LDS_BYTES = 139264;
constexpr size_t O_YP = 0, O_SHP = 17825792, O_SRP = 19922944, O_SSP = 20971520, O_MK = 20987904, O_MV = 25182208,
                 O_SHS = 29376512, O_SRS = 62930944, O_SSS = 79708160;
constexpr size_t WS_CTRL = 0;
constexpr size_t WS_WTIN = 4096;
constexpr size_t WTIN_L = (size_t)5888 * 1024;
constexpr size_t WS_WTOUT = WS_WTIN + 4 * WTIN_L * 2;
constexpr size_t WS_WTMEM = WS_WTOUT + (size_t)4 * 1024 * 1536 * 2;
constexpr size_t WS_W2T = WS_WTMEM + (size_t)4 * 1024 * 1024 * 2;
constexpr size_t WS_MEMN = WS_W2T + (size_t)2 * 3072 * 256 * 2;
constexpr size_t WS_XRES = WS_MEMN + (size_t)4 * 2048 * 1024 * 2;
constexpr size_t HA_SZ = (size_t)NTOK * 1024;
constexpr size_t WS_HA = WS_XRES + (size_t)NTOK * 1024 * 4;
constexpr size_t WS_PROJ = WS_HA + 6 * HA_SZ * 2;
constexpr size_t WS_ALORA = WS_PROJ + (size_t)NTOK * INC * 2;
constexpr size_t WS_LUP = WS_ALORA + (size_t)NTOK * 256 * 2;
constexpr size_t WS_VFIRST = WS_LUP + (size_t)NTOK * 3072 * 2;
constexpr size_t WS_BRANCH = WS_VFIRST + HA_SZ * 2;
constexpr size_t WS_PART = WS_BRANCH + (size_t)NTOK * BRW * 2;
constexpr size_t WS_XBAR = WS_PART + (size_t)5 * 1024 * 1024 * 4;
constexpr size_t WS_END = WS_XBAR + 16384;

struct Params {
  const float* in[31];
  float* out;
  char* ws;
  int ph_lo, ph_hi;
};
enum { I_XP = 0, I_XS, I_MEM, I_SH, I_SR, I_SS, I_CK, I_CV, I_NG, I_WIN, I_WOUT, I_MNG, I_WMEM, I_LB, I_ONG, I_MU, I_W0, I_W1, I_W2,
       I_A0, I_A1, I_A2, I_V0, I_V1, I_V2, I_KK, I_KA, I_RK, I_LG, I_LBI, I_FG };

__device__ __forceinline__ unsigned cvt_pk(float lo, float hi) { unsigned r; asm("v_cvt_pk_bf16_f32 %0, %1, %2" : "=v"(r) : "v"(lo), "v"(hi)); return r; }
__device__ __forceinline__ bfr f2bf(float f) { return (bfr)(cvt_pk(f, 0.f) & 0xffff); }
__device__ __forceinline__ float bf2f(unsigned h) { return __uint_as_float(h << 16); }
__device__ __forceinline__ float bflo(unsigned w) { return __uint_as_float(w << 16); }
__device__ __forceinline__ float bfhi(unsigned w) { return __uint_as_float(w & 0xffff0000u); }
__device__ __forceinline__ float frcp(float x) { return __builtin_amdgcn_rcpf(x); }
__device__ __forceinline__ float sigmoidf_(float x) { return frcp(1.f + __expf(-x)); }
template <int CTRL> __device__ __forceinline__ float dppf(float x) {
  return __builtin_bit_cast(float, __builtin_amdgcn_update_dpp(0, __builtin_bit_cast(int, x), CTRL, 0xf, 0xf, true));
}
__device__ __forceinline__ float wave_sum(float v) {
  v += dppf<0xB1>(v); v += dppf<0x4E>(v); v += dppf<0x141>(v); v += dppf<0x140>(v);
  const int iv = __builtin_bit_cast(int, v);
  float r = __builtin_bit_cast(float, __builtin_amdgcn_readlane(iv, 0));
  r += __builtin_bit_cast(float, __builtin_amdgcn_readlane(iv, 16));
  r += __builtin_bit_cast(float, __builtin_amdgcn_readlane(iv, 32));
  r += __builtin_bit_cast(float, __builtin_amdgcn_readlane(iv, 48));
  return r;
}
__device__ __forceinline__ float bperm(float v, int srclane) { return __builtin_bit_cast(float, __builtin_amdgcn_ds_bpermute(srclane << 2, __builtin_bit_cast(int, v))); }
__device__ __forceinline__ float sum8(float v) {
  v += dppf<0xB1>(v);
  v += dppf<0x4E>(v);
  v += dppf<0x141>(v);
  return v;
}
__device__ __forceinline__ const float* pin(const Params& p, int i) { asm volatile("" : "+s"(i)); return p.in[i]; }
__device__ __forceinline__ const float* xin_row(const Params& p, int g) {
  return g < NPR ? pin(p, I_XP) + (size_t)g * DM : pin(p, I_XS) + (size_t)(g - NPR) * DM;
}

__device__ __forceinline__ int tidx() { int t = threadIdx.x; asm volatile("" : "+v"(t)); return t; }
__device__ __forceinline__ int bidx() { int b = blockIdx.x; asm volatile("" : "+s"(b)); return b; }
__device__ __forceinline__ int wperm(int n) { const int c = n & 31; return (n & ~31) + ((c >> 2) & 1) * 16 + (c >> 3) * 4 + (c & 3); }

__device__ __forceinline__ void transpose_job(const float* __restrict__ src, int Ks, int Ns, bfr* __restrict__ dst, int ldd, int rot) {
  extern __shared__ __attribute__((aligned(16))) char smem[];
  bfr* T = (bfr*)smem;
  const int tid = tidx();
  const int tn = Ns >> 6, ntile = (Ks >> 6) * tn;
  const int G = gridDim.x;
  for (int tile = (bidx() + rot) % G; tile < ntile; tile += G) {
    const int k0 = (tile / tn) << 6, n0 = (tile % tn) << 6;
    const int kl = tid >> 3, nc = (tid & 7) << 3;
    const float* s = src + (size_t)(k0 + kl) * Ns + n0 + nc;
    const float4 a = *(const float4*)s, b = *(const float4*)(s + 4);
    __syncthreads();
    T[(nc + 0) * 72 + kl] = f2bf(a.x); T[(nc + 1) * 72 + kl] = f2bf(a.y); T[(nc + 2) * 72 + kl] = f2bf(a.z); T[(nc + 3) * 72 + kl] = f2bf(a.w);
    T[(nc + 4) * 72 + kl] = f2bf(b.x); T[(nc + 5) * 72 + kl] = f2bf(b.y); T[(nc + 6) * 72 + kl] = f2bf(b.z); T[(nc + 7) * 72 + kl] = f2bf(b.w);
    __syncthreads();
    const int nl = tid >> 3, kc = (tid & 7) << 3;
    const u32x4 v = *(const u32x4*)(T + nl * 72 + kc);
    *(u32x4*)(dst + (size_t)wperm(n0 + nl) * ldd + k0 + kc) = v;
  }
}

__device__ __forceinline__ void prologue(const Params& p) {
  const int tid = tidx(), wid = tid >> 6, lane = tid & 63;
  const int G = gridDim.x;
  char* ws = p.ws;
  int rot = 0;
  for (int l = 0; l < 4; ++l) {
    transpose_job(pin(p, I_WIN) + (size_t)l * DM * INC, DM, INC, (bfr*)(ws + WS_WTIN) + l * WTIN_L, DM, rot); rot = (rot + G - (1280 % G)) % G;
    transpose_job(pin(p, I_WOUT) + (size_t)l * BRW * DM, BRW, DM, (bfr*)(ws + WS_WTOUT) + (size_t)l * DM * BRW, BRW, rot); rot = (rot + G - (384 % G)) % G;
    transpose_job(pin(p, I_WMEM) + (size_t)l * DM * DM, DM, DM, (bfr*)(ws + WS_WTMEM) + (size_t)l * DM * DM, DM, rot); rot = (rot + G - (256 % G)) % G;
  }
  const int gt = bidx() * 512 + tid, nth = G * 512;
  for (int j = 0; j < 2; ++j) {
    bfr* dst = (bfr*)(ws + WS_WTIN) + (size_t)(2 * j + 1) * WTIN_L + (size_t)5120 * 1024;
    const float* w1 = pin(p, I_W1) + (size_t)j * 1024 * 64;
    const float* a1 = pin(p, I_A1) + (size_t)j * 1024 * 64;
    const float* v1 = pin(p, I_V1);
    for (int it = gt; it < 768 * 128; it += nth) {
      const int n = it % 768, kc = it / 768;
      const int seg = n >> 8, c = n & 255;
      float v[8];
#pragma unroll
      for (int e = 0; e < 8; ++e) {
        const int k = kc * 8 + e;
        float x = 0.f;
        if (seg == 0) { if (c < 64) x = w1[k * 64 + c]; }
        else if (seg == 1) { if (c < 64) x = a1[k * 64 + c]; }
        else { if (j == 1 && c < 32) x = v1[k * 32 + c]; }
        v[e] = x;
      }
      u32x4 o; o.x = cvt_pk(v[0], v[1]); o.y = cvt_pk(v[2], v[3]); o.z = cvt_pk(v[4], v[5]); o.w = cvt_pk(v[6], v[7]);
      *(u32x4*)(dst + (size_t)wperm(n) * 1024 + kc * 8) = o;
    }
    bfr* d2 = (bfr*)(ws + WS_W2T) + (size_t)j * 3072 * 256;
    const float* w2 = pin(p, I_W2) + (size_t)j * 64 * 1024;
    const float* a2 = pin(p, I_A2) + (size_t)j * 64 * 1024;
    const float* v2 = pin(p, I_V2);
    for (int it = gt; it < 3072 * 32; it += nth) {
      const int n = it % 3072, kc = it / 3072;
      const int seg = n >> 10, c = n & 1023;
      float v[8];
#pragma unroll
      for (int e = 0; e < 8; ++e) {
        const int k = kc * 8 + e;
        float x = 0.f;
        if (seg == 0) { if (k < 64) x = w2[k * 1024 + c]; }
        else if (seg == 1) { if (k >= 64 && k < 128) x = a2[(k - 64) * 1024 + c]; }
        else { if (j == 1 && k >= 128 && k < 160) x = v2[(k - 128) * 1024 + c]; }
        v[e] = x;
      }
      u32x4 o; o.x = cvt_pk(v[0], v[1]); o.y = cvt_pk(v[2], v[3]); o.z = cvt_pk(v[4], v[5]); o.w = cvt_pk(v[6], v[7]);
      *(u32x4*)(d2 + (size_t)wperm(n) * 256 + kc * 8) = o;
    }
  }
  const int gw = bidx() * 8 + wid, nw = G * 8;
  for (int row = gw; row < 2048 + NTOK; row += nw) {
    const bool ismem = row < 2048;
    const float* src = ismem ? pin(p, I_MEM) + (size_t)row * DM : xin_row(p, row - 2048);
    float4 x[4]; float ss = 0.f;
#pragma unroll
    for (int i = 0; i < 4; ++i) { x[i] = *(const float4*)(src + lane * 4 + i * 256); ss += x[i].x * x[i].x + x[i].y * x[i].y + x[i].z * x[i].z + x[i].w * x[i].w; }
    ss = wave_sum(ss);
    const float rs = rsqrtf(ss * (1.f / 1024.f) + 1e-6f);
    if (ismem) {
      for (int l = 0; l < 4; ++l) {
        bfr* dst = (bfr*)(ws + WS_MEMN) + ((size_t)l * 2048 + row) * DM;
#pragma unroll
        for (int i = 0; i < 4; ++i) {
          const float4 g = *(const float4*)(pin(p, I_MNG) + l * DM + lane * 4 + i * 256);
          u32x2 o; o.x = cvt_pk(x[i].x * rs * g.x, x[i].y * rs * g.y); o.y = cvt_pk(x[i].z * rs * g.z, x[i].w * rs * g.w);
          *(u32x2*)(dst + lane * 4 + i * 256) = o;
        }
      }
    } else {
      float* xr = (float*)(ws + WS_XRES) + (size_t)(row - 2048) * DM;
#pragma unroll
      for (int i = 0; i < 4; ++i) *(float4*)(xr + lane * 4 + i * 256) = x[i];
      bfr* dst = (bfr*)(ws + WS_HA) + (size_t)(row - 2048) * DM;
#pragma unroll
      for (int i = 0; i < 4; ++i) {
        const float4 g = *(const float4*)(pin(p, I_NG) + lane * 4 + i * 256);
        u32x2 o; o.x = cvt_pk(x[i].x * rs * g.x, x[i].y * rs * g.y); o.y = cvt_pk(x[i].z * rs * g.z, x[i].w * rs * g.w);
        *(u32x2*)(dst + lane * 4 + i * 256) = o;
      }
    }
  }
}

__device__ __forceinline__ void load_xrow(const Params& p, const int g, const int lane, float4 (&x)[4]) {
  const float* s = (const float*)(p.ws + WS_XRES) + (size_t)g * DM;
#pragma unroll
  for (int i = 0; i < 4; ++i) x[i] = *(const float4*)(s + lane * 4 + i * 256);
  if (g >= NPR) {
#pragma unroll
    for (int k = 0; k < 5; ++k) {
      const float* q = (const float*)(p.ws + WS_PART) + ((size_t)k * 1024 + (g - NPR)) * DM;
#pragma unroll
      for (int i = 0; i < 4; ++i) { const float4 t = *(const float4*)(q + lane * 4 + i * 256); x[i].x += t.x; x[i].y += t.y; x[i].z += t.z; x[i].w += t.w; }
    }
  }
}
__device__ __forceinline__ void prep_phase(const Params& p, int l) {
  const int tid = tidx(), wid = tid >> 6, lane = tid & 63;
  const bool rw = (l & 1);
  const int j = l >> 1;
  const float* xres = (const float*)(p.ws + WS_XRES);
  bfr* hA = (bfr*)(p.ws + WS_HA);
  const float* ng = pin(p, I_NG) + l * DM;
  const float* mu = pin(p, I_MU) + (size_t)j * 5 * DM;
  const int gw = bidx() * 8 + wid, nw = gridDim.x * 8;
  for (int task = gw; task < NPR / 4 + 128; task += nw) {
    const int g0 = task < NPR / 4 ? task * 4 : NPR + (task - NPR / 4) * 8;
    const int nrows = task < NPR / 4 ? 4 : 8;
    float hp[16];
    if (rw) {
      const bool smp = g0 >= NPR;
      const int t0 = smp ? ((g0 - NPR) & 7) : (g0 & 2047);
      if (t0 == 0) {
        if (smp) {
          const float* s = pin(p, I_SS) + ((size_t)j * 128 + ((g0 - NPR) >> 3)) * DM;
#pragma unroll
          for (int i = 0; i < 4; ++i) { const float4 v = *(const float4*)(s + lane * 4 + i * 256); hp[i * 4] = v.x; hp[i * 4 + 1] = v.y; hp[i * 4 + 2] = v.z; hp[i * 4 + 3] = v.w; }
        } else {
#pragma unroll
          for (int i = 0; i < 16; ++i) hp[i] = 0.f;
        }
      } else {
        float4 x[4]; float ss = 0.f;
        load_xrow(p, g0 - 1, lane, x);
#pragma unroll
        for (int i = 0; i < 4; ++i) ss += x[i].x * x[i].x + x[i].y * x[i].y + x[i].z * x[i].z + x[i].w * x[i].w;
        ss = wave_sum(ss);
        const float rs = rsqrtf(ss * (1.f / 1024.f) + 1e-6f);
#pragma unroll
        for (int i = 0; i < 4; ++i) {
          const float4 g = *(const float4*)(ng + lane * 4 + i * 256);
          hp[i * 4] = x[i].x * rs * g.x; hp[i * 4 + 1] = x[i].y * rs * g.y; hp[i * 4 + 2] = x[i].z * rs * g.z; hp[i * 4 + 3] = x[i].w * rs * g.w;
        }
      }
    }
    for (int r = 0; r < nrows; ++r) {
      const int g = g0 + r;
      float4 x[4]; float ss = 0.f;
      load_xrow(p, g, lane, x);
      if (g >= NPR) {
        float* xw = (float*)(p.ws + WS_XRES) + (size_t)g * DM;
#pragma unroll
        for (int i = 0; i < 4; ++i) *(float4*)(xw + lane * 4 + i * 256) = x[i];
      }
#pragma unroll
      for (int i = 0; i < 4; ++i) ss += x[i].x * x[i].x + x[i].y * x[i].y + x[i].z * x[i].z + x[i].w * x[i].w;
      ss = wave_sum(ss);
      const float rs = rsqrtf(ss * (1.f / 1024.f) + 1e-6f);
      float h[16];
#pragma unroll
      for (int i = 0; i < 4; ++i) {
        const float4 gg = *(const float4*)(ng + lane * 4 + i * 256);
        h[i * 4] = x[i].x * rs * gg.x; h[i * 4 + 1] = x[i].y * rs * gg.y; h[i * 4 + 2] = x[i].z * rs * gg.z; h[i * 4 + 3] = x[i].w * rs * gg.w;
        u32x2 o; o.x = cvt_pk(h[i * 4], h[i * 4 + 1]); o.y = cvt_pk(h[i * 4 + 2], h[i * 4 + 3]);
        *(u32x2*)(hA + (size_t)g * DM + lane * 4 + i * 256) = o;
      }
      if (rw) {
#pragma unroll
        for (int m = 0; m < 5; ++m) {
          bfr* dst = hA + (size_t)(1 + m) * HA_SZ + (size_t)g * DM;
#pragma unroll
          for (int i = 0; i < 4; ++i) {
            const float4 mm = *(const float4*)(mu + m * DM + lane * 4 + i * 256);
            const float a0 = h[i * 4] + (hp[i * 4] - h[i * 4]) * mm.x, a1 = h[i * 4 + 1] + (hp[i * 4 + 1] - h[i * 4 + 1]) * mm.y;
            const float a2 = h[i * 4 + 2] + (hp[i * 4 + 2] - h[i * 4 + 2]) * mm.z, a3 = h[i * 4 + 3] + (hp[i * 4 + 3] - h[i * 4 + 3]) * mm.w;
            u32x2 o; o.x = cvt_pk(a0, a1); o.y = cvt_pk(a2, a3);
            *(u32x2*)(dst + lane * 4 + i * 256) = o;
          }
        }
        const bool smp = g >= NPR;
        const int t = smp ? ((g - NPR) & 7) : (g & 2047);
        if (t == (smp ? 7 : 2047)) {
          float* o = p.out + (smp ? O_SSS + ((size_t)j * 128 + ((g - NPR) >> 3)) * DM : O_SSP + ((size_t)j * 8 + (g >> 11)) * DM);
#pragma unroll
          for (int i = 0; i < 4; ++i) *(float4*)(o + lane * 4 + i * 256) = make_float4(h[i * 4], h[i * 4 + 1], h[i * 4 + 2], h[i * 4 + 3]);
        }
#pragma unroll
        for (int i = 0; i < 16; ++i) hp[i] = h[i];
      }
    }
  }
}

__device__ __forceinline__ void final_phase(const Params& p) {
  const int tid = tidx(), wid = tid >> 6, lane = tid & 63;
  const float* xres = (const float*)(p.ws + WS_XRES);
  const float* fg = pin(p, I_FG);
  const int gw = bidx() * 8 + wid, nw = gridDim.x * 8;
  for (int g = gw; g < NTOK; g += nw) {
    float4 x[4]; float ss = 0.f;
    load_xrow(p, g, lane, x);
#pragma unroll
    for (int i = 0; i < 4; ++i) ss += x[i].x * x[i].x + x[i].y * x[i].y + x[i].z * x[i].z + x[i].w * x[i].w;
    ss = wave_sum(ss);
    const float rs = rsqrtf(ss * (1.f / 1024.f) + 1e-6f);
    float* o = p.out + O_YP + (size_t)g * DM;
#pragma unroll
    for (int i = 0; i < 4; ++i) {
      const float4 gg = *(const float4*)(fg + lane * 4 + i * 256);
      *(float4*)(o + lane * 4 + i * 256) = make_float4(x[i].x * rs * gg.x, x[i].y * rs * gg.y, x[i].z * rs * gg.z, x[i].w * rs * gg.w);
    }
  }
}

constexpr int BM = 256, BK = 64, HALF = 128, HT = HALF * BK;
__device__ __forceinline__ int lds_byte(int r, int c) {
  int st = (r >> 4) * 2 + (c >> 5), rr = r & 15, cc = c & 31, ob = rr * 64 + cc * 2;
  return st * 1024 + (ob ^ (((ob >> 9) & 1) << 5));
}
__device__ __forceinline__ void stage_rc(int b, int& R, int& C) {
  int st = b / 1024, sb = b % 1024, swz = sb ^ (((sb >> 9) & 1) << 5);
  R = (st >> 1) * 16 + swz / 64; C = (st & 1) * 32 + (swz % 64) / 2;
}

enum { EM_PROJ = 0, EM_G1R, EM_MEM, EM_LUP, EM_OUT, EM_OUTA };

__device__ __forceinline__ void epilogue(const Params& p, const int mode, const int l, const f32x4 (&acc)[2][2][4][2],
                                         const int pm, const int pn, const int wr, const int wc, const int fr, const int fq) {
  const int j = (l & 255) >> 1;
#pragma unroll
  for (int ai = 0; ai < 2; ++ai)
#pragma unroll
    for (int m = 0; m < 4; ++m) {
      const int row = pm * BM + ai * HALF + wr * 64 + m * 16 + fr;
#pragma unroll
      for (int bj = 0; bj < 2; ++bj)
#pragma unroll
        for (int n = 0; n < 2; ++n) {
          const int col = pn * BM + bj * HALF + wc * 32 + fq * 8 + n * 4;
          const f32x4 v = acc[ai][bj][m][n];
          if (mode == EM_PROJ || (mode == EM_G1R && pn < 20)) {
            if (n == 0) {
              const f32x4 v1 = acc[ai][bj][m][1];
              u32x4 o; o.x = cvt_pk(v[0], v[1]); o.y = cvt_pk(v[2], v[3]); o.z = cvt_pk(v1[0], v1[1]); o.w = cvt_pk(v1[2], v1[3]);
              *(u32x4*)((bfr*)(p.ws + WS_PROJ) + (size_t)row * INC + col) = o;
            }
          } else if (mode == EM_G1R) {
            bfr* al = (bfr*)(p.ws + WS_ALORA) + (size_t)row * 256;
            const int c = col & 255;
            if (pn == 20) {
              if (c < 64) {
                float t[4];
#pragma unroll
                for (int e = 0; e < 4; ++e) { const float ex = __expf(2.f * v[e]); t[e] = 1.f - 2.f * frcp(ex + 1.f); }
                u32x2 o; o.x = cvt_pk(t[0], t[1]); o.y = cvt_pk(t[2], t[3]);
                *(u32x2*)(al + c) = o;
              }
            } else if (pn == 21) {
              const int lim = (l == 3) ? 128 : 256;
              if (64 + c < lim) {
                u32x2 o; o.x = 0u; o.y = 0u;
                if (c < 64) { o.x = cvt_pk(v[0], v[1]); o.y = cvt_pk(v[2], v[3]); }
                *(u32x2*)(al + 64 + c) = o;
              }
            } else {
              if (128 + c < 256) {
                u32x2 o; o.x = 0u; o.y = 0u;
                if (c < 32) { o.x = cvt_pk(v[0], v[1]); o.y = cvt_pk(v[2], v[3]); }
                *(u32x2*)(al + 128 + c) = o;
              }
            }
          } else if (mode == EM_MEM) {
            const int lm = pm >> 3, r2 = row & 2047;
            float* o = p.out + (col < 512 ? O_MK : O_MV) + ((size_t)lm * 2048 + r2) * 512 + (col & 511);
            *(f32x4*)o = v;
          } else if (mode == EM_LUP) {
            const int seg = col >> 10, c = col & 1023;
            float t[4];
            if (seg == 0) {
              const float4 b = *(const float4*)(pin(p, I_W0) + j * DM + c);
              const float bb[4] = {b.x, b.y, b.z, b.w};
#pragma unroll
              for (int e = 0; e < 4; ++e) {
                const float x = bb[e] + v[e];
                const float sp = fmaxf(-x, 0.f) + __logf(1.f + __expf(-fabsf(x)));
                t[e] = -__expf(-sp - 0.5f);
              }
            } else if (seg == 1) {
              const float4 b = *(const float4*)(pin(p, I_A0) + j * DM + c);
              t[0] = sigmoidf_(b.x + v[0]); t[1] = sigmoidf_(b.y + v[1]); t[2] = sigmoidf_(b.z + v[2]); t[3] = sigmoidf_(b.w + v[3]);
            } else {
              const float4 b = *(const float4*)(pin(p, I_V0) + c);
              t[0] = sigmoidf_(b.x + v[0]); t[1] = sigmoidf_(b.y + v[1]); t[2] = sigmoidf_(b.z + v[2]); t[3] = sigmoidf_(b.w + v[3]);
            }
            u32x2 o; o.x = cvt_pk(t[0], t[1]); o.y = cvt_pk(t[2], t[3]);
            *(u32x2*)((bfr*)(p.ws + WS_LUP) + (size_t)row * 3072 + col) = o;
          } else if (mode == EM_OUT) {
            float* xo = (float*)(p.ws + WS_XRES) + (size_t)row * DM + col;
            const f32x4 x = *(const f32x4*)xo;
            *(f32x4*)xo = x + v;
          } else {
            *(f32x4*)((float*)(p.ws + WS_PART) + ((size_t)((l >> 8) - 1) * 1024 + (row - NPR)) * DM + col) = v;
          }
        }
    }
}

__device__ __forceinline__ void gemm_unit(const Params& p, const bfr* __restrict__ A, const bfr* __restrict__ Bt, const int K, const int kt0, const int nt,
                                          const int pm, const int pn, const int mode, const int l) {
  extern __shared__ __attribute__((aligned(16))) char smem[];
  bfr* shm = (bfr*)smem;
#define SA(b, h) (shm + ((b) * 2 + (h)) * HT)
#define SB(b, h) (shm + (4 + (b) * 2 + (h)) * HT)
#define STAGE(P, BASE, br, kt) do { const bfr* _g = (BASE) + (size_t)(br) * K + (kt0 + (kt)) * BK + goff; \
    __builtin_amdgcn_global_load_lds((const unsigned*)_g, (unsigned*)((char*)(P) + tid * 16), 16, 0, 0); \
    __builtin_amdgcn_global_load_lds((const unsigned*)(_g + (size_t)64 * K), (unsigned*)((char*)(P) + tid * 16 + 8192), 16, 0, 0); } while (0)
#define LDA(dst, b, h) for (int m = 0; m < 4; ++m) for (int k = 0; k < 2; ++k) \
    dst[m][k] = *reinterpret_cast<const bf16x8*>((char*)SA(b, h) + lds_byte(wr * 64 + m * 16 + fr, k * 32 + fq * 8))
#define LDB(dst, b, h) for (int n = 0; n < 2; ++n) for (int k = 0; k < 2; ++k) \
    dst[n][k] = *reinterpret_cast<const bf16x8*>((char*)SB(b, h) + lds_byte(wc * 32 + n * 16 + fr, k * 32 + fq * 8))
#define MMA(ai, bj, At, Bt_) do { __builtin_amdgcn_s_setprio(1); \
    for (int m = 0; m < 4; ++m) for (int n = 0; n < 2; ++n) for (int k = 0; k < 2; ++k) \
      acc[ai][bj][m][n] = __builtin_amdgcn_mfma_f32_16x16x32_bf16(Bt_[n][k], At[m][k], acc[ai][bj][m][n], 0, 0, 0); \
    __builtin_amdgcn_s_setprio(0); } while (0)
#define WAIT_V(n) asm volatile("s_waitcnt vmcnt(" #n ")" ::: "memory")
#define WAIT_L(n) asm volatile("s_waitcnt lgkmcnt(" #n ")" ::: "memory")
#define BAR __builtin_amdgcn_s_barrier()
#define SCHED __builtin_amdgcn_sched_barrier(0)
  const int tid = tidx();
  const int brow = pm * BM, bcol = pn * BM;
  const int wid = tid >> 6, lane = tid & 63, wr = wid >> 2, wc = wid & 3, fr = lane & 15, fq = lane >> 4;
  int R0, C0; stage_rc(tid * 16, R0, C0);
  const int goff = R0 * K + C0;
  f32x4 acc[2][2][4][2] = {};
  bf16x8 At[4][2], B0[2][2], B1[2][2];
  STAGE(SB(0, 0), Bt, bcol, 0); STAGE(SA(0, 0), A, brow, 0);
  STAGE(SB(0, 1), Bt, bcol + HALF, 0); STAGE(SA(0, 1), A, brow + HALF, 0);
  if (wr == 1) BAR;
  WAIT_V(4); BAR;
  STAGE(SB(1, 0), Bt, bcol, 1); STAGE(SA(1, 0), A, brow, 1); STAGE(SB(1, 1), Bt, bcol + HALF, 1);
  WAIT_V(6); BAR;
  for (int t = 0; t < nt - 2; t += 2) {
    LDB(B0, 0, 0); SCHED; LDA(At, 0, 0); STAGE(SA(1, 1), A, brow + HALF, t + 1);
    WAIT_L(8); BAR; WAIT_L(0); MMA(0, 0, At, B0); BAR; SCHED;
    LDB(B1, 0, 1); STAGE(SB(0, 0), Bt, bcol, t + 2);
    BAR; WAIT_L(0); MMA(0, 1, At, B1); BAR;
    LDA(At, 0, 1); STAGE(SA(0, 0), A, brow, t + 2);
    BAR; WAIT_L(0); MMA(1, 0, At, B0); BAR; SCHED;
    STAGE(SB(0, 1), Bt, bcol + HALF, t + 2);
    WAIT_V(6); BAR; MMA(1, 1, At, B1); BAR;
    LDB(B0, 1, 0); SCHED; LDA(At, 1, 0); STAGE(SA(0, 1), A, brow + HALF, t + 2);
    WAIT_L(8); BAR; WAIT_L(0); MMA(0, 0, At, B0); BAR; SCHED;
    LDB(B1, 1, 1); STAGE(SB(1, 0), Bt, bcol, t + 3);
    BAR; WAIT_L(0); MMA(0, 1, At, B1); BAR;
    LDA(At, 1, 1); STAGE(SA(1, 0), A, brow, t + 3);
    BAR; WAIT_L(0); MMA(1, 0, At, B0); BAR; SCHED;
    STAGE(SB(1, 1), Bt, bcol + HALF, t + 3);
    WAIT_V(6); BAR; MMA(1, 1, At, B1); BAR;
  }
  { LDB(B0, 0, 0); LDA(At, 0, 0); STAGE(SA(1, 1), A, brow + HALF, nt - 1);
    BAR; WAIT_L(0); MMA(0, 0, At, B0); BAR;
    LDB(B1, 0, 1); BAR; WAIT_L(0); MMA(0, 1, At, B1); BAR;
    LDA(At, 0, 1); WAIT_V(4); BAR; WAIT_L(0); MMA(1, 0, At, B0); MMA(1, 1, At, B1); BAR; }
  { LDB(B0, 1, 0); LDA(At, 1, 0); WAIT_V(2); BAR; WAIT_L(0); MMA(0, 0, At, B0); BAR;
    LDB(B1, 1, 1); WAIT_V(0); BAR; WAIT_L(0); MMA(0, 1, At, B1); BAR;
    LDA(At, 1, 1); BAR; WAIT_L(0); MMA(1, 0, At, B0); MMA(1, 1, At, B1); BAR; }
  if (wr == 0) BAR;
  epilogue(p, mode, l, acc, pm, pn, wr, wc, fr, fq);
  WAIT_V(0);
#undef SA
#undef SB
}

__device__ __forceinline__ bool unit_order(int i, int c, int G, int nM, int nN, int& pm, int& pn) {
  const int nwg = nM * nN;
  const long L = (long)i * G + c; if (L >= nwg) return false;
  int wgid = (int)L; { const int q = nwg / 8, r = nwg % 8, xcd = wgid % 8, off = wgid / 8; wgid = (xcd < r ? xcd * (q + 1) : r * (q + 1) + (xcd - r) * q) + off; }
  const int nig = 8 * nN, gid = wgid / nig, fm = gid * 8, gsz = (nM - fm) < 8 ? (nM - fm) : 8;
  pm = fm + ((wgid % nig) % gsz); pn = (wgid % nig) / gsz; return true;
}

__device__ __forceinline__ void gemm_phase(const Params& p, const int kind, const int l) {
  const int G = gridDim.x;
  const int j = l >> 1;
  const bool rw = l & 1;
  char* ws = p.ws;
  const bfr* hA = (const bfr*)(ws + WS_HA);
  int nM = NTOK / BM, nN, K, mode;
  const bfr* Bt;
  if (kind == 0) { nN = rw ? (l == 3 ? 23 : 22) : 20; K = 1024; mode = rw ? EM_G1R : EM_PROJ; Bt = (const bfr*)(ws + WS_WTIN) + l * WTIN_L; }
  else if (kind == 1) { nN = (l == 3) ? 12 : 8; K = 256; mode = EM_LUP; Bt = (const bfr*)(ws + WS_W2T) + (size_t)j * 3072 * 256; }
  else { nN = 4; K = 1536; mode = EM_OUT; Bt = (const bfr*)(ws + WS_WTOUT) + (size_t)l * DM * BRW; }
  int pm, pn;
  const int nwg1 = nM * nN;
  const bool withmem = (kind == 0 && l == 0);
  const int c2 = (bidx() + G - (nwg1 % G)) % G;
  int seg = 0, i = 0;
  for (;;) {
    const bfr* A; const bfr* B = Bt; int KK = K, md = mode, kt0 = 0, nt = K / BK, lk = l;
    if (kind == 2) {
      const int t = bidx() + G * i;
      if (t >= 256 + 96) break;
      ++i;
      A = (const bfr*)(ws + WS_BRANCH);
      if (t < 256) { pm = (t & 7) * 8 + (t >> 5); pn = (t >> 3) & 3; }
      else { const int v = t - 256, rem = v % 24, ks = rem % 6; pm = 64 + v / 24; pn = rem / 6; kt0 = ks * 4; nt = 4; if (ks) { md = EM_OUTA; lk = l | (ks << 8); } }
    } else {
      bool ok;
      if (seg == 0) ok = unit_order(i, bidx(), G, nM, nN, pm, pn);
      else ok = unit_order(i, c2, G, 32, 4, pm, pn);
      if (!ok) { if (seg == 0 && withmem) { seg = 1; i = 0; continue; } break; }
      ++i;
      if (seg == 1) { A = (const bfr*)(ws + WS_MEMN); B = (const bfr*)(ws + WS_WTMEM) + (size_t)(pm >> 3) * DM * DM; KK = 1024; nt = 16; md = EM_MEM; }
      else if (kind == 0) {
        int sel = 0;
        if (rw) sel = pn < 4 ? 1 : pn < 8 ? 3 : pn < 12 ? 4 : pn < 20 ? 0 : pn == 20 ? 2 : pn == 21 ? 5 : 4;
        A = hA + (size_t)sel * HA_SZ;
      } else A = (const bfr*)(ws + WS_ALORA);
    }
    gemm_unit(p, A, B, KK, kt0, nt, pm, pn, md, lk);
  }
}

__device__ __forceinline__ void xattn_unit(const Params& p, const float* __restrict__ kb, const float* __restrict__ vb, const int g0, const int ntok, const int head) {
  extern __shared__ __attribute__((aligned(16))) char smem[];
  bfr* Ks = (bfr*)smem;
  bfr* Vt = Ks + 256 * 136;
  const int tid = tidx(), wid = tid >> 6, lane = tid & 63, fr = lane & 15, fq = lane >> 4;
#pragma unroll 4
  for (int i = 0; i < 16; ++i) {
    const int idx = tid + i * 512, row = idx >> 5, c4 = (idx & 31) << 2;
    const float4 v = *(const float4*)(kb + (size_t)row * 512 + c4);
    u32x2 o; o.x = cvt_pk(v.x, v.y); o.y = cvt_pk(v.z, v.w);
    *(u32x2*)(Ks + row * 136 + c4) = o;
  }
  {
    const int pp = lane & 7, dd = lane >> 3;
#pragma unroll 4
    for (int it = 0; it < 8; ++it) {
      const int wq = it * 8 + wid, mb = wq & 15, db = wq >> 4;
      const int m0 = mb * 16 + 2 * pp, d0 = db * 32 + dd * 4;
      const float4 a = *(const float4*)(vb + (size_t)m0 * 512 + d0);
      const float4 b = *(const float4*)(vb + (size_t)(m0 + 1) * 512 + d0);
      *(unsigned*)(Vt + (d0 + 0) * 260 + m0) = cvt_pk(a.x, b.x);
      *(unsigned*)(Vt + (d0 + 1) * 260 + m0) = cvt_pk(a.y, b.y);
      *(unsigned*)(Vt + (d0 + 2) * 260 + m0) = cvt_pk(a.z, b.z);
      *(unsigned*)(Vt + (d0 + 3) * 260 + m0) = cvt_pk(a.w, b.w);
    }
  }
  __syncthreads();
  if (wid * 16 < ntok) {
    const bfr* proj = (const bfr*)(p.ws + WS_PROJ);
    int tl = wid * 16 + fr; if (tl > ntok - 1) tl = ntok - 1;
    const bfr* qrow = proj + (size_t)(g0 + tl) * INC + 3072 + head * 128;
    bf16x8 qf[4];
#pragma unroll
    for (int ks = 0; ks < 4; ++ks) qf[ks] = *(const bf16x8*)(qrow + ks * 32 + fq * 8);
    f32x4 sc[16];
#pragma unroll
    for (int mt = 0; mt < 16; ++mt) {
      f32x4 a = {0.f, 0.f, 0.f, 0.f};
#pragma unroll
      for (int ks = 0; ks < 4; ++ks) {
        const bf16x8 kf = *(const bf16x8*)(Ks + (mt * 16 + fr) * 136 + ks * 32 + fq * 8);
        a = __builtin_amdgcn_mfma_f32_16x16x32_bf16(kf, qf[ks], a, 0, 0, 0);
      }
      sc[mt] = a;
    }
    float mx = -3.0e38f;
#pragma unroll
    for (int mt = 0; mt < 16; ++mt) mx = fmaxf(mx, fmaxf(fmaxf(sc[mt][0], sc[mt][1]), fmaxf(sc[mt][2], sc[mt][3])));
    mx = fmaxf(mx, bperm(mx, lane ^ 16)); mx = fmaxf(mx, bperm(mx, lane ^ 32));
    const float cs = 0.08838834764831845f * 1.4426950408889634f;
    float sum = 0.f;
#pragma unroll
    for (int mt = 0; mt < 16; ++mt)
#pragma unroll
      for (int e = 0; e < 4; ++e) { const float pe = exp2f((sc[mt][e] - mx) * cs); sc[mt][e] = pe; sum += pe; }
    sum += bperm(sum, lane ^ 16); sum += bperm(sum, lane ^ 32);
    const float inv = frcp(sum);
    bf16x8 pf[8];
#pragma unroll
    for (int u = 0; u < 8; ++u) {
      u32x4 w; w.x = cvt_pk(sc[2 * u][0], sc[2 * u][1]); w.y = cvt_pk(sc[2 * u][2], sc[2 * u][3]);
      w.z = cvt_pk(sc[2 * u + 1][0], sc[2 * u + 1][1]); w.w = cvt_pk(sc[2 * u + 1][2], sc[2 * u + 1][3]);
      pf[u] = __builtin_bit_cast(bf16x8, w);
    }
    const bool tvalid = (wid * 16 + fr) < ntok;
    const int g = g0 + tl;
    const bfr* gate = proj + (size_t)g * INC + 3584 + 1024 + head * 128;
    bfr* br = (bfr*)(p.ws + WS_BRANCH) + (size_t)g * BRW + 1024 + head * 128;
#pragma unroll
    for (int dt = 0; dt < 8; ++dt) {
      f32x4 a = {0.f, 0.f, 0.f, 0.f};
#pragma unroll
      for (int u = 0; u < 8; ++u) {
        const bfr* vr = Vt + (dt * 16 + fr) * 260 + fq * 4;
        u32x4 w;
        const u32x2 lo = *(const u32x2*)(vr + (2 * u) * 16), hi = *(const u32x2*)(vr + (2 * u + 1) * 16);
        w.x = lo.x; w.y = lo.y; w.z = hi.x; w.w = hi.y;
        a = __builtin_amdgcn_mfma_f32_16x16x32_bf16(__builtin_bit_cast(bf16x8, w), pf[u], a, 0, 0, 0);
      }
      if (tvalid) {
        const u32x2 gw = *(const u32x2*)(gate + dt * 16 + fq * 4);
        const float g0f = bflo(gw.x), g1f = bfhi(gw.x), g2f = bflo(gw.y), g3f = bfhi(gw.y);
        u32x2 o;
        o.x = cvt_pk(a[0] * inv * g0f * sigmoidf_(g0f), a[1] * inv * g1f * sigmoidf_(g1f));
        o.y = cvt_pk(a[2] * inv * g2f * sigmoidf_(g2f), a[3] * inv * g3f * sigmoidf_(g3f));
        *(u32x2*)(br + dt * 16 + fq * 4) = o;
      }
    }
  }
  __syncthreads();
}

struct HgRaw { u32x2 q, f, v, g; };
__device__ __forceinline__ void hg_load(HgRaw& r, const bfr* __restrict__ proj, const int g0, const int T, const int sbi, const int h,
                                        const int wid, const int fr, const int fq, const int tid) {
  const int t0 = sbi * 16;
  if (t0 + fr < T) {
    const bfr* pr = proj + (size_t)(g0 + t0 + fr) * INC + h * 128 + wid * 16 + fq * 4;
    r.q = *(const u32x2*)pr; r.f = *(const u32x2*)(pr + 1024); r.g = *(const u32x2*)(pr + 3584);
  }
  const int vt = tid >> 5, dv4 = (tid & 31) << 2;
  if (t0 + vt < T) r.v = *(const u32x2*)(proj + (size_t)(g0 + t0 + vt) * INC + 2048 + h * 128 + dv4);
}
constexpr int HG_SET = 16 * 136 * 2 + 128 * 16 * 2;

__device__ __forceinline__ void hgrn_unit(const Params& p, const int l, const bool smp, const int b, const int h) {
  extern __shared__ __attribute__((aligned(16))) char smem[];
  bfr* lds0 = (bfr*)smem;
  float* decb = (float*)(lds0 + 2 * HG_SET);
  float* redb = decb + 256;
  const int tid = tidx(), wid = tid >> 6, lane = tid & 63, fr = lane & 15, fq = lane >> 4;
  const int j = l >> 1;
  const bfr* proj = (const bfr*)(p.ws + WS_PROJ);
  bfr* branch = (bfr*)(p.ws + WS_BRANCH);
  const int g0 = smp ? NPR + b * 8 : b * 2048;
  const int T = smp ? 8 : 2048;
  const int nsub = (T + 15) >> 4;
  f32x4 S[8];
  if (smp) {
    const float* s0 = pin(p, I_SH) + (((size_t)j * 128 + b) * 8 + h) * 16384;
#pragma unroll
    for (int kt = 0; kt < 8; ++kt)
#pragma unroll
      for (int e = 0; e < 4; ++e) S[kt][e] = s0[(kt * 16 + fq * 4 + e) * 128 + wid * 16 + fr];
  } else {
#pragma unroll
    for (int kt = 0; kt < 8; ++kt) S[kt] = (f32x4){0.f, 0.f, 0.f, 0.f};
  }
  const int dkp = wid * 16 + fq * 4;
  float lb[4];
#pragma unroll
  for (int e = 0; e < 4; ++e) {
    if (j == 0) lb[e] = 0.f;
    else { const int c = h * 128 + dkp + e; lb[e] = sigmoidf_(pin(p, I_LB)[1024 + c] - pin(p, I_LB)[c]); }
  }
  float og[4];
#pragma unroll
  for (int e = 0; e < 4; ++e) og[e] = pin(p, I_ONG)[j * 128 + wid * 16 + fq * 4 + e];

  HgRaw raw[4];
#pragma unroll
  for (int u = 0; u < 4; ++u) { raw[u].q = raw[u].f = raw[u].v = raw[u].g = (u32x2){0u, 0u}; hg_load(raw[u], proj, g0, T, u, h, wid, fr, fq, tid); }
  u32x2 gsave[2] = {(u32x2){0u, 0u}, (u32x2){0u, 0u}};
  f32x4 oprev = {0.f, 0.f, 0.f, 0.f};

  for (int i4 = 0; i4 < nsub; i4 += 4) {
#pragma unroll
    for (int u = 0; u < 4; ++u) {
      const int i = i4 + u;
      if (i < nsub) {
        const int s = u & 1;
        bfr* Qs = lds0 + s * HG_SET; bfr* Kh = Qs + 16 * 136; bfr* Kt = Kh + 16 * 136; bfr* Vt = Kt + 128 * 16;
        float* dec = decb + s * 128; float* red = redb + s * 128;
        {
          const int sb = i * 16;
          const bool valid = (sb + fr) < T;
          float q[4], P[4], kv[4];
          const float qz[4] = {bflo(raw[u].q.x), bfhi(raw[u].q.x), bflo(raw[u].q.y), bfhi(raw[u].q.y)};
          const float fz[4] = {bflo(raw[u].f.x), bfhi(raw[u].f.x), bflo(raw[u].f.y), bfhi(raw[u].f.y)};
#pragma unroll
          for (int e = 0; e < 4; ++e) {
            const float sg = sigmoidf_(fz[e]);
            const float f = fmaxf(lb[e] + (1.f - lb[e]) * sg, 1e-30f);
            P[e] = valid ? f : 1.f;
            kv[e] = valid ? (1.f - lb[e]) * (1.f - sg) : 0.f;
            q[e] = valid ? qz[e] * sigmoidf_(qz[e]) : 0.f;
          }
#pragma unroll
          for (int e = 0; e < 4; ++e) {
            P[e] *= __builtin_bit_cast(float, __builtin_amdgcn_update_dpp(0x3f800000, __builtin_bit_cast(int, P[e]), 0x111, 0xf, 0xf, false));
            P[e] *= __builtin_bit_cast(float, __builtin_amdgcn_update_dpp(0x3f800000, __builtin_bit_cast(int, P[e]), 0x112, 0xf, 0xf, false));
            P[e] *= __builtin_bit_cast(float, __builtin_amdgcn_update_dpp(0x3f800000, __builtin_bit_cast(int, P[e]), 0x114, 0xf, 0xf, false));
            P[e] *= __builtin_bit_cast(float, __builtin_amdgcn_update_dpp(0x3f800000, __builtin_bit_cast(int, P[e]), 0x118, 0xf, 0xf, false));
          }
          float qt[4], kh[4], kt[4];
#pragma unroll
          for (int e = 0; e < 4; ++e) {
            const float Pl = bperm(P[e], lane | 15);
            const float inv = frcp(fmaxf(P[e], 1e-30f));
            qt[e] = q[e] * P[e]; kh[e] = kv[e] * inv; kt[e] = kh[e] * Pl;
          }
          if (fr == 15) *(f32x4*)(dec + dkp) = (f32x4){P[0], P[1], P[2], P[3]};
          const int kpos = (wid >> 1) * 32 + fq * 8 + (wid & 1) * 4;
          u32x2 o; o.x = cvt_pk(qt[0], qt[1]); o.y = cvt_pk(qt[2], qt[3]);
          *(u32x2*)(Qs + fr * 136 + kpos) = o;
          o.x = cvt_pk(kh[0], kh[1]); o.y = cvt_pk(kh[2], kh[3]);
          *(u32x2*)(Kh + fr * 136 + kpos) = o;
          { const unsigned k01 = cvt_pk(kt[0], kt[1]), k23 = cvt_pk(kt[2], kt[3]);
            Kt[(dkp + 0) * 16 + fr] = (bfr)(k01 & 0xffff); Kt[(dkp + 1) * 16 + fr] = (bfr)(k01 >> 16);
            Kt[(dkp + 2) * 16 + fr] = (bfr)(k23 & 0xffff); Kt[(dkp + 3) * 16 + fr] = (bfr)(k23 >> 16); }
          const int vt = tid >> 5, dv4 = (tid & 31) << 2;
          const bool vv = (sb + vt) < T;
          const unsigned vx = vv ? raw[u].v.x : 0u, vy = vv ? raw[u].v.y : 0u;
          Vt[(dv4 + 0) * 16 + vt] = (bfr)(vx & 0xffff); Vt[(dv4 + 1) * 16 + vt] = (bfr)(vx >> 16);
          Vt[(dv4 + 2) * 16 + vt] = (bfr)(vy & 0xffff); Vt[(dv4 + 3) * 16 + vt] = (bfr)(vy >> 16);
          gsave[s] = raw[u].g;
          hg_load(raw[u], proj, g0, T, i + 4, h, wid, fr, fq, tid);
        }
        __syncthreads();
        if (i > 0) {
          const float* redp = redb + (s ^ 1) * 128;
          float tot = 0.f;
#pragma unroll
          for (int w = 0; w < 8; ++w) tot += redp[fr * 8 + w];
          const float rs = rsqrtf(tot * (1.f / 128.f) + 1e-6f);
          const int tk = (i - 1) * 16 + fr;
          if (tk < T) {
            const u32x2 gw = gsave[s ^ 1];
            const float gg[4] = {bflo(gw.x), bfhi(gw.x), bflo(gw.y), bfhi(gw.y)};
            float r[4];
#pragma unroll
            for (int e = 0; e < 4; ++e) r[e] = oprev[e] * rs * og[e] * gg[e] * sigmoidf_(gg[e]);
            u32x2 o; o.x = cvt_pk(r[0], r[1]); o.y = cvt_pk(r[2], r[3]);
            *(u32x2*)(branch + (size_t)(g0 + tk) * BRW + h * 128 + wid * 16 + fq * 4) = o;
          }
        }
        {
          bf16x8 qp[4], kp[4];
#pragma unroll
          for (int uu = 0; uu < 4; ++uu) {
            qp[uu] = *(const bf16x8*)(Qs + fr * 136 + uu * 32 + fq * 8);
            kp[uu] = *(const bf16x8*)(Kh + fr * 136 + uu * 32 + fq * 8);
          }
          f32x4 at = {0.f, 0.f, 0.f, 0.f};
#pragma unroll
          for (int uu = 0; uu < 4; ++uu) at = __builtin_amdgcn_mfma_f32_16x16x32_bf16(kp[uu], qp[uu], at, 0, 0, 0);
#pragma unroll
          for (int e = 0; e < 4; ++e) if (fq * 4 + e > fr) at[e] = 0.f;
          u32x2 aw; aw.x = cvt_pk(at[0], at[1]); aw.y = cvt_pk(at[2], at[3]);
          const bf16x4 a4 = __builtin_bit_cast(bf16x4, aw);
          const bf16x4 vf = *(const bf16x4*)(Vt + (wid * 16 + fr) * 16 + fq * 4);
          const bf16x8 vf8 = {vf[0], vf[1], vf[2], vf[3], 0, 0, 0, 0}, a8 = {a4[0], a4[1], a4[2], a4[3], 0, 0, 0, 0};
          f32x4 oacc = __builtin_amdgcn_mfma_f32_16x16x32_bf16(vf8, a8, (f32x4){0.f, 0.f, 0.f, 0.f}, 0, 0, 0);
#pragma unroll
          for (int uu = 0; uu < 4; ++uu) {
            u32x4 w; w.x = cvt_pk(S[2 * uu][0], S[2 * uu][1]); w.y = cvt_pk(S[2 * uu][2], S[2 * uu][3]);
            w.z = cvt_pk(S[2 * uu + 1][0], S[2 * uu + 1][1]); w.w = cvt_pk(S[2 * uu + 1][2], S[2 * uu + 1][3]);
            oacc = __builtin_amdgcn_mfma_f32_16x16x32_bf16(__builtin_bit_cast(bf16x8, w), qp[uu], oacc, 0, 0, 0);
          }
#pragma unroll
          for (int kt = 0; kt < 8; ++kt) {
            const f32x4 d = *(const f32x4*)(dec + kt * 16 + fq * 4);
            const bf16x4 kf = *(const bf16x4*)(Kt + (kt * 16 + fr) * 16 + fq * 4);
            const bf16x8 kf8 = {kf[0], kf[1], kf[2], kf[3], 0, 0, 0, 0};
            S[kt] = __builtin_amdgcn_mfma_f32_16x16x32_bf16(kf8, vf8, S[kt] * d, 0, 0, 0);
          }
          float ss = oacc[0] * oacc[0] + oacc[1] * oacc[1] + oacc[2] * oacc[2] + oacc[3] * oacc[3];
          ss += bperm(ss, lane ^ 16); ss += bperm(ss, lane ^ 32);
          if (fq == 0) red[fr * 8 + wid] = ss;
          oprev = oacc;
        }
      }
    }
  }
  __syncthreads();
  {
    const int i = nsub - 1, s = i & 1;
    const float* redp = redb + s * 128;
    float tot = 0.f;
#pragma unroll
    for (int w = 0; w < 8; ++w) tot += redp[fr * 8 + w];
    const float rs = rsqrtf(tot * (1.f / 128.f) + 1e-6f);
    const int tk = i * 16 + fr;
    if (tk < T) {
      const u32x2 gw = gsave[s];
      const float gg[4] = {bflo(gw.x), bfhi(gw.x), bflo(gw.y), bfhi(gw.y)};
      float r[4];
#pragma unroll
      for (int e = 0; e < 4; ++e) r[e] = oprev[e] * rs * og[e] * gg[e] * sigmoidf_(gg[e]);
      u32x2 o; o.x = cvt_pk(r[0], r[1]); o.y = cvt_pk(r[2], r[3]);
      *(u32x2*)(branch + (size_t)(g0 + tk) * BRW + h * 128 + wid * 16 + fq * 4) = o;
    }
  }
  float* so = p.out + (smp ? O_SHS + (((size_t)j * 128 + b) * 8 + h) * 16384 : O_SHP + (((size_t)j * 8 + b) * 8 + h) * 16384);
#pragma unroll
  for (int kt = 0; kt < 8; ++kt)
#pragma unroll
    for (int e = 0; e < 4; ++e) so[(kt * 16 + fq * 4 + e) * 128 + wid * 16 + fr] = S[kt][e];
  __syncthreads();
}

#define LDS_BARRIER() do { asm volatile("s_waitcnt lgkmcnt(0)" ::: "memory"); __builtin_amdgcn_s_barrier(); asm volatile("" ::: "memory"); } while (0)
typedef float f32x2 __attribute__((ext_vector_type(2)));
struct RwRaw { u32x2 r, k, v, gt, ew, a, vg, vf; };
constexpr int RW_SET = 7 * 1024;
struct RwCtx {
  const bfr* proj; const bfr* lup; const bfr* vfsrc; bfr* vdst; bfr* branch;
  int vgoff, vfld;
  int g0, T, tsl, cq4, C4;
  f32x4 kkw, kaw, rkw, lng, lnb;
};
__device__ __forceinline__ float sum16(float v) {
  v += dppf<0xB1>(v); v += dppf<0x4E>(v); v += dppf<0x141>(v); v += dppf<0x140>(v);
  return v;
}
__device__ __forceinline__ f32x4 unpk4(const u32x2 w) { return (f32x4){bflo(w.x), bfhi(w.x), bflo(w.y), bfhi(w.y)}; }
__device__ __forceinline__ void rw_load(RwRaw& raw, const RwCtx& c, const int tile) {
  int tok = tile * 16 + c.tsl; tok = tok < c.T ? tok : c.T - 1;
  const size_t g = (size_t)(c.g0 + tok);
  const bfr* pr = c.proj + g * INC + c.C4;
  raw.r = *(const u32x2*)pr; raw.k = *(const u32x2*)(pr + 1024); raw.v = *(const u32x2*)(pr + 2048); raw.gt = *(const u32x2*)(pr + 3584);
  const bfr* pl = c.lup + g * 3072 + c.C4;
  raw.ew = *(const u32x2*)pl; raw.a = *(const u32x2*)(pl + 1024); raw.vg = *(const u32x2*)(pl + c.vgoff);
  raw.vf = *(const u32x2*)(c.vfsrc + g * c.vfld + c.C4);
}
__device__ __forceinline__ void rw_prep(const RwRaw& raw, f32x4& bon, f32x4& gt, float* __restrict__ L, const RwCtx& c, const int tile) {
  int tok = tile * 16 + c.tsl; tok = tok < c.T ? tok : c.T - 1;
  const int tt = tok & 15;
  const size_t g = (size_t)(c.g0 + tok);
  const f32x4 r = unpk4(raw.r), k = unpk4(raw.k), ew = unpk4(raw.ew), a = unpk4(raw.a);
  f32x4 v = unpk4(raw.v);
  *(u32x2*)(c.vdst + g * DM + c.C4) = raw.v;
  v = v + (unpk4(raw.vf) - v) * unpk4(raw.vg);
  f32x4 dcy; dcy[0] = __expf(ew[0]); dcy[1] = __expf(ew[1]); dcy[2] = __expf(ew[2]); dcy[3] = __expf(ew[3]);
  f32x4 kk = k * c.kkw;
  const float n2 = sum16((kk[0] * kk[0] + kk[1] * kk[1]) + (kk[2] * kk[2] + kk[3] * kk[3]));
  const float inv = __builtin_amdgcn_rsqf(fmaxf(n2, 1e-24f));
  kk = kk * inv;
  const f32x4 k2 = k * (1.f + (a - 1.f) * c.kaw);
  const f32x4 rk = r * k2 * c.rkw;
  const float sb = sum16((rk[0] + rk[1]) + (rk[2] + rk[3]));
  bon = v * sb;
  gt = unpk4(raw.gt);
  const int o = tt * 64 + c.cq4;
  *(f32x4*)(L + 0 * 1024 + o) = r; *(f32x4*)(L + 1 * 1024 + o) = dcy; *(f32x4*)(L + 2 * 1024 + o) = k2; *(f32x4*)(L + 3 * 1024 + o) = v;
  *(f32x4*)(L + 4 * 1024 + o) = -kk; *(f32x4*)(L + 5 * 1024 + o) = kk * a;
}
__device__ __forceinline__ void rw_post(const f32x4 bon, const f32x4 gt, const float* __restrict__ L, const RwCtx& c, const int tile) {
  int tok = tile * 16 + c.tsl; tok = tok < c.T ? tok : c.T - 1;
  const int tt = tok & 15;
  const size_t g = (size_t)(c.g0 + tok);
  const f32x4 y = *(const f32x4*)(L + 6 * 1024 + tt * 64 + c.cq4);
  const float mean = sum16((y[0] + y[1]) + (y[2] + y[3])) * (1.f / 64.f);
  const f32x4 d = y - mean;
  const float var = sum16((d[0] * d[0] + d[1] * d[1]) + (d[2] * d[2] + d[3] * d[3])) * (1.f / 64.f);
  f32x4 o = d * rsqrtf(var + 64e-5f) * c.lng + c.lnb + bon;
  o[0] *= gt[0] * sigmoidf_(gt[0]); o[1] *= gt[1] * sigmoidf_(gt[1]); o[2] *= gt[2] * sigmoidf_(gt[2]); o[3] *= gt[3] * sigmoidf_(gt[3]);
  u32x2 w; w.x = cvt_pk(o[0], o[1]); w.y = cvt_pk(o[2], o[3]);
  *(u32x2*)(c.branch + g * BRW + c.C4) = w;
}
struct RwVec { f32x4 r0, r1, w0, w1, k0, k1, a0, a1, b0, b1; float v; };
__device__ __forceinline__ void rw_ldvec(RwVec& x, const float* __restrict__ L, const int t, const int row, const int c0) {
  x.r0 = *(const f32x4*)(L + 0 * 1024 + t * 64 + c0); x.r1 = *(const f32x4*)(L + 0 * 1024 + t * 64 + c0 + 4);
  x.w0 = *(const f32x4*)(L + 1 * 1024 + t * 64 + c0); x.w1 = *(const f32x4*)(L + 1 * 1024 + t * 64 + c0 + 4);
  x.k0 = *(const f32x4*)(L + 2 * 1024 + t * 64 + c0); x.k1 = *(const f32x4*)(L + 2 * 1024 + t * 64 + c0 + 4);
  x.v = L[3 * 1024 + t * 64 + row];
  x.a0 = *(const f32x4*)(L + 4 * 1024 + t * 64 + c0); x.a1 = *(const f32x4*)(L + 4 * 1024 + t * 64 + c0 + 4);
  x.b0 = *(const f32x4*)(L + 5 * 1024 + t * 64 + c0); x.b1 = *(const f32x4*)(L + 5 * 1024 + t * 64 + c0 + 4);
}
template <int NST>
__device__ __forceinline__ void rw_scan(f32x2 (&S)[4], float* __restrict__ L, const int row, const int c0, const int cg) {
  RwVec cur, nxt;
  rw_ldvec(cur, L, 0, row, c0);
  float ys0 = 0.f, ys1 = 0.f;
#pragma unroll
  for (int t = 0; t < NST; ++t) {
    if (t + 1 < NST) rw_ldvec(nxt, L, t + 1, row, c0);
    const f32x2 av[4] = {{cur.a0[0], cur.a0[1]}, {cur.a0[2], cur.a0[3]}, {cur.a1[0], cur.a1[1]}, {cur.a1[2], cur.a1[3]}};
    const f32x2 wv[4] = {{cur.w0[0], cur.w0[1]}, {cur.w0[2], cur.w0[3]}, {cur.w1[0], cur.w1[1]}, {cur.w1[2], cur.w1[3]}};
    const f32x2 bv[4] = {{cur.b0[0], cur.b0[1]}, {cur.b0[2], cur.b0[3]}, {cur.b1[0], cur.b1[1]}, {cur.b1[2], cur.b1[3]}};
    const f32x2 kv[4] = {{cur.k0[0], cur.k0[1]}, {cur.k0[2], cur.k0[3]}, {cur.k1[0], cur.k1[1]}, {cur.k1[2], cur.k1[3]}};
    const f32x2 rv[4] = {{cur.r0[0], cur.r0[1]}, {cur.r0[2], cur.r0[3]}, {cur.r1[0], cur.r1[1]}, {cur.r1[2], cur.r1[3]}};
    const f32x2 vi2 = {cur.v, cur.v};
    f32x2 pa = S[0] * av[0] + S[1] * av[1];
    const f32x2 pb = S[2] * av[2] + S[3] * av[3];
    f32x2 n[4];
#pragma unroll
    for (int q = 0; q < 4; ++q) n[q] = S[q] * wv[q] + vi2 * kv[q];
    pa += pb;
    const float sa = sum8(pa[0] + pa[1]);
    const f32x2 sa2 = {sa, sa};
#pragma unroll
    for (int q = 0; q < 4; ++q) S[q] = sa2 * bv[q] + n[q];
    f32x2 ya = S[0] * rv[0] + S[1] * rv[1];
    const f32x2 yb = S[2] * rv[2] + S[3] * rv[3];
    ya += yb;
    const float y = sum8(ya[0] + ya[1]);
    if (cg == (t & 7)) { if (t < 8) ys0 = y; else ys1 = y; }
    cur = nxt;
  }
  L[6 * 1024 + cg * 64 + row] = ys0;
  if (NST > 8) L[6 * 1024 + (cg + 8) * 64 + row] = ys1;
}

__device__ __forceinline__ void rwkv_unit(const Params& p, const int l, const bool smp, const int b, const int head) {
  extern __shared__ __attribute__((aligned(16))) char smem[];
  float* L0 = (float*)smem;
  float* L1 = L0 + RW_SET;
  RwCtx c;
  const int tid = tidx();
  const int wid = tid >> 6, lane = tid & 63;
  const int j = l >> 1;
  c.proj = (const bfr*)(p.ws + WS_PROJ);
  c.lup = (const bfr*)(p.ws + WS_LUP);
  c.vfsrc = (j == 0) ? c.proj + 2048 : (const bfr*)(p.ws + WS_VFIRST);
  c.vfld = (j == 0) ? INC : DM;
  c.vgoff = (j == 0) ? 1024 : 2048;
  c.vdst = (j == 0) ? (bfr*)(p.ws + WS_VFIRST) : (bfr*)(p.ws + WS_HA + 2 * HA_SZ * 2);
  c.branch = (bfr*)(p.ws + WS_BRANCH);
  c.g0 = smp ? NPR + b * 8 : b * 2048;
  c.T = smp ? 8 : 2048;
  c.tsl = 2 * wid + ((lane >> 4) & 1);
  c.cq4 = (lane & 15) * 4;
  c.C4 = head * 64 + c.cq4;
  const int cg = lane & 7, row = wid * 8 + (lane >> 3), c0 = cg * 8;
  f32x2 S[4];
  if (smp) {
    const float* s0 = pin(p, I_SR) + ((((size_t)j * 128 + b) * 16 + head) * 64 + row) * 64 + c0;
    const float4 a = *(const float4*)s0, bq = *(const float4*)(s0 + 4);
    S[0] = (f32x2){a.x, a.y}; S[1] = (f32x2){a.z, a.w}; S[2] = (f32x2){bq.x, bq.y}; S[3] = (f32x2){bq.z, bq.w};
  } else {
    S[0] = S[1] = S[2] = S[3] = (f32x2){0.f, 0.f};
  }
  c.kkw = *(const f32x4*)(pin(p, I_KK) + j * DM + c.C4); c.kaw = *(const f32x4*)(pin(p, I_KA) + j * DM + c.C4); c.rkw = *(const f32x4*)(pin(p, I_RK) + j * DM + c.C4);
  c.lng = *(const f32x4*)(pin(p, I_LG) + j * DM + c.C4); c.lnb = *(const f32x4*)(pin(p, I_LBI) + j * DM + c.C4);
  RwRaw rawA, rawB;
  f32x4 bonA, bonB, gtA, gtB;
  if (smp) {
    rw_load(rawA, c, 0);
    rw_prep(rawA, bonA, gtA, L0, c, 0);
    LDS_BARRIER();
    rw_scan<8>(S, L0, row, c0, cg);
    LDS_BARRIER();
    rw_post(bonA, gtA, L0, c, 0);
  } else {
    const int ntile = 128;
    rw_load(rawA, c, 0); rw_load(rawB, c, 1);
    rw_prep(rawA, bonA, gtA, L0, c, 0); rw_load(rawA, c, 2);
    LDS_BARRIER();
    rw_scan<16>(S, L0, row, c0, cg); rw_prep(rawB, bonB, gtB, L1, c, 1); rw_load(rawB, c, 3);
    LDS_BARRIER();
    for (int i = 1; i < ntile - 1; i += 2) {
      rw_post(bonA, gtA, L0, c, i - 1); rw_scan<16>(S, L1, row, c0, cg); rw_prep(rawA, bonA, gtA, L0, c, i + 1); rw_load(rawA, c, i + 3);
      LDS_BARRIER();
      rw_post(bonB, gtB, L1, c, i); rw_scan<16>(S, L0, row, c0, cg); rw_prep(rawB, bonB, gtB, L1, c, i + 2); rw_load(rawB, c, i + 4);
      LDS_BARRIER();
    }
    rw_post(bonA, gtA, L0, c, ntile - 2); rw_scan<16>(S, L1, row, c0, cg);
    LDS_BARRIER();
    rw_post(bonB, gtB, L1, c, ntile - 1);
  }
  float* so = p.out + (smp ? O_SRS + ((((size_t)j * 128 + b) * 16 + head) * 64 + row) * 64 + c0 : O_SRP + ((((size_t)j * 8 + b) * 16 + head) * 64 + row) * 64 + c0);
  *(float4*)so = make_float4(S[0][0], S[0][1], S[1][0], S[1][1]); *(float4*)(so + 4) = make_float4(S[2][0], S[2][1], S[3][0], S[3][1]);
  __syncthreads();
}

__device__ __forceinline__ void mix_phase(const Params& p, const int l, const int rep) {
  __shared__ int s_item;
  unsigned* ctr = (unsigned*)(p.ws + WS_CTRL) + l + 4 * rep;
  const bool rw = l & 1;
  const int nP = rw ? 128 : 64, nS = rw ? 2048 : 1024;
  const int nitems = nP + nS + 1024;
  for (;;) {
    __syncthreads();
    if (tidx() == 0) s_item = (int)atomicAdd(ctr, 1u);
    __syncthreads();
    int it = s_item;
    if (rep > 0 && PROBE_SUB == 1) { if (it >= nP) break; }
    if (rep > 0 && PROBE_SUB == 2) { it += nP; if (it >= nP + nS) break; }
    if (rep > 0 && PROBE_SUB == 3) { it += nP + nS; }
    if (it >= nitems) break;
    if (it < nP + nS) {
      const bool smp = it >= nP;
      if (smp) it -= nP;
      if (rw) rwkv_unit(p, l, smp, it >> 4, it & 15); else hgrn_unit(p, l, smp, it >> 3, it & 7);
    } else {
      it -= nP + nS;
      const float* kb; const float* vb; int g0, ntok, head;
      if (it < 512) {
        const int b = it >> 6, blk = it & 15; head = (it >> 4) & 3;
        const size_t off = ((size_t)(l * 8 + b) * 256) * 512 + head * 128;
        kb = p.out + O_MK + off; vb = p.out + O_MV + off; g0 = b * 2048 + blk * 128; ntok = 128;
      } else {
        it -= 512;
        const int b = it >> 2; head = it & 3;
        const size_t off = ((size_t)(l * 128 + b) * 256) * 512 + head * 128;
        kb = pin(p, I_CK) + off; vb = pin(p, I_CV) + off; g0 = NPR + b * 8; ntok = 8;
      }
      xattn_unit(p, kb, vb, g0, ntok, head);
    }
  }
}

#define XB_TMO      128
#define XB_XCNT(j)  (256  + 64 * (j))
#define XB_XSUB(j)  (1280 + 64 * (j))
#define XB_XGEN(j)  (2304 + 64 * (j))
#define XB_TOP      3328
#define XB_TOPGEN   3392
#define XB_SPIN_CAP (1u << 18)
#define XB_LAS __attribute__((address_space(3)))
__device__ __forceinline__ unsigned xb_ld(unsigned* p)              { return __hip_atomic_load(p, __ATOMIC_RELAXED, __HIP_MEMORY_SCOPE_AGENT); }
__device__ __forceinline__ unsigned xb_add(unsigned* p, unsigned v) { return __hip_atomic_fetch_add(p, v, __ATOMIC_RELAXED, __HIP_MEMORY_SCOPE_AGENT); }
__device__ __forceinline__ unsigned xb_xcc_id() { return (unsigned)__builtin_amdgcn_s_getreg((3 << 11) | 20) & 0xFu; }
#define XB_SPIN(cond, bar) do { unsigned _sp = 0; while (cond) { __builtin_amdgcn_s_sleep(1); \
    if ((++_sp & 255u) == 0u) { if (xb_ld(&(bar)[XB_TMO])) break; if (_sp > XB_SPIN_CAP) { atomicAdd(&(bar)[XB_TMO], 1u); break; } } } } while (0)
__device__ __forceinline__ void xcd_barrier_complete(unsigned* bar, unsigned x, unsigned& nloc, unsigned& nx) {
  const unsigned G = gridDim.x;
  unsigned sum, cnt, mine, sp = 0u;
  for (;;) {
    sum = 0u; cnt = 0u; mine = 0u;
#pragma unroll
    for (unsigned j = 0; j < 16; ++j) { const unsigned c = xb_ld(&bar[XB_XCNT(j)]); sum += c; cnt += (c > 0u) ? 1u : 0u; mine = (j == x) ? c : mine; }
    if (sum == G) break;
    __builtin_amdgcn_s_sleep(1);
    if ((++sp & 255u) == 0u) { if (xb_ld(&bar[XB_TMO])) break; if (sp > XB_SPIN_CAP) { atomicAdd(&bar[XB_TMO], 1u); break; } }
  }
  nloc = mine > 0u ? mine : 1u; nx = cnt > 0u ? cnt : 1u;
}
__device__ __forceinline__ void grid_barrier(unsigned* bar, volatile XB_LAS unsigned* st) {
  asm volatile("s_waitcnt vmcnt(0)" ::: "memory");
  __syncthreads();
  if (threadIdx.x == 0) {
    const unsigned x = xb_xcc_id();
    __builtin_amdgcn_s_waitcnt(0);
    unsigned nloc = st[0], nx = st[1];
    if (nloc == 0u) { xcd_barrier_complete(bar, x, nloc, nx); st[0] = nloc; st[1] = nx; }
    const unsigned old = xb_add(&bar[XB_XSUB(x)], 1u);
    const unsigned gen = old / nloc;
    if (old + 1u == (gen + 1u) * nloc) {
      __builtin_amdgcn_fence(__ATOMIC_RELEASE, "agent");
      asm volatile("s_waitcnt vmcnt(0)" ::: "memory");
      const unsigned og = xb_add(&bar[XB_TOP], 1u);
      const unsigned tg = og / nx;
      if (og + 1u == (tg + 1u) * nx) xb_add(&bar[XB_TOPGEN], 1u);
      else XB_SPIN(xb_ld(&bar[XB_TOPGEN]) == tg, bar);
      __builtin_amdgcn_fence(__ATOMIC_ACQUIRE, "agent");
      xb_add(&bar[XB_XGEN(x)], 1u);
      asm volatile("s_waitcnt vmcnt(0)" ::: "memory");
    } else {
      XB_SPIN(xb_ld(&bar[XB_XGEN(x)]) == gen, bar);
      __builtin_amdgcn_fence(__ATOMIC_ACQUIRE, "agent");
      asm volatile("s_waitcnt vmcnt(0)" ::: "memory");
    }
  }
  __syncthreads();
}
__device__ __forceinline__ void run_phase(const Params& p, const int ph, const int rep) {
  int code;
  switch (ph) {
    case 0: code = 0; break;
    case 1: code = 1 | (0 << 4) | (0 << 8); break;
    case 2: code = 2 | (0 << 8); break;
    case 3: code = 1 | (2 << 4) | (0 << 8); break;
    case 4: code = 3 | (1 << 8); break;
    case 5: code = 1 | (0 << 4) | (1 << 8); break;
    case 6: code = 1 | (1 << 4) | (1 << 8); break;
    case 7: code = 2 | (1 << 8); break;
    case 8: code = 1 | (2 << 4) | (1 << 8); break;
    case 9: code = 3 | (2 << 8); break;
    case 10: code = 1 | (0 << 4) | (2 << 8); break;
    case 11: code = 2 | (2 << 8); break;
    case 12: code = 1 | (2 << 4) | (2 << 8); break;
    case 13: code = 3 | (3 << 8); break;
    case 14: code = 1 | (0 << 4) | (3 << 8); break;
    case 15: code = 1 | (1 << 4) | (3 << 8); break;
    case 16: code = 2 | (3 << 8); break;
    case 17: code = 1 | (2 << 4) | (3 << 8); break;
    default: code = 4; break;
  }
  const int type = code & 15, kind = (code >> 4) & 15, l = code >> 8;
  if (type == 0) prologue(p);
  else if (type == 1) gemm_phase(p, kind, l);
  else if (type == 2) mix_phase(p, l, rep);
  else if (type == 3) prep_phase(p, l);
  else final_phase(p);
}
constexpr int NPHASE = 19;

__global__ void __launch_bounds__(512) mega(Params p) {
  __shared__ uint4 xb_words;
  if (threadIdx.x == 0) {
    xb_words = make_uint4(0u, 0u, 0u, 0u);
    (void)xb_add(&((unsigned*)(p.ws + WS_XBAR))[XB_XCNT(xb_xcc_id())], 1u);
  }
  __syncthreads();
  for (int ph = p.ph_lo; ph <= p.ph_hi; ++ph) {
    const int nrep = ((PROBE_MASK >> ph) & 1u) ? 2 : 1;
    for (int rep = 0; rep < nrep; ++rep) {
      run_phase(p, ph, rep);
      if (ph < p.ph_hi || rep + 1 < nrep) {
        if (p.ph_hi < 0) cg::this_grid().sync();
        grid_barrier((unsigned*)(p.ws + WS_XBAR), (volatile XB_LAS unsigned*)&xb_words);
      }
    }
  }
}

extern "C" void kernel_launch(void* const* d_in, const int* in_sizes, int n_in, void* d_out, int out_size, void* d_ws, size_t ws_size,
                              hipStream_t stream) {
  static int grid = 0;
  if (grid == 0) {
    if (n_in != 31 || ws_size < WS_END) { fprintf(stderr, "kernel_launch: unexpected n_in %d / ws %zu (need %zu)\n", n_in, ws_size, (size_t)WS_END); grid = -1; return; }
    int dev = 0, cus = 0, per_cu = 0;
    hipGetDevice(&dev);
    hipDeviceGetAttribute(&cus, hipDeviceAttributeMultiprocessorCount, dev);
    if (hipFuncSetAttribute((const void*)mega, hipFuncAttributeMaxDynamicSharedMemorySize, LDS_BYTES) != hipSuccess) { fprintf(stderr, "hipFuncSetAttribute failed\n"); grid = -1; return; }
    hipOccupancyMaxActiveBlocksPerMultiprocessor(&per_cu, (const void*)mega, 512, LDS_BYTES);
    if (per_cu < 1) { fprintf(stderr, "occupancy query says %d blocks/CU\n", per_cu); per_cu = 1; }
    (void)hipGetLastError();
    grid = cus * per_cu;
  }
  if (grid < 0) return;
  Params p{};
  for (int i = 0; i < 31; ++i) p.in[i] = (const float*)d_in[i];
  p.out = (float*)d_out; p.ws = (char*)d_ws;
  if (hipMemsetAsync((char*)d_ws + WS_XBAR, 0, 16384, stream) != hipSuccess) { fprintf(stderr, "kernel_launch: barrier-word memset failed\n"); return; }
  if (hipMemsetAsync((char*)d_ws + WS_CTRL, 0, 4096, stream) != hipSuccess) { fprintf(stderr, "kernel_launch: control-word memset failed\n"); return; }
#if COOP
  p.ph_lo = 0; p.ph_hi = NPHASE - 1;
  void* args[] = {&p};
  hipError_t e = hipLaunchCooperativeKernel((const void*)mega, dim3(grid), dim3(512), args, LDS_BYTES, stream);
  if (e != hipSuccess) fprintf(stderr, "cooperative launch failed: %s (grid %d)\n", hipGetErrorString(e), grid);
#else
  for (int ph = 0; ph < NPHASE; ++ph) {
    p.ph_lo = ph; p.ph_hi = ph;
    hipLaunchKernelGGL(mega, dim3(grid), dim3(512), LDS_BYTES, stream, p);
  }
#endif
}
```

```cpp
#include <hip/hip_runtime.h>
#include <hip/hip_cooperative_groups.h>
#include <cstdio>
#include <cstdint>
namespace cg = cooperative_groups;

#ifndef COOP
#define COOP 1
#endif
#ifndef PROBE_SUB
#define PROBE_SUB 0
#endif
#ifndef PROBE_MASK
#define PROBE_MASK 0u
#endif

typedef unsigned short bfr;
typedef short bf16x8 __attribute__((ext_vector_type(8)));
typedef short bf16x4 __attribute__((ext_vector_type(4)));
typedef float f32x4 __attribute__((ext_vector_type(4)));
typedef unsigned u32x2 __attribute__((ext_vector_type(2)));
typedef unsigned u32x4 __attribute__((ext_vector_type(4)));

constexpr int NTOK = 17408, NPR = 16384, DM = 1024, INC = 5120, BRW = 1536;
constexpr int LDS_BYTES = 139264;
constexpr size_t O_YP = 0, O_SHP = 17825792, O_SRP = 19922944, O_SSP = 20971520, O_MK = 20987904, O_MV = 25182208,
                 O_SHS = 29376512, O_SRS = 62930944, O_SSS = 79708160;
constexpr size_t WS_CTRL = 0;
constexpr size_t WS_WTIN = 4096;
constexpr size_t WTIN_L = (size_t)5888 * 1024;
constexpr size_t WS_WTOUT = WS_WTIN + 4 * WTIN_L * 2;
constexpr size_t WS_WTMEM = WS_WTOUT + (size_t)4 * 1024 * 1536 * 2;
constexpr size_t WS_W2T = WS_WTMEM + (size_t)4 * 1024 * 1024 * 2;
constexpr size_t WS_MEMN = WS_W2T + (size_t)2 * 3072 * 256 * 2;
constexpr size_t WS_XRES = WS_MEMN + (size_t)4 * 2048 * 1024 * 2;
constexpr size_t HA_SZ = (size_t)NTOK * 1024;
constexpr size_t WS_HA = WS_XRES + (size_t)NTOK * 1024 * 4;
constexpr size_t WS_PROJ = WS_HA + 6 * HA_SZ * 2;
constexpr size_t WS_ALORA = WS_PROJ + (size_t)NTOK * INC * 2;
constexpr size_t WS_LUP = WS_ALORA + (size_t)NTOK * 256 * 2;
constexpr size_t WS_VFIRST = WS_LUP + (size_t)NTOK * 3072 * 2;
constexpr size_t WS_BRANCH = WS_VFIRST + HA_SZ * 2;
constexpr size_t WS_PART = WS_BRANCH + (size_t)NTOK * BRW * 2;
constexpr size_t WS_XBAR = WS_PART + (size_t)5 * 1024 * 1024 * 4;
constexpr size_t WS_END = WS_XBAR + 16384;

struct Params {
  const float* in[31];
  float* out;
  char* ws;
  int ph_lo, ph_hi;
};
enum { I_XP = 0, I_XS, I_MEM, I_SH, I_SR, I_SS, I_CK, I_CV, I_NG, I_WIN, I_WOUT, I_MNG, I_WMEM, I_LB, I_ONG, I_MU, I_W0, I_W1, I_W2,
       I_A0, I_A1, I_A2, I_V0, I_V1, I_V2, I_KK, I_KA, I_RK, I_LG, I_LBI, I_FG };

__device__ __forceinline__ unsigned cvt_pk(float lo, float hi) { unsigned r; asm("v_cvt_pk_bf16_f32 %0, %1, %2" : "=v"(r) : "v"(lo), "v"(hi)); return r; }
__device__ __forceinline__ bfr f2bf(float f) { return (bfr)(cvt_pk(f, 0.f) & 0xffff); }
__device__ __forceinline__ float bf2f(unsigned h) { return __uint_as_float(h << 16); }
__device__ __forceinline__ float bflo(unsigned w) { return __uint_as_float(w << 16); }
__device__ __forceinline__ float bfhi(unsigned w) { return __uint_as_float(w & 0xffff0000u); }
__device__ __forceinline__ float frcp(float x) { return __builtin_amdgcn_rcpf(x); }
__device__ __forceinline__ float sigmoidf_(float x) { return frcp(1.f + __expf(-x)); }
template <int CTRL> __device__ __forceinline__ float dppf(float x) {
  return __builtin_bit_cast(float, __builtin_amdgcn_update_dpp(0, __builtin_bit_cast(int, x), CTRL, 0xf, 0xf, true));
}
__device__ __forceinline__ float wave_sum(float v) {
  v += dppf<0xB1>(v); v += dppf<0x4E>(v); v += dppf<0x141>(v); v += dppf<0x140>(v);
  const int iv = __builtin_bit_cast(int, v);
  float r = __builtin_bit_cast(float, __builtin_amdgcn_readlane(iv, 0));
  r += __builtin_bit_cast(float, __builtin_amdgcn_readlane(iv, 16));
  r += __builtin_bit_cast(float, __builtin_amdgcn_readlane(iv, 32));
  r += __builtin_bit_cast(float, __builtin_amdgcn_readlane(iv, 48));
  return r;
}
__device__ __forceinline__ float bperm(float v, int srclane) { return __builtin_bit_cast(float, __builtin_amdgcn_ds_bpermute(srclane << 2, __builtin_bit_cast(int, v))); }
__device__ __forceinline__ float sum8(float v) {
  v += dppf<0xB1>(v);
  v += dppf<0x4E>(v);
  v += dppf<0x141>(v);
  return v;
}
__device__ __forceinline__ const float* pin(const Params& p, int i) { asm volatile("" : "+s"(i)); return p.in[i]; }
__device__ __forceinline__ const float* xin_row(const Params& p, int g) {
  return g < NPR ? pin(p, I_XP) + (size_t)g * DM : pin(p, I_XS) + (size_t)(g - NPR) * DM;
}

__device__ __forceinline__ int tidx() { int t = threadIdx.x; asm volatile("" : "+v"(t)); return t; }
__device__ __forceinline__ int bidx() { int b = blockIdx.x; asm volatile("" : "+s"(b)); return b; }
__device__ __forceinline__ int wperm(int n) { const int c = n & 31; return (n & ~31) + ((c >> 2) & 1) * 16 + (c >> 3) * 4 + (c & 3); }

__device__ __forceinline__ void transpose_job(const float* __restrict__ src, int Ks, int Ns, bfr* __restrict__ dst, int ldd, int rot) {
  extern __shared__ __attribute__((aligned(16))) char smem[];
  bfr* T = (bfr*)smem;
  const int tid = tidx();
  const int tn = Ns >> 6, ntile = (Ks >> 6) * tn;
  const int G = gridDim.x;
  for (int tile = (bidx() + rot) % G; tile < ntile; tile += G) {
    const int k0 = (tile / tn) << 6, n0 = (tile % tn) << 6;
    const int kl = tid >> 3, nc = (tid & 7) << 3;
    const float* s = src + (size_t)(k0 + kl) * Ns + n0 + nc;
    const float4 a = *(const float4*)s, b = *(const float4*)(s + 4);
    __syncthreads();
    T[(nc + 0) * 72 + kl] = f2bf(a.x); T[(nc + 1) * 72 + kl] = f2bf(a.y); T[(nc + 2) * 72 + kl] = f2bf(a.z); T[(nc + 3) * 72 + kl] = f2bf(a.w);
    T[(nc + 4) * 72 + kl] = f2bf(b.x); T[(nc + 5) * 72 + kl] = f2bf(b.y); T[(nc + 6) * 72 + kl] = f2bf(b.z); T[(nc + 7) * 72 + kl] = f2bf(b.w);
    __syncthreads();
    const int nl = tid >> 3, kc = (tid & 7) << 3;
    const u32x4 v = *(const u32x4*)(T + nl * 72 + kc);
    *(u32x4*)(dst + (size_t)wperm(n0 + nl) * ldd + k0 + kc) = v;
  }
}

__device__ __forceinline__ void prologue(const Params& p) {
  const int tid = tidx(), wid = tid >> 6, lane = tid & 63;
  const int G = gridDim.x;
  char* ws = p.ws;
  int rot = 0;
  for (int l = 0; l < 4; ++l) {
    transpose_job(pin(p, I_WIN) + (size_t)l * DM * INC, DM, INC, (bfr*)(ws + WS_WTIN) + l * WTIN_L, DM, rot); rot = (rot + G - (1280 % G)) % G;
    transpose_job(pin(p, I_WOUT) + (size_t)l * BRW * DM, BRW, DM, (bfr*)(ws + WS_WTOUT) + (size_t)l * DM * BRW, BRW, rot); rot = (rot + G - (384 % G)) % G;
    transpose_job(pin(p, I_WMEM) + (size_t)l * DM * DM, DM, DM, (bfr*)(ws + WS_WTMEM) + (size_t)l * DM * DM, DM, rot); rot = (rot + G - (256 % G)) % G;
  }
  const int gt = bidx() * 512 + tid, nth = G * 512;
  for (int j = 0; j < 2; ++j) {
    bfr* dst = (bfr*)(ws + WS_WTIN) + (size_t)(2 * j + 1) * WTIN_L + (size_t)5120 * 1024;
    const float* w1 = pin(p, I_W1) + (size_t)j * 1024 * 64;
    const float* a1 = pin(p, I_A1) + (size_t)j * 1024 * 64;
    const float* v1 = pin(p, I_V1);
    for (int it = gt; it < 768 * 128; it += nth) {
      const int n = it % 768, kc = it / 768;
      const int seg = n >> 8, c = n & 255;
      float v[8];
#pragma unroll
      for (int e = 0; e < 8; ++e) {
        const int k = kc * 8 + e;
        float x = 0.f;
        if (seg == 0) { if (c < 64) x = w1[k * 64 + c]; }
        else if (seg == 1) { if (c < 64) x = a1[k * 64 + c]; }
        else { if (j == 1 && c < 32) x = v1[k * 32 + c]; }
        v[e] = x;
      }
      u32x4 o; o.x = cvt_pk(v[0], v[1]); o.y = cvt_pk(v[2], v[3]); o.z = cvt_pk(v[4], v[5]); o.w = cvt_pk(v[6], v[7]);
      *(u32x4*)(dst + (size_t)wperm(n) * 1024 + kc * 8) = o;
    }
    bfr* d2 = (bfr*)(ws + WS_W2T) + (size_t)j * 3072 * 256;
    const float* w2 = pin(p, I_W2) + (size_t)j * 64 * 1024;
    const float* a2 = pin(p, I_A2) + (size_t)j * 64 * 1024;
    const float* v2 = pin(p, I_V2);
    for (int it = gt; it < 3072 * 32; it += nth) {
      const int n = it % 3072, kc = it / 3072;
      const int seg = n >> 10, c = n & 1023;
      float v[8];
#pragma unroll
      for (int e = 0; e < 8; ++e) {
        const int k = kc * 8 + e;
        float x = 0.f;
        if (seg == 0) { if (k < 64) x = w2[k * 1024 + c]; }
        else if (seg == 1) { if (k >= 64 && k < 128) x = a2[(k - 64) * 1024 + c]; }
        else { if (j == 1 && k >= 128 && k < 160) x = v2[(k - 128) * 1024 + c]; }
        v[e] = x;
      }
      u32x4 o; o.x = cvt_pk(v[0], v[1]); o.y = cvt_pk(v[2], v[3]); o.z = cvt_pk(v[4], v[5]); o.w = cvt_pk(v[6], v[7]);
      *(u32x4*)(d2 + (size_t)wperm(n) * 256 + kc * 8) = o;
    }
  }
  const int gw = bidx() * 8 + wid, nw = G * 8;
  for (int row = gw; row < 2048 + NTOK; row += nw) {
    const bool ismem = row < 2048;
    const float* src = ismem ? pin(p, I_MEM) + (size_t)row * DM : xin_row(p, row - 2048);
    float4 x[4]; float ss = 0.f;
#pragma unroll
    for (int i = 0; i < 4; ++i) { x[i] = *(const float4*)(src + lane * 4 + i * 256); ss += x[i].x * x[i].x + x[i].y * x[i].y + x[i].z * x[i].z + x[i].w * x[i].w; }
    ss = wave_sum(ss);
    const float rs = rsqrtf(ss * (1.f / 1024.f) + 1e-6f);
    if (ismem) {
      for (int l = 0; l < 4; ++l) {
        bfr* dst = (bfr*)(ws + WS_MEMN) + ((size_t)l * 2048 + row) * DM;
#pragma unroll
        for (int i = 0; i < 4; ++i) {
          const float4 g = *(const float4*)(pin(p, I_MNG) + l * DM + lane * 4 + i * 256);
          u32x2 o; o.x = cvt_pk(x[i].x * rs * g.x, x[i].y * rs * g.y); o.y = cvt_pk(x[i].z * rs * g.z, x[i].w * rs * g.w);
          *(u32x2*)(dst + lane * 4 + i * 256) = o;
        }
      }
    } else {
      float* xr = (float*)(ws + WS_XRES) + (size_t)(row - 2048) * DM;
#pragma unroll
      for (int i = 0; i < 4; ++i) *(float4*)(xr + lane * 4 + i * 256) = x[i];
      bfr* dst = (bfr*)(ws + WS_HA) + (size_t)(row - 2048) * DM;
#pragma unroll
      for (int i = 0; i < 4; ++i) {
        const float4 g = *(const float4*)(pin(p, I_NG) + lane * 4 + i * 256);
        u32x2 o; o.x = cvt_pk(x[i].x * rs * g.x, x[i].y * rs * g.y); o.y = cvt_pk(x[i].z * rs * g.z, x[i].w * rs * g.w);
        *(u32x2*)(dst + lane * 4 + i * 256) = o;
      }
    }
  }
}

__device__ __forceinline__ void load_xrow(const Params& p, const int g, const int lane, float4 (&x)[4]) {
  const float* s = (const float*)(p.ws + WS_XRES) + (size_t)g * DM;
#pragma unroll
  for (int i = 0; i < 4; ++i) x[i] = *(const float4*)(s + lane * 4 + i * 256);
  if (g >= NPR) {
#pragma unroll
    for (int k = 0; k < 5; ++k) {
      const float* q = (const float*)(p.ws + WS_PART) + ((size_t)k * 1024 + (g - NPR)) * DM;
#pragma unroll
      for (int i = 0; i < 4; ++i) { const float4 t = *(const float4*)(q + lane * 4 + i * 256); x[i].x += t.x; x[i].y += t.y; x[i].z += t.z; x[i].w += t.w; }
    }
  }
}
__device__ __forceinline__ void prep_phase(const Params& p, int l) {
  const int tid = tidx(), wid = tid >> 6, lane = tid & 63;
  const bool rw = (l & 1);
  const int j = l >> 1;
  const float* xres = (const float*)(p.ws + WS_XRES);
  bfr* hA = (bfr*)(p.ws + WS_HA);
  const float* ng = pin(p, I_NG) + l * DM;
  const float* mu = pin(p, I_MU) + (size_t)j * 5 * DM;
  const int gw = bidx() * 8 + wid, nw = gridDim.x * 8;
  for (int task = gw; task < NPR / 4 + 128; task += nw) {
    const int g0 = task < NPR / 4 ? task * 4 : NPR + (task - NPR / 4) * 8;
    const int nrows = task < NPR / 4 ? 4 : 8;
    float hp[16];
    if (rw) {
      const bool smp = g0 >= NPR;
      const int t0 = smp ? ((g0 - NPR) & 7) : (g0 & 2047);
      if (t0 == 0) {
        if (smp) {
          const float* s = pin(p, I_SS) + ((size_t)j * 128 + ((g0 - NPR) >> 3)) * DM;
#pragma unroll
          for (int i = 0; i < 4; ++i) { const float4 v = *(const float4*)(s + lane * 4 + i * 256); hp[i * 4] = v.x; hp[i * 4 + 1] = v.y; hp[i * 4 + 2] = v.z; hp[i * 4 + 3] = v.w; }
        } else {
#pragma unroll
          for (int i = 0; i < 16; ++i) hp[i] = 0.f;
        }
      } else {
        float4 x[4]; float ss = 0.f;
        load_xrow(p, g0 - 1, lane, x);
#pragma unroll
        for (int i = 0; i < 4; ++i) ss += x[i].x * x[i].x + x[i].y * x[i].y + x[i].z * x[i].z + x[i].w * x[i].w;
        ss = wave_sum(ss);
        const float rs = rsqrtf(ss * (1.f / 1024.f) + 1e-6f);
#pragma unroll
        for (int i = 0; i < 4; ++i) {
          const float4 g = *(const float4*)(ng + lane * 4 + i * 256);
          hp[i * 4] = x[i].x * rs * g.x; hp[i * 4 + 1] = x[i].y * rs * g.y; hp[i * 4 + 2] = x[i].z * rs * g.z; hp[i * 4 + 3] = x[i].w * rs * g.w;
        }
      }
    }
    for (int r = 0; r < nrows; ++r) {
      const int g = g0 + r;
      float4 x[4]; float ss = 0.f;
      load_xrow(p, g, lane, x);
      if (g >= NPR) {
        float* xw = (float*)(p.ws + WS_XRES) + (size_t)g * DM;
#pragma unroll
        for (int i = 0; i < 4; ++i) *(float4*)(xw + lane * 4 + i * 256) = x[i];
      }
#pragma unroll
      for (int i = 0; i < 4; ++i) ss += x[i].x * x[i].x + x[i].y * x[i].y + x[i].z * x[i].z + x[i].w * x[i].w;
      ss = wave_sum(ss);
      const float rs = rsqrtf(ss * (1.f / 1024.f) + 1e-6f);
      float h[16];
#pragma unroll
      for (int i = 0; i < 4; ++i) {
        const float4 gg = *(const float4*)(ng + lane * 4 + i * 256);
        h[i * 4] = x[i].x * rs * gg.x; h[i * 4 + 1] = x[i].y * rs * gg.y; h[i * 4 + 2] = x[i].z * rs * gg.z; h[i * 4 + 3] = x[i].w * rs * gg.w;
        u32x2 o; o.x = cvt_pk(h[i * 4], h[i * 4 + 1]); o.y = cvt_pk(h[i * 4 + 2], h[i * 4 + 3]);
        *(u32x2*)(hA + (size_t)g * DM + lane * 4 + i * 256) = o;
      }
      if (rw) {
#pragma unroll
        for (int m = 0; m < 5; ++m) {
          bfr* dst = hA + (size_t)(1 + m) * HA_SZ + (size_t)g * DM;
#pragma unroll
          for (int i = 0; i < 4; ++i) {
            const float4 mm = *(const float4*)(mu + m * DM + lane * 4 + i * 256);
            const float a0 = h[i * 4] + (hp[i * 4] - h[i * 4]) * mm.x, a1 = h[i * 4 + 1] + (hp[i * 4 + 1] - h[i * 4 + 1]) * mm.y;
            const float a2 = h[i * 4 + 2] + (hp[i * 4 + 2] - h[i * 4 + 2]) * mm.z, a3 = h[i * 4 + 3] + (hp[i * 4 + 3] - h[i * 4 + 3]) * mm.w;
            u32x2 o; o.x = cvt_pk(a0, a1); o.y = cvt_pk(a2, a3);
            *(u32x2*)(dst + lane * 4 + i * 256) = o;
          }
        }
        const bool smp = g >= NPR;
        const int t = smp ? ((g - NPR) & 7) : (g & 2047);
        if (t == (smp ? 7 : 2047)) {
          float* o = p.out + (smp ? O_SSS + ((size_t)j * 128 + ((g - NPR) >> 3)) * DM : O_SSP + ((size_t)j * 8 + (g >> 11)) * DM);
#pragma unroll
          for (int i = 0; i < 4; ++i) *(float4*)(o + lane * 4 + i * 256) = make_float4(h[i * 4], h[i * 4 + 1], h[i * 4 + 2], h[i * 4 + 3]);
        }
#pragma unroll
        for (int i = 0; i < 16; ++i) hp[i] = h[i];
      }
    }
  }
}

__device__ __forceinline__ void final_phase(const Params& p) {
  const int tid = tidx(), wid = tid >> 6, lane = tid & 63;
  const float* xres = (const float*)(p.ws + WS_XRES);
  const float* fg = pin(p, I_FG);
  const int gw = bidx() * 8 + wid, nw = gridDim.x * 8;
  for (int g = gw; g < NTOK; g += nw) {
    float4 x[4]; float ss = 0.f;
    load_xrow(p, g, lane, x);
#pragma unroll
    for (int i = 0; i < 4; ++i) ss += x[i].x * x[i].x + x[i].y * x[i].y + x[i].z * x[i].z + x[i].w * x[i].w;
    ss = wave_sum(ss);
    const float rs = rsqrtf(ss * (1.f / 1024.f) + 1e-6f);
    float* o = p.out + O_YP + (size_t)g * DM;
#pragma unroll
    for (int i = 0; i < 4; ++i) {
      const float4 gg = *(const float4*)(fg + lane * 4 + i * 256);
      *(float4*)(o + lane * 4 + i * 256) = make_float4(x[i].x * rs * gg.x, x[i].y * rs * gg.y, x[i].z * rs * gg.z, x[i].w * rs * gg.w);
    }
  }
}

constexpr int BM = 256, BK = 64, HALF = 128, HT = HALF * BK;
__device__ __forceinline__ int lds_byte(int r, int c) {
  int st = (r >> 4) * 2 + (c >> 5), rr = r & 15, cc = c & 31, ob = rr * 64 + cc * 2;
  return st * 1024 + (ob ^ (((ob >> 9) & 1) << 5));
}
__device__ __forceinline__ void stage_rc(int b, int& R, int& C) {
  int st = b / 1024, sb = b % 1024, swz = sb ^ (((sb >> 9) & 1) << 5);
  R = (st >> 1) * 16 + swz / 64; C = (st & 1) * 32 + (swz % 64) / 2;
}

enum { EM_PROJ = 0, EM_G1R, EM_MEM, EM_LUP, EM_OUT, EM_OUTA };

__device__ __forceinline__ void epilogue(const Params& p, const int mode, const int l, const f32x4 (&acc)[2][2][4][2],
                                         const int pm, const int pn, const int wr, const int wc, const int fr, const int fq) {
  const int j = (l & 255) >> 1;
#pragma unroll
  for (int ai = 0; ai < 2; ++ai)
#pragma unroll
    for (int m = 0; m < 4; ++m) {
      const int row = pm * BM + ai * HALF + wr * 64 + m * 16 + fr;
#pragma unroll
      for (int bj = 0; bj < 2; ++bj)
#pragma unroll
        for (int n = 0; n < 2; ++n) {
          const int col = pn * BM + bj * HALF + wc * 32 + fq * 8 + n * 4;
          const f32x4 v = acc[ai][bj][m][n];
          if (mode == EM_PROJ || (mode == EM_G1R && pn < 20)) {
            if (n == 0) {
              const f32x4 v1 = acc[ai][bj][m][1];
              u32x4 o; o.x = cvt_pk(v[0], v[1]); o.y = cvt_pk(v[2], v[3]); o.z = cvt_pk(v1[0], v1[1]); o.w = cvt_pk(v1[2], v1[3]);
              *(u32x4*)((bfr*)(p.ws + WS_PROJ) + (size_t)row * INC + col) = o;
            }
          } else if (mode == EM_G1R) {
            bfr* al = (bfr*)(p.ws + WS_ALORA) + (size_t)row * 256;
            const int c = col & 255;
            if (pn == 20) {
              if (c < 64) {
                float t[4];
#pragma unroll
                for (int e = 0; e < 4; ++e) { const float ex = __expf(2.f * v[e]); t[e] = 1.f - 2.f * frcp(ex + 1.f); }
                u32x2 o; o.x = cvt_pk(t[0], t[1]); o.y = cvt_pk(t[2], t[3]);
                *(u32x2*)(al + c) = o;
              }
            } else if (pn == 21) {
              const int lim = (l == 3) ? 128 : 256;
              if (64 + c < lim) {
                u32x2 o; o.x = 0u; o.y = 0u;
                if (c < 64) { o.x = cvt_pk(v[0], v[1]); o.y = cvt_pk(v[2], v[3]); }
                *(u32x2*)(al + 64 + c) = o;
              }
            } else {
              if (128 + c < 256) {
                u32x2 o; o.x = 0u; o.y = 0u;
                if (c < 32) { o.x = cvt_pk(v[0], v[1]); o.y = cvt_pk(v[2], v[3]); }
                *(u32x2*)(al + 128 + c) = o;
              }
            }
          } else if (mode == EM_MEM) {
            const int lm = pm >> 3, r2 = row & 2047;
            float* o = p.out + (col < 512 ? O_MK : O_MV) + ((size_t)lm * 2048 + r2) * 512 + (col & 511);
            *(f32x4*)o = v;
          } else if (mode == EM_LUP) {
            const int seg = col >> 10, c = col & 1023;
            float t[4];
            if (seg == 0) {
              const float4 b = *(const float4*)(pin(p, I_W0) + j * DM + c);
              const float bb[4] = {b.x, b.y, b.z, b.w};
#pragma unroll
              for (int e = 0; e < 4; ++e) {
                const float x = bb[e] + v[e];
                const float sp = fmaxf(-x, 0.f) + __logf(1.f + __expf(-fabsf(x)));
                t[e] = -__expf(-sp - 0.5f);
              }
            } else if (seg == 1) {
              const float4 b = *(const float4*)(pin(p, I_A0) + j * DM + c);
              t[0] = sigmoidf_(b.x + v[0]); t[1] = sigmoidf_(b.y + v[1]); t[2] = sigmoidf_(b.z + v[2]); t[3] = sigmoidf_(b.w + v[3]);
            } else {
              const float4 b = *(const float4*)(pin(p, I_V0) + c);
              t[0] = sigmoidf_(b.x + v[0]); t[1] = sigmoidf_(b.y + v[1]); t[2] = sigmoidf_(b.z + v[2]); t[3] = sigmoidf_(b.w + v[3]);
            }
            u32x2 o; o.x = cvt_pk(t[0], t[1]); o.y = cvt_pk(t[2], t[3]);
            *(u32x2*)((bfr*)(p.ws + WS_LUP) + (size_t)row * 3072 + col) = o;
          } else if (mode == EM_OUT) {
            float* xo = (float*)(p.ws + WS_XRES) + (size_t)row * DM + col;
            const f32x4 x = *(const f32x4*)xo;
            *(f32x4*)xo = x + v;
          } else {
            *(f32x4*)((float*)(p.ws + WS_PART) + ((size_t)((l >> 8) - 1) * 1024 + (row - NPR)) * DM + col) = v;
          }
        }
    }
}

__device__ __forceinline__ void gemm_unit(const Params& p, const bfr* __restrict__ A, const bfr* __restrict__ Bt, const int K, const int kt0, const int nt,
                                          const int pm, const int pn, const int mode, const int l) {
  extern __shared__ __attribute__((aligned(16))) char smem[];
  bfr* shm = (bfr*)smem;
#define SA(b, h) (shm + ((b) * 2 + (h)) * HT)
#define SB(b, h) (shm + (4 + (b) * 2 + (h)) * HT)
#define STAGE(P, BASE, br, kt) do { const bfr* _g = (BASE) + (size_t)(br) * K + (kt0 + (kt)) * BK + goff; \
    __builtin_amdgcn_global_load_lds((const unsigned*)_g, (unsigned*)((char*)(P) + tid * 16), 16, 0, 0); \
    __builtin_amdgcn_global_load_lds((const unsigned*)(_g + (size_t)64 * K), (unsigned*)((char*)(P) + tid * 16 + 8192), 16, 0, 0); } while (0)
#define LDA(dst, b, h) for (int m = 0; m < 4; ++m) for (int k = 0; k < 2; ++k) \
    dst[m][k] = *reinterpret_cast<const bf16x8*>((char*)SA(b, h) + lds_byte(wr * 64 + m * 16 + fr, k * 32 + fq * 8))
#define LDB(dst, b, h) for (int n = 0; n < 2; ++n) for (int k = 0; k < 2; ++k) \
    dst[n][k] = *reinterpret_cast<const bf16x8*>((char*)SB(b, h) + lds_byte(wc * 32 + n * 16 + fr, k * 32 + fq * 8))
#define MMA(ai, bj, At, Bt_) do { __builtin_amdgcn_s_setprio(1); \
    for (int m = 0; m < 4; ++m) for (int n = 0; n < 2; ++n) for (int k = 0; k < 2; ++k) \
      acc[ai][bj][m][n] = __builtin_amdgcn_mfma_f32_16x16x32_bf16(Bt_[n][k], At[m][k], acc[ai][bj][m][n], 0, 0, 0); \
    __builtin_amdgcn_s_setprio(0); } while (0)
#define WAIT_V(n) asm volatile("s_waitcnt vmcnt(" #n ")" ::: "memory")
#define WAIT_L(n) asm volatile("s_waitcnt lgkmcnt(" #n ")" ::: "memory")
#define BAR __builtin_amdgcn_s_barrier()
#define SCHED __builtin_amdgcn_sched_barrier(0)
  const int tid = tidx();
  const int brow = pm * BM, bcol = pn * BM;
  const int wid = tid >> 6, lane = tid & 63, wr = wid >> 2, wc = wid & 3, fr = lane & 15, fq = lane >> 4;
  int R0, C0; stage_rc(tid * 16, R0, C0);
  const int goff = R0 * K + C0;
  f32x4 acc[2][2][4][2] = {};
  bf16x8 At[4][2], B0[2][2], B1[2][2];
  STAGE(SB(0, 0), Bt, bcol, 0); STAGE(SA(0, 0), A, brow, 0);
  STAGE(SB(0, 1), Bt, bcol + HALF, 0); STAGE(SA(0, 1), A, brow + HALF, 0);
  if (wr == 1) BAR;
  WAIT_V(4); BAR;
  STAGE(SB(1, 0), Bt, bcol, 1); STAGE(SA(1, 0), A, brow, 1); STAGE(SB(1, 1), Bt, bcol + HALF, 1);
  WAIT_V(6); BAR;
  for (int t = 0; t < nt - 2; t += 2) {
    LDB(B0, 0, 0); SCHED; LDA(At, 0, 0); STAGE(SA(1, 1), A, brow + HALF, t + 1);
    WAIT_L(8); BAR; WAIT_L(0); MMA(0, 0, At, B0); BAR; SCHED;
    LDB(B1, 0, 1); STAGE(SB(0, 0), Bt, bcol, t + 2);
    BAR; WAIT_L(0); MMA(0, 1, At, B1); BAR;
    LDA(At, 0, 1); STAGE(SA(0, 0), A, brow, t + 2);
    BAR; WAIT_L(0); MMA(1, 0, At, B0); BAR; SCHED;
    STAGE(SB(0, 1), Bt, bcol + HALF, t + 2);
    WAIT_V(6); BAR; MMA(1, 1, At, B1); BAR;
    LDB(B0, 1, 0); SCHED; LDA(At, 1, 0); STAGE(SA(0, 1), A, brow + HALF, t + 2);
    WAIT_L(8); BAR; WAIT_L(0); MMA(0, 0, At, B0); BAR; SCHED;
    LDB(B1, 1, 1); STAGE(SB(1, 0), Bt, bcol, t + 3);
    BAR; WAIT_L(0); MMA(0, 1, At, B1); BAR;
    LDA(At, 1, 1); STAGE(SA(1, 0), A, brow, t + 3);
    BAR; WAIT_L(0); MMA(1, 0, At, B0); BAR; SCHED;
    STAGE(SB(1, 1), Bt, bcol + HALF, t + 3);
    WAIT_V(6); BAR; MMA(1, 1, At, B1); BAR;
  }
  { LDB(B0, 0, 0); LDA(At, 0, 0); STAGE(SA(1, 1), A, brow + HALF, nt - 1);
    BAR; WAIT_L(0); MMA(0, 0, At, B0); BAR;
    LDB(B1, 0, 1); BAR; WAIT_L(0); MMA(0, 1, At, B1); BAR;
    LDA(At, 0, 1); WAIT_V(4); BAR; WAIT_L(0); MMA(1, 0, At, B0); MMA(1, 1, At, B1); BAR; }
  { LDB(B0, 1, 0); LDA(At, 1, 0); WAIT_V(2); BAR; WAIT_L(0); MMA(0, 0, At, B0); BAR;
    LDB(B1, 1, 1); WAIT_V(0); BAR; WAIT_L(0); MMA(0, 1, At, B1); BAR;
    LDA(At, 1, 1); BAR; WAIT_L(0); MMA(1, 0, At, B0); MMA(1, 1, At, B1); BAR; }
  if (wr == 0) BAR;
  epilogue(p, mode, l, acc, pm, pn, wr, wc, fr, fq);
  WAIT_V(0);
#undef SA
#undef SB
}

__device__ __forceinline__ bool unit_order(int i, int c, int G, int nM, int nN, int& pm, int& pn) {
  const int nwg = nM * nN;
  const long L = (long)i * G + c; if (L >= nwg) return false;
  int wgid = (int)L; { const int q = nwg / 8, r = nwg % 8, xcd = wgid % 8, off = wgid / 8; wgid = (xcd < r ? xcd * (q + 1) : r * (q + 1) + (xcd - r) * q) + off; }
  const int nig = 8 * nN, gid = wgid / nig, fm = gid * 8, gsz = (nM - fm) < 8 ? (nM - fm) : 8;
  pm = fm + ((wgid % nig) % gsz); pn = (wgid % nig) / gsz; return true;
}

__device__ __forceinline__ void gemm_phase(const Params& p, const int kind, const int l) {
  const int G = gridDim.x;
  const int j = l >> 1;
  const bool rw = l & 1;
  char* ws = p.ws;
  const bfr* hA = (const bfr*)(ws + WS_HA);
  int nM = NTOK / BM, nN, K, mode;
  const bfr* Bt;
  if (kind == 0) { nN = rw ? (l == 3 ? 23 : 22) : 20; K = 1024; mode = rw ? EM_G1R : EM_PROJ; Bt = (const bfr*)(ws + WS_WTIN) + l * WTIN_L; }
  else if (kind == 1) { nN = (l == 3) ? 12 : 8; K = 256; mode = EM_LUP; Bt = (const bfr*)(ws + WS_W2T) + (size_t)j * 3072 * 256; }
  else { nN = 4; K = 1536; mode = EM_OUT; Bt = (const bfr*)(ws + WS_WTOUT) + (size_t)l * DM * BRW; }
  int pm, pn;
  const int nwg1 = nM * nN;
  const bool withmem = (kind == 0 && l == 0);
  const int c2 = (bidx() + G - (nwg1 % G)) % G;
  int seg = 0, i = 0;
  for (;;) {
    const bfr* A; const bfr* B = Bt; int KK = K, md = mode, kt0 = 0, nt = K / BK, lk = l;
    if (kind == 2) {
      const int t = bidx() + G * i;
      if (t >= 256 + 96) break;
      ++i;
      A = (const bfr*)(ws + WS_BRANCH);
      if (t < 256) { pm = (t & 7) * 8 + (t >> 5); pn = (t >> 3) & 3; }
      else { const int v = t - 256, rem = v % 24, ks = rem % 6; pm = 64 + v / 24; pn = rem / 6; kt0 = ks * 4; nt = 4; if (ks) { md = EM_OUTA; lk = l | (ks << 8); } }
    } else {
      bool ok;
      if (seg == 0) ok = unit_order(i, bidx(), G, nM, nN, pm, pn);
      else ok = unit_order(i, c2, G, 32, 4, pm, pn);
      if (!ok) { if (seg == 0 && withmem) { seg = 1; i = 0; continue; } break; }
      ++i;
      if (seg == 1) { A = (const bfr*)(ws + WS_MEMN); B = (const bfr*)(ws + WS_WTMEM) + (size_t)(pm >> 3) * DM * DM; KK = 1024; nt = 16; md = EM_MEM; }
      else if (kind == 0) {
        int sel = 0;
        if (rw) sel = pn < 4 ? 1 : pn < 8 ? 3 : pn < 12 ? 4 : pn < 20 ? 0 : pn == 20 ? 2 : pn == 21 ? 5 : 4;
        A = hA + (size_t)sel * HA_SZ;
      } else A = (const bfr*)(ws + WS_ALORA);
    }
    gemm_unit(p, A, B, KK, kt0, nt, pm, pn, md, lk);
  }
}

__device__ __forceinline__ void xattn_unit(const Params& p, const float* __restrict__ kb, const float* __restrict__ vb, const int g0, const int ntok, const int head) {
  extern __shared__ __attribute__((aligned(16))) char smem[];
  bfr* Ks = (bfr*)smem;
  bfr* Vt = Ks + 256 * 136;
  const int tid = tidx(), wid = tid >> 6, lane = tid & 63, fr = lane & 15, fq = lane >> 4;
#pragma unroll 4
  for (int i = 0; i < 16; ++i) {
    const int idx = tid + i * 512, row = idx >> 5, c4 = (idx & 31) << 2;
    const float4 v = *(const float4*)(kb + (size_t)row * 512 + c4);
    u32x2 o; o.x = cvt_pk(v.x, v.y); o.y = cvt_pk(v.z, v.w);
    *(u32x2*)(Ks + row * 136 + c4) = o;
  }
  {
    const int pp = lane & 7, dd = lane >> 3;
#pragma unroll 4
    for (int it = 0; it < 8; ++it) {
      const int wq = it * 8 + wid, mb = wq & 15, db = wq >> 4;
      const int m0 = mb * 16 + 2 * pp, d0 = db * 32 + dd * 4;
      const float4 a = *(const float4*)(vb + (size_t)m0 * 512 + d0);
      const float4 b = *(const float4*)(vb + (size_t)(m0 + 1) * 512 + d0);
      *(unsigned*)(Vt + (d0 + 0) * 260 + m0) = cvt_pk(a.x, b.x);
      *(unsigned*)(Vt + (d0 + 1) * 260 + m0) = cvt_pk(a.y, b.y);
      *(unsigned*)(Vt + (d0 + 2) * 260 + m0) = cvt_pk(a.z, b.z);
      *(unsigned*)(Vt + (d0 + 3) * 260 + m0) = cvt_pk(a.w, b.w);
    }
  }
  __syncthreads();
  if (wid * 16 < ntok) {
    const bfr* proj = (const bfr*)(p.ws + WS_PROJ);
    int tl = wid * 16 + fr; if (tl > ntok - 1) tl = ntok - 1;
    const bfr* qrow = proj + (size_t)(g0 + tl) * INC + 3072 + head * 128;
    bf16x8 qf[4];
#pragma unroll
    for (int ks = 0; ks < 4; ++ks) qf[ks] = *(const bf16x8*)(qrow + ks * 32 + fq * 8);
    f32x4 sc[16];
#pragma unroll
    for (int mt = 0; mt < 16; ++mt) {
      f32x4 a = {0.f, 0.f, 0.f, 0.f};
#pragma unroll
      for (int ks = 0; ks < 4; ++ks) {
        const bf16x8 kf = *(const bf16x8*)(Ks + (mt * 16 + fr) * 136 + ks * 32 + fq * 8);
        a = __builtin_amdgcn_mfma_f32_16x16x32_bf16(kf, qf[ks], a, 0, 0, 0);
      }
      sc[mt] = a;
    }
    float mx = -3.0e38f;
#pragma unroll
    for (int mt = 0; mt < 16; ++mt) mx = fmaxf(mx, fmaxf(fmaxf(sc[mt][0], sc[mt][1]), fmaxf(sc[mt][2], sc[mt][3])));
    mx = fmaxf(mx, bperm(mx, lane ^ 16)); mx = fmaxf(mx, bperm(mx, lane ^ 32));
    const float cs = 0.08838834764831845f * 1.4426950408889634f;
    float sum = 0.f;
#pragma unroll
    for (int mt = 0; mt < 16; ++mt)
#pragma unroll
      for (int e = 0; e < 4; ++e) { const float pe = exp2f((sc[mt][e] - mx) * cs); sc[mt][e] = pe; sum += pe; }
    sum += bperm(sum, lane ^ 16); sum += bperm(sum, lane ^ 32);
    const float inv = frcp(sum);
    bf16x8 pf[8];
#pragma unroll
    for (int u = 0; u < 8; ++u) {
      u32x4 w; w.x = cvt_pk(sc[2 * u][0], sc[2 * u][1]); w.y = cvt_pk(sc[2 * u][2], sc[2 * u][3]);
      w.z = cvt_pk(sc[2 * u + 1][0], sc[2 * u + 1][1]); w.w = cvt_pk(sc[2 * u + 1][2], sc[2 * u + 1][3]);
      pf[u] = __builtin_bit_cast(bf16x8, w);
    }
    const bool tvalid = (wid * 16 + fr) < ntok;
    const int g = g0 + tl;
    const bfr* gate = proj + (size_t)g * INC + 3584 + 1024 + head * 128;
    bfr* br = (bfr*)(p.ws + WS_BRANCH) + (size_t)g * BRW + 1024 + head * 128;
#pragma unroll
    for (int dt = 0; dt < 8; ++dt) {
      f32x4 a = {0.f, 0.f, 0.f, 0.f};
#pragma unroll
      for (int u = 0; u < 8; ++u) {
        const bfr* vr = Vt + (dt * 16 + fr) * 260 + fq * 4;
        u32x4 w;
        const u32x2 lo = *(const u32x2*)(vr + (2 * u) * 16), hi = *(const u32x2*)(vr + (2 * u + 1) * 16);
        w.x = lo.x; w.y = lo.y; w.z = hi.x; w.w = hi.y;
        a = __builtin_amdgcn_mfma_f32_16x16x32_bf16(__builtin_bit_cast(bf16x8, w), pf[u], a, 0, 0, 0);
      }
      if (tvalid) {
        const u32x2 gw = *(const u32x2*)(gate + dt * 16 + fq * 4);
        const float g0f = bflo(gw.x), g1f = bfhi(gw.x), g2f = bflo(gw.y), g3f = bfhi(gw.y);
        u32x2 o;
        o.x = cvt_pk(a[0] * inv * g0f * sigmoidf_(g0f), a[1] * inv * g1f * sigmoidf_(g1f));
        o.y = cvt_pk(a[2] * inv * g2f * sigmoidf_(g2f), a[3] * inv * g3f * sigmoidf_(g3f));
        *(u32x2*)(br + dt * 16 + fq * 4) = o;
      }
    }
  }
  __syncthreads();
}

struct HgRaw { u32x2 q, f, v, g; };
__device__ __forceinline__ void hg_load(HgRaw& r, const bfr* __restrict__ proj, const int g0, const int T, const int sbi, const int h,
                                        const int wid, const int fr, const int fq, const int tid) {
  const int t0 = sbi * 16;
  if (t0 + fr < T) {
    const bfr* pr = proj + (size_t)(g0 + t0 + fr) * INC + h * 128 + wid * 16 + fq * 4;
    r.q = *(const u32x2*)pr; r.f = *(const u32x2*)(pr + 1024); r.g = *(const u32x2*)(pr + 3584);
  }
  const int vt = tid >> 5, dv4 = (tid & 31) << 2;
  if (t0 + vt < T) r.v = *(const u32x2*)(proj + (size_t)(g0 + t0 + vt) * INC + 2048 + h * 128 + dv4);
}
constexpr int HG_SET = 16 * 136 * 2 + 128 * 16 * 2;

__device__ __forceinline__ void hgrn_unit(const Params& p, const int l, const bool smp, const int b, const int h) {
  extern __shared__ __attribute__((aligned(16))) char smem[];
  bfr* lds0 = (bfr*)smem;
  float* decb = (float*)(lds0 + 2 * HG_SET);
  float* redb = decb + 256;
  const int tid = tidx(), wid = tid >> 6, lane = tid & 63, fr = lane & 15, fq = lane >> 4;
  const int j = l >> 1;
  const bfr* proj = (const bfr*)(p.ws + WS_PROJ);
  bfr* branch = (bfr*)(p.ws + WS_BRANCH);
  const int g0 = smp ? NPR + b * 8 : b * 2048;
  const int T = smp ? 8 : 2048;
  const int nsub = (T + 15) >> 4;
  f32x4 S[8];
  if (smp) {
    const float* s0 = pin(p, I_SH) + (((size_t)j * 128 + b) * 8 + h) * 16384;
#pragma unroll
    for (int kt = 0; kt < 8; ++kt)
#pragma unroll
      for (int e = 0; e < 4; ++e) S[kt][e] = s0[(kt * 16 + fq * 4 + e) * 128 + wid * 16 + fr];
  } else {
#pragma unroll
    for (int kt = 0; kt < 8; ++kt) S[kt] = (f32x4){0.f, 0.f, 0.f, 0.f};
  }
  const int dkp = wid * 16 + fq * 4;
  float lb[4];
#pragma unroll
  for (int e = 0; e < 4; ++e) {
    if (j == 0) lb[e] = 0.f;
    else { const int c = h * 128 + dkp + e; lb[e] = sigmoidf_(pin(p, I_LB)[1024 + c] - pin(p, I_LB)[c]); }
  }
  float og[4];
#pragma unroll
  for (int e = 0; e < 4; ++e) og[e] = pin(p, I_ONG)[j * 128 + wid * 16 + fq * 4 + e];

  HgRaw raw[4];
#pragma unroll
  for (int u = 0; u < 4; ++u) { raw[u].q = raw[u].f = raw[u].v = raw[u].g = (u32x2){0u, 0u}; hg_load(raw[u], proj, g0, T, u, h, wid, fr, fq, tid); }
  u32x2 gsave[2] = {(u32x2){0u, 0u}, (u32x2){0u, 0u}};
  f32x4 oprev = {0.f, 0.f, 0.f, 0.f};

  for (int i4 = 0; i4 < nsub; i4 += 4) {
#pragma unroll
    for (int u = 0; u < 4; ++u) {
      const int i = i4 + u;
      if (i < nsub) {
        const int s = u & 1;
        bfr* Qs = lds0 + s * HG_SET; bfr* Kh = Qs + 16 * 136; bfr* Kt = Kh + 16 * 136; bfr* Vt = Kt + 128 * 16;
        float* dec = decb + s * 128; float* red = redb + s * 128;
        {
          const int sb = i * 16;
          const bool valid = (sb + fr) < T;
          float q[4], P[4], kv[4];
          const float qz[4] = {bflo(raw[u].q.x), bfhi(raw[u].q.x), bflo(raw[u].q.y), bfhi(raw[u].q.y)};
          const float fz[4] = {bflo(raw[u].f.x), bfhi(raw[u].f.x), bflo(raw[u].f.y), bfhi(raw[u].f.y)};
#pragma unroll
          for (int e = 0; e < 4; ++e) {
            const float sg = sigmoidf_(fz[e]);
            const float f = fmaxf(lb[e] + (1.f - lb[e]) * sg, 1e-30f);
            P[e] = valid ? f : 1.f;
            kv[e] = valid ? (1.f - lb[e]) * (1.f - sg) : 0.f;
            q[e] = valid ? qz[e] * sigmoidf_(qz[e]) : 0.f;
          }
#pragma unroll
          for (int e = 0; e < 4; ++e) {
            P[e] *= __builtin_bit_cast(float, __builtin_amdgcn_update_dpp(0x3f800000, __builtin_bit_cast(int, P[e]), 0x111, 0xf, 0xf, false));
            P[e] *= __builtin_bit_cast(float, __builtin_amdgcn_update_dpp(0x3f800000, __builtin_bit_cast(int, P[e]), 0x112, 0xf, 0xf, false));
            P[e] *= __builtin_bit_cast(float, __builtin_amdgcn_update_dpp(0x3f800000, __builtin_bit_cast(int, P[e]), 0x114, 0xf, 0xf, false));
            P[e] *= __builtin_bit_cast(float, __builtin_amdgcn_update_dpp(0x3f800000, __builtin_bit_cast(int, P[e]), 0x118, 0xf, 0xf, false));
          }
          float qt[4], kh[4], kt[4];
#pragma unroll
          for (int e = 0; e < 4; ++e) {
            const float Pl = bperm(P[e], lane | 15);
            const float inv = frcp(fmaxf(P[e], 1e-30f));
            qt[e] = q[e] * P[e]; kh[e] = kv[e] * inv; kt[e] = kh[e] * Pl;
          }
          if (fr == 15) *(f32x4*)(dec + dkp) = (f32x4){P[0], P[1], P[2], P[3]};
          const int kpos = (wid >> 1) * 32 + fq * 8 + (wid & 1) * 4;
          u32x2 o; o.x = cvt_pk(qt[0], qt[1]); o.y = cvt_pk(qt[2], qt[3]);
          *(u32x2*)(Qs + fr * 136 + kpos) = o;
          o.x = cvt_pk(kh[0], kh[1]); o.y = cvt_pk(kh[2], kh[3]);
          *(u32x2*)(Kh + fr * 136 + kpos) = o;
          { const unsigned k01 = cvt_pk(kt[0], kt[1]), k23 = cvt_pk(kt[2], kt[3]);
            Kt[(dkp + 0) * 16 + fr] = (bfr)(k01 & 0xffff); Kt[(dkp + 1) * 16 + fr] = (bfr)(k01 >> 16);
            Kt[(dkp + 2) * 16 + fr] = (bfr)(k23 & 0xffff); Kt[(dkp + 3) * 16 + fr] = (bfr)(k23 >> 16); }
          const int vt = tid >> 5, dv4 = (tid & 31) << 2;
          const bool vv = (sb + vt) < T;
          const unsigned vx = vv ? raw[u].v.x : 0u, vy = vv ? raw[u].v.y : 0u;
          Vt[(dv4 + 0) * 16 + vt] = (bfr)(vx & 0xffff); Vt[(dv4 + 1) * 16 + vt] = (bfr)(vx >> 16);
          Vt[(dv4 + 2) * 16 + vt] = (bfr)(vy & 0xffff); Vt[(dv4 + 3) * 16 + vt] = (bfr)(vy >> 16);
          gsave[s] = raw[u].g;
          hg_load(raw[u], proj, g0, T, i + 4, h, wid, fr, fq, tid);
        }
        __syncthreads();
        if (i > 0) {
          const float* redp = redb + (s ^ 1) * 128;
          float tot = 0.f;
#pragma unroll
          for (int w = 0; w < 8; ++w) tot += redp[fr * 8 + w];
          const float rs = rsqrtf(tot * (1.f / 128.f) + 1e-6f);
          const int tk = (i - 1) * 16 + fr;
          if (tk < T) {
            const u32x2 gw = gsave[s ^ 1];
            const float gg[4] = {bflo(gw.x), bfhi(gw.x), bflo(gw.y), bfhi(gw.y)};
            float r[4];
#pragma unroll
            for (int e = 0; e < 4; ++e) r[e] = oprev[e] * rs * og[e] * gg[e] * sigmoidf_(gg[e]);
            u32x2 o; o.x = cvt_pk(r[0], r[1]); o.y = cvt_pk(r[2], r[3]);
            *(u32x2*)(branch + (size_t)(g0 + tk) * BRW + h * 128 + wid * 16 + fq * 4) = o;
          }
        }
        {
          bf16x8 qp[4], kp[4];
#pragma unroll
          for (int uu = 0; uu < 4; ++uu) {
            qp[uu] = *(const bf16x8*)(Qs + fr * 136 + uu * 32 + fq * 8);
            kp[uu] = *(const bf16x8*)(Kh + fr * 136 + uu * 32 + fq * 8);
          }
          f32x4 at = {0.f, 0.f, 0.f, 0.f};
#pragma unroll
          for (int uu = 0; uu < 4; ++uu) at = __builtin_amdgcn_mfma_f32_16x16x32_bf16(kp[uu], qp[uu], at, 0, 0, 0);
#pragma unroll
          for (int e = 0; e < 4; ++e) if (fq * 4 + e > fr) at[e] = 0.f;
          u32x2 aw; aw.x = cvt_pk(at[0], at[1]); aw.y = cvt_pk(at[2], at[3]);
          const bf16x4 a4 = __builtin_bit_cast(bf16x4, aw);
          const bf16x4 vf = *(const bf16x4*)(Vt + (wid * 16 + fr) * 16 + fq * 4);
          const bf16x8 vf8 = {vf[0], vf[1], vf[2], vf[3], 0, 0, 0, 0}, a8 = {a4[0], a4[1], a4[2], a4[3], 0, 0, 0, 0};
          f32x4 oacc = __builtin_amdgcn_mfma_f32_16x16x32_bf16(vf8, a8, (f32x4){0.f, 0.f, 0.f, 0.f}, 0, 0, 0);
#pragma unroll
          for (int uu = 0; uu < 4; ++uu) {
            u32x4 w; w.x = cvt_pk(S[2 * uu][0], S[2 * uu][1]); w.y = cvt_pk(S[2 * uu][2], S[2 * uu][3]);
            w.z = cvt_pk(S[2 * uu + 1][0], S[2 * uu + 1][1]); w.w = cvt_pk(S[2 * uu + 1][2], S[2 * uu + 1][3]);
            oacc = __builtin_amdgcn_mfma_f32_16x16x32_bf16(__builtin_bit_cast(bf16x8, w), qp[uu], oacc, 0, 0, 0);
          }
#pragma unroll
          for (int kt = 0; kt < 8; ++kt) {
            const f32x4 d = *(const f32x4*)(dec + kt * 16 + fq * 4);
            const bf16x4 kf = *(const bf16x4*)(Kt + (kt * 16 + fr) * 16 + fq * 4);
            const bf16x8 kf8 = {kf[0], kf[1], kf[2], kf[3], 0, 0, 0, 0};
            S[kt] = __builtin_amdgcn_mfma_f32_16x16x32_bf16(kf8, vf8, S[kt] * d, 0, 0, 0);
          }
          float ss = oacc[0] * oacc[0] + oacc[1] * oacc[1] + oacc[2] * oacc[2] + oacc[3] * oacc[3];
          ss += bperm(ss, lane ^ 16); ss += bperm(ss, lane ^ 32);
          if (fq == 0) red[fr * 8 + wid] = ss;
          oprev = oacc;
        }
      }
    }
  }
  __syncthreads();
  {
    const int i = nsub - 1, s = i & 1;
    const float* redp = redb + s * 128;
    float tot = 0.f;
#pragma unroll
    for (int w = 0; w < 8; ++w) tot += redp[fr * 8 + w];
    const float rs = rsqrtf(tot * (1.f / 128.f) + 1e-6f);
    const int tk = i * 16 + fr;
    if (tk < T) {
      const u32x2 gw = gsave[s];
      const float gg[4] = {bflo(gw.x), bfhi(gw.x), bflo(gw.y), bfhi(gw.y)};
      float r[4];
#pragma unroll
      for (int e = 0; e < 4; ++e) r[e] = oprev[e] * rs * og[e] * gg[e] * sigmoidf_(gg[e]);
      u32x2 o; o.x = cvt_pk(r[0], r[1]); o.y = cvt_pk(r[2], r[3]);
      *(u32x2*)(branch + (size_t)(g0 + tk) * BRW + h * 128 + wid * 16 + fq * 4) = o;
    }
  }
  float* so = p.out + (smp ? O_SHS + (((size_t)j * 128 + b) * 8 + h) * 16384 : O_SHP + (((size_t)j * 8 + b) * 8 + h) * 16384);
#pragma unroll
  for (int kt = 0; kt < 8; ++kt)
#pragma unroll
    for (int e = 0; e < 4; ++e) so[(kt * 16 + fq * 4 + e) * 128 + wid * 16 + fr] = S[kt][e];
  __syncthreads();
}

#define LDS_BARRIER() do { asm volatile("s_waitcnt lgkmcnt(0)" ::: "memory"); __builtin_amdgcn_s_barrier(); asm volatile("" ::: "memory"); } while (0)
typedef float f32x2 __attribute__((ext_vector_type(2)));
struct RwRaw { u32x2 r, k, v, gt, ew, a, vg, vf; };
constexpr int RW_SET = 7 * 1024;
struct RwCtx {
  const bfr* proj; const bfr* lup; const bfr* vfsrc; bfr* vdst; bfr* branch;
  int vgoff, vfld;
  int g0, T, tsl, cq4, C4;
  f32x4 kkw, kaw, rkw, lng, lnb;
};
__device__ __forceinline__ float sum16(float v) {
  v += dppf<0xB1>(v); v += dppf<0x4E>(v); v += dppf<0x141>(v); v += dppf<0x140>(v);
  return v;
}
__device__ __forceinline__ f32x4 unpk4(const u32x2 w) { return (f32x4){bflo(w.x), bfhi(w.x), bflo(w.y), bfhi(w.y)}; }
__device__ __forceinline__ void rw_load(RwRaw& raw, const RwCtx& c, const int tile) {
  int tok = tile * 16 + c.tsl; tok = tok < c.T ? tok : c.T - 1;
  const size_t g = (size_t)(c.g0 + tok);
  const bfr* pr = c.proj + g * INC + c.C4;
  raw.r = *(const u32x2*)pr; raw.k = *(const u32x2*)(pr + 1024); raw.v = *(const u32x2*)(pr + 2048); raw.gt = *(const u32x2*)(pr + 3584);
  const bfr* pl = c.lup + g * 3072 + c.C4;
  raw.ew = *(const u32x2*)pl; raw.a = *(const u32x2*)(pl + 1024); raw.vg = *(const u32x2*)(pl + c.vgoff);
  raw.vf = *(const u32x2*)(c.vfsrc + g * c.vfld + c.C4);
}
__device__ __forceinline__ void rw_prep(const RwRaw& raw, f32x4& bon, f32x4& gt, float* __restrict__ L, const RwCtx& c, const int tile) {
  int tok = tile * 16 + c.tsl; tok = tok < c.T ? tok : c.T - 1;
  const int tt = tok & 15;
  const size_t g = (size_t)(c.g0 + tok);
  const f32x4 r = unpk4(raw.r), k = unpk4(raw.k), ew = unpk4(raw.ew), a = unpk4(raw.a);
  f32x4 v = unpk4(raw.v);
  *(u32x2*)(c.vdst + g * DM + c.C4) = raw.v;
  v = v + (unpk4(raw.vf) - v) * unpk4(raw.vg);
  f32x4 dcy; dcy[0] = __expf(ew[0]); dcy[1] = __expf(ew[1]); dcy[2] = __expf(ew[2]); dcy[3] = __expf(ew[3]);
  f32x4 kk = k * c.kkw;
  const float n2 = sum16((kk[0] * kk[0] + kk[1] * kk[1]) + (kk[2] * kk[2] + kk[3] * kk[3]));
  const float inv = __builtin_amdgcn_rsqf(fmaxf(n2, 1e-24f));
  kk = kk * inv;
  const f32x4 k2 = k * (1.f + (a - 1.f) * c.kaw);
  const f32x4 rk = r * k2 * c.rkw;
  const float sb = sum16((rk[0] + rk[1]) + (rk[2] + rk[3]));
  bon = v * sb;
  gt = unpk4(raw.gt);
  const int o = tt * 64 + c.cq4;
  *(f32x4*)(L + 0 * 1024 + o) = r; *(f32x4*)(L + 1 * 1024 + o) = dcy; *(f32x4*)(L + 2 * 1024 + o) = k2; *(f32x4*)(L + 3 * 1024 + o) = v;
  *(f32x4*)(L + 4 * 1024 + o) = -kk; *(f32x4*)(L + 5 * 1024 + o) = kk * a;
}
__device__ __forceinline__ void rw_post(const f32x4 bon, const f32x4 gt, const float* __restrict__ L, const RwCtx& c, const int tile) {
  int tok = tile * 16 + c.tsl; tok = tok < c.T ? tok : c.T - 1;
  const int tt = tok & 15;
  const size_t g = (size_t)(c.g0 + tok);
  const f32x4 y = *(const f32x4*)(L + 6 * 1024 + tt * 64 + c.cq4);
  const float mean = sum16((y[0] + y[1]) + (y[2] + y[3])) * (1.f / 64.f);
  const f32x4 d = y - mean;
  const float var = sum16((d[0] * d[0] + d[1] * d[1]) + (d[2] * d[2] + d[3] * d[3])) * (1.f / 64.f);
  f32x4 o = d * rsqrtf(var + 64e-5f) * c.lng + c.lnb + bon;
  o[0] *= gt[0] * sigmoidf_(gt[0]); o[1] *= gt[1] * sigmoidf_(gt[1]); o[2] *= gt[2] * sigmoidf_(gt[2]); o[3] *= gt[3] * sigmoidf_(gt[3]);
  u32x2 w; w.x = cvt_pk(o[0], o[1]); w.y = cvt_pk(o[2], o[3]);
  *(u32x2*)(c.branch + g * BRW + c.C4) = w;
}
struct RwVec { f32x4 r0, r1, w0, w1, k0, k1, a0, a1, b0, b1; float v; };
__device__ __forceinline__ void rw_ldvec(RwVec& x, const float* __restrict__ L, const int t, const int row, const int c0) {
  x.r0 = *(const f32x4*)(L + 0 * 1024 + t * 64 + c0); x.r1 = *(const f32x4*)(L + 0 * 1024 + t * 64 + c0 + 4);
  x.w0 = *(const f32x4*)(L + 1 * 1024 + t * 64 + c0); x.w1 = *(const f32x4*)(L + 1 * 1024 + t * 64 + c0 + 4);
  x.k0 = *(const f32x4*)(L + 2 * 1024 + t * 64 + c0); x.k1 = *(const f32x4*)(L + 2 * 1024 + t * 64 + c0 + 4);
  x.v = L[3 * 1024 + t * 64 + row];
  x.a0 = *(const f32x4*)(L + 4 * 1024 + t * 64 + c0); x.a1 = *(const f32x4*)(L + 4 * 1024 + t * 64 + c0 + 4);
  x.b0 = *(const f32x4*)(L + 5 * 1024 + t * 64 + c0); x.b1 = *(const f32x4*)(L + 5 * 1024 + t * 64 + c0 + 4);
}
template <int NST>
__device__ __forceinline__ void rw_scan(f32x2 (&S)[4], float* __restrict__ L, const int row, const int c0, const int cg) {
  RwVec cur, nxt;
  rw_ldvec(cur, L, 0, row, c0);
  float yp[NST / 2], ra[NST / 2];
  const bool hi = (cg & 4) != 0, b1 = (cg & 2) != 0, b0 = (cg & 1) != 0;
#pragma unroll
  for (int t = 0; t < NST; ++t) {
    if (t + 1 < NST) rw_ldvec(nxt, L, t + 1, row, c0);
    const f32x2 av[4] = {{cur.a0[0], cur.a0[1]}, {cur.a0[2], cur.a0[3]}, {cur.a1[0], cur.a1[1]}, {cur.a1[2], cur.a1[3]}};
    const f32x2 wv[4] = {{cur.w0[0], cur.w0[1]}, {cur.w0[2], cur.w0[3]}, {cur.w1[0], cur.w1[1]}, {cur.w1[2], cur.w1[3]}};
    const f32x2 bv[4] = {{cur.b0[0], cur.b0[1]}, {cur.b0[2], cur.b0[3]}, {cur.b1[0], cur.b1[1]}, {cur.b1[2], cur.b1[3]}};
    const f32x2 kv[4] = {{cur.k0[0], cur.k0[1]}, {cur.k0[2], cur.k0[3]}, {cur.k1[0], cur.k1[1]}, {cur.k1[2], cur.k1[3]}};
    const f32x2 rv[4] = {{cur.r0[0], cur.r0[1]}, {cur.r0[2], cur.r0[3]}, {cur.r1[0], cur.r1[1]}, {cur.r1[2], cur.r1[3]}};
    const f32x2 vi2 = {cur.v, cur.v};
    f32x2 pa = S[0] * av[0] + S[1] * av[1];
    const f32x2 pb = S[2] * av[2] + S[3] * av[3];
    f32x2 n[4];
#pragma unroll
    for (int q = 0; q < 4; ++q) n[q] = S[q] * wv[q] + vi2 * kv[q];
    pa += pb;
    const float sa = sum8(pa[0] + pa[1]);
    const f32x2 sa2 = {sa, sa};
#pragma unroll
    for (int q = 0; q < 4; ++q) S[q] = sa2 * bv[q] + n[q];
    f32x2 ya = S[0] * rv[0] + S[1] * rv[1];
    const f32x2 yb = S[2] * rv[2] + S[3] * rv[3];
    ya += yb;
    if (t < NST / 2) yp[t] = ya[0] + ya[1];
    else { const float lo = yp[t - NST / 2], hv = ya[0] + ya[1]; const float mine = hi ? hv : lo, send = hi ? lo : hv; ra[t - NST / 2] = mine + dppf<0x141>(send); }
    cur = nxt;
  }
  float rb[NST / 4], rc[NST / 8];
#pragma unroll
  for (int k = 0; k < NST / 4; ++k) { const float mine = b1 ? ra[k + NST / 4] : ra[k], send = b1 ? ra[k] : ra[k + NST / 4]; rb[k] = mine + dppf<0x4E>(send); }
#pragma unroll
  for (int k = 0; k < NST / 8; ++k) { const float mine = b0 ? rb[k + NST / 8] : rb[k], send = b0 ? rb[k] : rb[k + NST / 8]; rc[k] = mine + dppf<0xB1>(send); }
  const int base = (hi ? NST / 2 : 0) + (b1 ? NST / 4 : 0) + (b0 ? NST / 8 : 0);
#pragma unroll
  for (int k = 0; k < NST / 8; ++k) L[6 * 1024 + (base + k) * 64 + row] = rc[k];
}

__device__ __forceinline__ void rwkv_unit(const Params& p, const int l, const bool smp, const int b, const int head) {
  extern __shared__ __attribute__((aligned(16))) char smem[];
  float* L0 = (float*)smem;
  float* L1 = L0 + RW_SET;
  RwCtx c;
  const int tid = tidx();
  const int wid = tid >> 6, lane = tid & 63;
  const int j = l >> 1;
  c.proj = (const bfr*)(p.ws + WS_PROJ);
  c.lup = (const bfr*)(p.ws + WS_LUP);
  c.vfsrc = (j == 0) ? c.proj + 2048 : (const bfr*)(p.ws + WS_VFIRST);
  c.vfld = (j == 0) ? INC : DM;
  c.vgoff = (j == 0) ? 1024 : 2048;
  c.vdst = (j == 0) ? (bfr*)(p.ws + WS_VFIRST) : (bfr*)(p.ws + WS_HA + 2 * HA_SZ * 2);
  c.branch = (bfr*)(p.ws + WS_BRANCH);
  c.g0 = smp ? NPR + b * 8 : b * 2048;
  c.T = smp ? 8 : 2048;
  c.tsl = 2 * wid + ((lane >> 4) & 1);
  c.cq4 = (lane & 15) * 4;
  c.C4 = head * 64 + c.cq4;
  const int cg = lane & 7, row = wid * 8 + (lane >> 3), c0 = cg * 8;
  f32x2 S[4];
  if (smp) {
    const float* s0 = pin(p, I_SR) + ((((size_t)j * 128 + b) * 16 + head) * 64 + row) * 64 + c0;
    const float4 a = *(const float4*)s0, bq = *(const float4*)(s0 + 4);
    S[0] = (f32x2){a.x, a.y}; S[1] = (f32x2){a.z, a.w}; S[2] = (f32x2){bq.x, bq.y}; S[3] = (f32x2){bq.z, bq.w};
  } else {
    S[0] = S[1] = S[2] = S[3] = (f32x2){0.f, 0.f};
  }
  c.kkw = *(const f32x4*)(pin(p, I_KK) + j * DM + c.C4); c.kaw = *(const f32x4*)(pin(p, I_KA) + j * DM + c.C4); c.rkw = *(const f32x4*)(pin(p, I_RK) + j * DM + c.C4);
  c.lng = *(const f32x4*)(pin(p, I_LG) + j * DM + c.C4); c.lnb = *(const f32x4*)(pin(p, I_LBI) + j * DM + c.C4);
  RwRaw rawA, rawB;
  f32x4 bonA, bonB, gtA, gtB;
  if (smp) {
    rw_load(rawA, c, 0);
    rw_prep(rawA, bonA, gtA, L0, c, 0);
    LDS_BARRIER();
    rw_scan<8>(S, L0, row, c0, cg);
    LDS_BARRIER();
    rw_post(bonA, gtA, L0, c, 0);
  } else {
    const int ntile = 128;
    rw_load(rawA, c, 0); rw_load(rawB, c, 1);
    rw_prep(rawA, bonA, gtA, L0, c, 0); rw_load(rawA, c, 2);
    LDS_BARRIER();
    rw_scan<16>(S, L0, row, c0, cg); rw_prep(rawB, bonB, gtB, L1, c, 1); rw_load(rawB, c, 3);
    LDS_BARRIER();
    for (int i = 1; i < ntile - 1; i += 2) {
      rw_post(bonA, gtA, L0, c, i - 1); rw_scan<16>(S, L1, row, c0, cg); rw_prep(rawA, bonA, gtA, L0, c, i + 1); rw_load(rawA, c, i + 3);
      LDS_BARRIER();
      rw_post(bonB, gtB, L1, c, i); rw_scan<16>(S, L0, row, c0, cg); rw_prep(rawB, bonB, gtB, L1, c, i + 2); rw_load(rawB, c, i + 4);
      LDS_BARRIER();
    }
    rw_post(bonA, gtA, L0, c, ntile - 2); rw_scan<16>(S, L1, row, c0, cg);
    LDS_BARRIER();
    rw_post(bonB, gtB, L1, c, ntile - 1);
  }
  float* so = p.out + (smp ? O_SRS + ((((size_t)j * 128 + b) * 16 + head) * 64 + row) * 64 + c0 : O_SRP + ((((size_t)j * 8 + b) * 16 + head) * 64 + row) * 64 + c0);
  *(float4*)so = make_float4(S[0][0], S[0][1], S[1][0], S[1][1]); *(float4*)(so + 4) = make_float4(S[2][0], S[2][1], S[3][0], S[3][1]);
  __syncthreads();
}

__device__ __forceinline__ void mix_phase(const Params& p, const int l, const int rep) {
  __shared__ int s_item;
  unsigned* ctr = (unsigned*)(p.ws + WS_CTRL) + l + 4 * rep;
  const bool rw = l & 1;
  const int nP = rw ? 128 : 64, nS = rw ? 2048 : 1024;
  const int nitems = nP + nS + 1024;
  for (;;) {
    __syncthreads();
    if (tidx() == 0) s_item = (int)atomicAdd(ctr, 1u);
    __syncthreads();
    int it = s_item;
    if (rep > 0 && PROBE_SUB == 1) { if (it >= nP) break; }
    if (rep > 0 && PROBE_SUB == 2) { it += nP; if (it >= nP + nS) break; }
    if (rep > 0 && PROBE_SUB == 3) { it += nP + nS; }
    if (it >= nitems) break;
    if (it < nP + nS) {
      const bool smp = it >= nP;
      if (smp) it -= nP;
      if (rw) rwkv_unit(p, l, smp, it >> 4, it & 15); else hgrn_unit(p, l, smp, it >> 3, it & 7);
    } else {
      it -= nP + nS;
      const float* kb; const float* vb; int g0, ntok, head;
      if (it < 512) {
        const int b = it >> 6, blk = it & 15; head = (it >> 4) & 3;
        const size_t off = ((size_t)(l * 8 + b) * 256) * 512 + head * 128;
        kb = p.out + O_MK + off; vb = p.out + O_MV + off; g0 = b * 2048 + blk * 128; ntok = 128;
      } else {
        it -= 512;
        const int b = it >> 2; head = it & 3;
        const size_t off = ((size_t)(l * 128 + b) * 256) * 512 + head * 128;
        kb = pin(p, I_CK) + off; vb = pin(p, I_CV) + off; g0 = NPR + b * 8; ntok = 8;
      }
      xattn_unit(p, kb, vb, g0, ntok, head);
    }
  }
}

#define XB_TMO      128
#define XB_XCNT(j)  (256  + 64 * (j))
#define XB_XSUB(j)  (1280 + 64 * (j))
#define XB_XGEN(j)  (2304 + 64 * (j))
#define XB_TOP      3328
#define XB_TOPGEN   3392
#define XB_SPIN_CAP (1u << 18)
#define XB_LAS __attribute__((address_space(3)))
__device__ __forceinline__ unsigned xb_ld(unsigned* p)              { return __hip_atomic_load(p, __ATOMIC_RELAXED, __HIP_MEMORY_SCOPE_AGENT); }
__device__ __forceinline__ unsigned xb_add(unsigned* p, unsigned v) { return __hip_atomic_fetch_add(p, v, __ATOMIC_RELAXED, __HIP_MEMORY_SCOPE_AGENT); }
__device__ __forceinline__ unsigned xb_xcc_id() { return (unsigned)__builtin_amdgcn_s_getreg((3 << 11) | 20) & 0xFu; }
#define XB_SPIN(cond, bar) do { unsigned _sp = 0; while (cond) { __builtin_amdgcn_s_sleep(1); \
    if ((++_sp & 255u) == 0u) { if (xb_ld(&(bar)[XB_TMO])) break; if (_sp > XB_SPIN_CAP) { atomicAdd(&(bar)[XB_TMO], 1u); break; } } } } while (0)
__device__ __forceinline__ void xcd_barrier_complete(unsigned* bar, unsigned x, unsigned& nloc, unsigned& nx) {
  const unsigned G = gridDim.x;
  unsigned sum, cnt, mine, sp = 0u;
  for (;;) {
    sum = 0u; cnt = 0u; mine = 0u;
#pragma unroll
    for (unsigned j = 0; j < 16; ++j) { const unsigned c = xb_ld(&bar[XB_XCNT(j)]); sum += c; cnt += (c > 0u) ? 1u : 0u; mine = (j == x) ? c : mine; }
    if (sum == G) break;
    __builtin_amdgcn_s_sleep(1);
    if ((++sp & 255u) == 0u) { if (xb_ld(&bar[XB_TMO])) break; if (sp > XB_SPIN_CAP) { atomicAdd(&bar[XB_TMO], 1u); break; } }
  }
  nloc = mine > 0u ? mine : 1u; nx = cnt > 0u ? cnt : 1u;
}
__device__ __forceinline__ void grid_barrier(unsigned* bar, volatile XB_LAS unsigned* st) {
  asm volatile("s_waitcnt vmcnt(0)" ::: "memory");
  __syncthreads();
  if (threadIdx.x == 0) {
    const unsigned x = xb_xcc_id();
    __builtin_amdgcn_s_waitcnt(0);
    unsigned nloc = st[0], nx = st[1];
    if (nloc == 0u) { xcd_barrier_complete(bar, x, nloc, nx); st[0] = nloc; st[1] = nx; }
    const unsigned old = xb_add(&bar[XB_XSUB(x)], 1u);
    const unsigned gen = old / nloc;
    if (old + 1u == (gen + 1u) * nloc) {
      __builtin_amdgcn_fence(__ATOMIC_RELEASE, "agent");
      asm volatile("s_waitcnt vmcnt(0)" ::: "memory");
      const unsigned og = xb_add(&bar[XB_TOP], 1u);
      const unsigned tg = og / nx;
      if (og + 1u == (tg + 1u) * nx) xb_add(&bar[XB_TOPGEN], 1u);
      else XB_SPIN(xb_ld(&bar[XB_TOPGEN]) == tg, bar);
      __builtin_amdgcn_fence(__ATOMIC_ACQUIRE, "agent");
      xb_add(&bar[XB_XGEN(x)], 1u);
      asm volatile("s_waitcnt vmcnt(0)" ::: "memory");
    } else {
      XB_SPIN(xb_ld(&bar[XB_XGEN(x)]) == gen, bar);
      __builtin_amdgcn_fence(__ATOMIC_ACQUIRE, "agent");
      asm volatile("s_waitcnt vmcnt(0)" ::: "memory");
    }
  }
  __syncthreads();
}
__device__ __forceinline__ void run_phase(const Params& p, const int ph, const int rep) {
  int code;
  switch (ph) {
    case 0: code = 0; break;
    case 1: code = 1 | (0 << 4) | (0 << 8); break;
    case 2: code = 2 | (0 << 8); break;
    case 3: code = 1 | (2 << 4) | (0 << 8); break;
    case 4: code = 3 | (1 << 8); break;
    case 5: code = 1 | (0 << 4) | (1 << 8); break;
    case 6: code = 1 | (1 << 4) | (1 << 8); break;
    case 7: code = 2 | (1 << 8); break;
    case 8: code = 1 | (2 << 4) | (1 << 8); break;
    case 9: code = 3 | (2 << 8); break;
    case 10: code = 1 | (0 << 4) | (2 << 8); break;
    case 11: code = 2 | (2 << 8); break;
    case 12: code = 1 | (2 << 4) | (2 << 8); break;
    case 13: code = 3 | (3 << 8); break;
    case 14: code = 1 | (0 << 4) | (3 << 8); break;
    case 15: code = 1 | (1 << 4) | (3 << 8); break;
    case 16: code = 2 | (3 << 8); break;
    case 17: code = 1 | (2 << 4) | (3 << 8); break;
    default: code = 4; break;
  }
  const int type = code & 15, kind = (code >> 4) & 15, l = code >> 8;
  if (type == 0) prologue(p);
  else if (type == 1) gemm_phase(p, kind, l);
  else if (type == 2) mix_phase(p, l, rep);
  else if (type == 3) prep_phase(p, l);
  else final_phase(p);
}
constexpr int NPHASE = 19;

__global__ void __launch_bounds__(512) mega(Params p) {
  __shared__ uint4 xb_words;
  if (threadIdx.x == 0) {
    xb_words = make_uint4(0u, 0u, 0u, 0u);
    (void)xb_add(&((unsigned*)(p.ws + WS_XBAR))[XB_XCNT(xb_xcc_id())], 1u);
  }
  __syncthreads();
  for (int ph = p.ph_lo; ph <= p.ph_hi; ++ph) {
    const int nrep = ((PROBE_MASK >> ph) & 1u) ? 2 : 1;
    for (int rep = 0; rep < nrep; ++rep) {
      run_phase(p, ph, rep);
      if (ph < p.ph_hi || rep + 1 < nrep) {
        if (p.ph_hi < 0) cg::this_grid().sync();
        grid_barrier((unsigned*)(p.ws + WS_XBAR), (volatile XB_LAS unsigned*)&xb_words);
      }
    }
  }
}

extern "C" void kernel_launch(void* const* d_in, const int* in_sizes, int n_in, void* d_out, int out_size, void* d_ws, size_t ws_size,
                              hipStream_t stream) {
  static int grid = 0;
  if (grid == 0) {
    if (n_in != 31 || ws_size < WS_END) { fprintf(stderr, "kernel_launch: unexpected n_in %d / ws %zu (need %zu)\n", n_in, ws_size, (size_t)WS_END); grid = -1; return; }
    int dev = 0, cus = 0, per_cu = 0;
    hipGetDevice(&dev);
    hipDeviceGetAttribute(&cus, hipDeviceAttributeMultiprocessorCount, dev);
    if (hipFuncSetAttribute((const void*)mega, hipFuncAttributeMaxDynamicSharedMemorySize, LDS_BYTES) != hipSuccess) { fprintf(stderr, "hipFuncSetAttribute failed\n"); grid = -1; return; }
    hipOccupancyMaxActiveBlocksPerMultiprocessor(&per_cu, (const void*)mega, 512, LDS_BYTES);
    if (per_cu < 1) { fprintf(stderr, "occupancy query says %d blocks/CU\n", per_cu); per_cu = 1; }
    (void)hipGetLastError();
    grid = cus * per_cu;
  }
  if (grid < 0) return;
  Params p{};
  for (int i = 0; i < 31; ++i) p.in[i] = (const float*)d_in[i];
  p.out = (float*)d_out; p.ws = (char*)d_ws;
  if (hipMemsetAsync((char*)d_ws + WS_XBAR, 0, 16384, stream) != hipSuccess) { fprintf(stderr, "kernel_launch: barrier-word memset failed\n"); return; }
  if (hipMemsetAsync((char*)d_ws + WS_CTRL, 0, 4096, stream) != hipSuccess) { fprintf(stderr, "kernel_launch: control-word memset failed\n"); return; }
#if COOP
  p.ph_lo = 0; p.ph_hi = NPHASE - 1;
  void* args[] = {&p};
  hipError_t e = hipLaunchCooperativeKernel((const void*)mega, dim3(grid), dim3(512), args, LDS_BYTES, stream);
  if (e != hipSuccess) fprintf(stderr, "cooperative launch failed: %s (grid %d)\n", hipGetErrorString(e), grid);
#else
  for (int ph = 0; ph < NPHASE; ++ph) {
    p.ph_lo = ph; p.ph_hi = ph;
    hipLaunchKernelGGL(mega, dim3(grid), dim3(512), LDS_BYTES, stream, p);
  }
#endif
}
```

```cpp
#include <hip/hip_runtime.h>
#include <hip/hip_cooperative_groups.h>
#include <cstdio>
#include <cstdint>
namespace cg = cooperative_groups;

#ifndef COOP
#define COOP 1
#endif
#ifndef PROBE_SUB
#define PROBE_SUB 0
#endif
#ifndef PROBE_MASK
#define PROBE_MASK 0u
#endif

typedef unsigned short bfr;
typedef short bf16x8 __attribute__((ext_vector_type(8)));
typedef short bf16x4 __attribute__((ext_vector_type(4)));
typedef float f32x4 __attribute__((ext_vector_type(4)));
typedef unsigned u32x2 __attribute__((ext_vector_type(2)));
typedef unsigned u32x4 __attribute__((ext_vector_type(4)));

constexpr int NTOK = 17408, NPR = 16384, DM = 1024, INC = 5120, BRW = 1536;
constexpr int LDS_BYTES = 139264;
constexpr size_t O_YP = 0, O_SHP = 17825792, O_SRP = 19922944, O_SSP = 20971520, O_MK = 20987904, O_MV = 25182208,
                 O_SHS = 29376512, O_SRS = 62930944, O_SSS = 79708160;
constexpr size_t WS_CTRL = 0;
constexpr size_t WS_WTIN = 4096;
constexpr size_t WTIN_L = (size_t)5888 * 1024;
constexpr size_t WS_WTOUT = WS_WTIN + 4 * WTIN_L * 2;
constexpr size_t WS_WTMEM = WS_WTOUT + (size_t)4 * 1024 * 1536 * 2;
constexpr size_t WS_W2T = WS_WTMEM + (size_t)4 * 1024 * 1024 * 2;
constexpr size_t WS_MEMN = WS_W2T + (size_t)2 * 3072 * 256 * 2;
constexpr size_t WS_XRES = WS_MEMN + (size_t)4 * 2048 * 1024 * 2;
constexpr size_t HA_SZ = (size_t)NTOK * 1024;
constexpr size_t WS_HA = WS_XRES + (size_t)NTOK * 1024 * 4;
constexpr size_t WS_PROJ = WS_HA + 6 * HA_SZ * 2;
constexpr size_t WS_ALORA = WS_PROJ + (size_t)NTOK * INC * 2;
constexpr size_t WS_LUP = WS_ALORA + (size_t)NTOK * 256 * 2;
constexpr size_t WS_VFIRST = WS_LUP + (size_t)NTOK * 3072 * 2;
constexpr size_t WS_BRANCH = WS_VFIRST + HA_SZ * 2;
constexpr size_t WS_PART = WS_BRANCH + (size_t)NTOK * BRW * 2;
constexpr size_t WS_XBAR = WS_PART + (size_t)5 * 1024 * 1024 * 4;
constexpr size_t WS_END = WS_XBAR + 16384;

struct Params {
  const float* in[31];
  float* out;
  char* ws;
  int ph_lo, ph_hi;
};
enum { I_XP = 0, I_XS, I_MEM, I_SH, I_SR, I_SS, I_CK, I_CV, I_NG, I_WIN, I_WOUT, I_MNG, I_WMEM, I_LB, I_ONG, I_MU, I_W0, I_W1, I_W2,
       I_A0, I_A1, I_A2, I_V0, I_V1, I_V2, I_KK, I_KA, I_RK, I_LG, I_LBI, I_FG };

__device__ __forceinline__ unsigned cvt_pk(float lo, float hi) { unsigned r; asm("v_cvt_pk_bf16_f32 %0, %1, %2" : "=v"(r) : "v"(lo), "v"(hi)); return r; }
__device__ __forceinline__ bfr f2bf(float f) { return (bfr)(cvt_pk(f, 0.f) & 0xffff); }
__device__ __forceinline__ float bf2f(unsigned h) { return __uint_as_float(h << 16); }
__device__ __forceinline__ float bflo(unsigned w) { return __uint_as_float(w << 16); }
__device__ __forceinline__ float bfhi(unsigned w) { return __uint_as_float(w & 0xffff0000u); }
__device__ __forceinline__ float frcp(float x) { return __builtin_amdgcn_rcpf(x); }
__device__ __forceinline__ float sigmoidf_(float x) { return frcp(1.f + __expf(-x)); }
template <int CTRL> __device__ __forceinline__ float dppf(float x) {
  return __builtin_bit_cast(float, __builtin_amdgcn_update_dpp(0, __builtin_bit_cast(int, x), CTRL, 0xf, 0xf, true));
}
__device__ __forceinline__ float wave_sum(float v) {
  v += dppf<0xB1>(v); v += dppf<0x4E>(v); v += dppf<0x141>(v); v += dppf<0x140>(v);
  const int iv = __builtin_bit_cast(int, v);
  float r = __builtin_bit_cast(float, __builtin_amdgcn_readlane(iv, 0));
  r += __builtin_bit_cast(float, __builtin_amdgcn_readlane(iv, 16));
  r += __builtin_bit_cast(float, __builtin_amdgcn_readlane(iv, 32));
  r += __builtin_bit_cast(float, __builtin_amdgcn_readlane(iv, 48));
  return r;
}
__device__ __forceinline__ float bperm(float v, int srclane) { return __builtin_bit_cast(float, __builtin_amdgcn_ds_bpermute(srclane << 2, __builtin_bit_cast(int, v))); }
__device__ __forceinline__ float sum8(float v) {
  v += dppf<0xB1>(v);
  v += dppf<0x4E>(v);
  v += dppf<0x141>(v);
  return v;
}
__device__ __forceinline__ const float* pin(const Params& p, int i) { asm volatile("" : "+s"(i)); return p.in[i]; }
__device__ __forceinline__ const float* xin_row(const Params& p, int g) {
  return g < NPR ? pin(p, I_XP) + (size_t)g * DM : pin(p, I_XS) + (size_t)(g - NPR) * DM;
}

__device__ __forceinline__ int tidx() { int t = threadIdx.x; asm volatile("" : "+v"(t)); return t; }
__device__ __forceinline__ int bidx() { int b = blockIdx.x; asm volatile("" : "+s"(b)); return b; }
__device__ __forceinline__ int wperm(int n) { const int c = n & 31; return (n & ~31) + ((c >> 2) & 1) * 16 + (c >> 3) * 4 + (c & 3); }

__device__ __forceinline__ void transpose_job(const float* __restrict__ src, int Ks, int Ns, bfr* __restrict__ dst, int ldd, int rot) {
  extern __shared__ __attribute__((aligned(16))) char smem[];
  bfr* T = (bfr*)smem;
  const int tid = tidx();
  const int tn = Ns >> 6, ntile = (Ks >> 6) * tn;
  const int G = gridDim.x;
  for (int tile = (bidx() + rot) % G; tile < ntile; tile += G) {
    const int k0 = (tile / tn) << 6, n0 = (tile % tn) << 6;
    const int kl = tid >> 3, nc = (tid & 7) << 3;
    const float* s = src + (size_t)(k0 + kl) * Ns + n0 + nc;
    const float4 a = *(const float4*)s, b = *(const float4*)(s + 4);
    __syncthreads();
    T[(nc + 0) * 72 + kl] = f2bf(a.x); T[(nc + 1) * 72 + kl] = f2bf(a.y); T[(nc + 2) * 72 + kl] = f2bf(a.z); T[(nc + 3) * 72 + kl] = f2bf(a.w);
    T[(nc + 4) * 72 + kl] = f2bf(b.x); T[(nc + 5) * 72 + kl] = f2bf(b.y); T[(nc + 6) * 72 + kl] = f2bf(b.z); T[(nc + 7) * 72 + kl] = f2bf(b.w);
    __syncthreads();
    const int nl = tid >> 3, kc = (tid & 7) << 3;
    const u32x4 v = *(const u32x4*)(T + nl * 72 + kc);
    *(u32x4*)(dst + (size_t)wperm(n0 + nl) * ldd + k0 + kc) = v;
  }
}

__device__ __forceinline__ void prologue(const Params& p) {
  const int tid = tidx(), wid = tid >> 6, lane = tid & 63;
  const int G = gridDim.x;
  char* ws = p.ws;
  int rot = 0;
  for (int l = 0; l < 4; ++l) {
    transpose_job(pin(p, I_WIN) + (size_t)l * DM * INC, DM, INC, (bfr*)(ws + WS_WTIN) + l * WTIN_L, DM, rot); rot = (rot + G - (1280 % G)) % G;
    transpose_job(pin(p, I_WOUT) + (size_t)l * BRW * DM, BRW, DM, (bfr*)(ws + WS_WTOUT) + (size_t)l * DM * BRW, BRW, rot); rot = (rot + G - (384 % G)) % G;
    transpose_job(pin(p, I_WMEM) + (size_t)l * DM * DM, DM, DM, (bfr*)(ws + WS_WTMEM) + (size_t)l * DM * DM, DM, rot); rot = (rot + G - (256 % G)) % G;
  }
  const int gt = bidx() * 512 + tid, nth = G * 512;
  for (int j = 0; j < 2; ++j) {
    bfr* dst = (bfr*)(ws + WS_WTIN) + (size_t)(2 * j + 1) * WTIN_L + (size_t)5120 * 1024;
    const float* w1 = pin(p, I_W1) + (size_t)j * 1024 * 64;
    const float* a1 = pin(p, I_A1) + (size_t)j * 1024 * 64;
    const float* v1 = pin(p, I_V1);
    for (int it = gt; it < 768 * 128; it += nth) {
      const int n = it % 768, kc = it / 768;
      const int seg = n >> 8, c = n & 255;
      float v[8];
#pragma unroll
      for (int e = 0; e < 8; ++e) {
        const int k = kc * 8 + e;
        float x = 0.f;
        if (seg == 0) { if (c < 64) x = w1[k * 64 + c]; }
        else if (seg == 1) { if (c < 64) x = a1[k * 64 + c]; }
        else { if (j == 1 && c < 32) x = v1[k * 32 + c]; }
        v[e] = x;
      }
      u32x4 o; o.x = cvt_pk(v[0], v[1]); o.y = cvt_pk(v[2], v[3]); o.z = cvt_pk(v[4], v[5]); o.w = cvt_pk(v[6], v[7]);
      *(u32x4*)(dst + (size_t)wperm(n) * 1024 + kc * 8) = o;
    }
    bfr* d2 = (bfr*)(ws + WS_W2T) + (size_t)j * 3072 * 256;
    const float* w2 = pin(p, I_W2) + (size_t)j * 64 * 1024;
    const float* a2 = pin(p, I_A2) + (size_t)j * 64 * 1024;
    const float* v2 = pin(p, I_V2);
    for (int it = gt; it < 3072 * 32; it += nth) {
      const int n = it % 3072, kc = it / 3072;
      const int seg = n >> 10, c = n & 1023;
      float v[8];
#pragma unroll
      for (int e = 0; e < 8; ++e) {
        const int k = kc * 8 + e;
        float x = 0.f;
        if (seg == 0) { if (k < 64) x = w2[k * 1024 + c]; }
        else if (seg == 1) { if (k >= 64 && k < 128) x = a2[(k - 64) * 1024 + c]; }
        else { if (j == 1 && k >= 128 && k < 160) x = v2[(k - 128) * 1024 + c]; }
        v[e] = x;
      }
      u32x4 o; o.x = cvt_pk(v[0], v[1]); o.y = cvt_pk(v[2], v[3]); o.z = cvt_pk(v[4], v[5]); o.w = cvt_pk(v[6], v[7]);
      *(u32x4*)(d2 + (size_t)wperm(n) * 256 + kc * 8) = o;
    }
  }
  const int gw = bidx() * 8 + wid, nw = G * 8;
  for (int row = gw; row < 2048 + NTOK; row += nw) {
    const bool ismem = row < 2048;
    const float* src = ismem ? pin(p, I_MEM) + (size_t)row * DM : xin_row(p, row - 2048);
    float4 x[4]; float ss = 0.f;
#pragma unroll
    for (int i = 0; i < 4; ++i) { x[i] = *(const float4*)(src + lane * 4 + i * 256); ss += x[i].x * x[i].x + x[i].y * x[i].y + x[i].z * x[i].z + x[i].w * x[i].w; }
    ss = wave_sum(ss);
    const float rs = rsqrtf(ss * (1.f / 1024.f) + 1e-6f);
    if (ismem) {
      for (int l = 0; l < 4; ++l) {
        bfr* dst = (bfr*)(ws + WS_MEMN) + ((size_t)l * 2048 + row) * DM;
#pragma unroll
        for (int i = 0; i < 4; ++i) {
          const float4 g = *(const float4*)(pin(p, I_MNG) + l * DM + lane * 4 + i * 256);
          u32x2 o; o.x = cvt_pk(x[i].x * rs * g.x, x[i].y * rs * g.y); o.y = cvt_pk(x[i].z * rs * g.z, x[i].w * rs * g.w);
          *(u32x2*)(dst + lane * 4 + i * 256) = o;
        }
      }
    } else {
      float* xr = (float*)(ws + WS_XRES) + (size_t)(row - 2048) * DM;
#pragma unroll
      for (int i = 0; i < 4; ++i) *(float4*)(xr + lane * 4 + i * 256) = x[i];
      bfr* dst = (bfr*)(ws + WS_HA) + (size_t)(row - 2048) * DM;
#pragma unroll
      for (int i = 0; i < 4; ++i) {
        const float4 g = *(const float4*)(pin(p, I_NG) + lane * 4 + i * 256);
        u32x2 o; o.x = cvt_pk(x[i].x * rs * g.x, x[i].y * rs * g.y); o.y = cvt_pk(x[i].z * rs * g.z, x[i].w * rs * g.w);
        *(u32x2*)(dst + lane * 4 + i * 256) = o;
      }
    }
  }
}

__device__ __forceinline__ void load_xrow(const Params& p, const int g, const int lane, float4 (&x)[4]) {
  const float* s = (const float*)(p.ws + WS_XRES) + (size_t)g * DM;
#pragma unroll
  for (int i = 0; i < 4; ++i) x[i] = *(const float4*)(s + lane * 4 + i * 256);
  if (g >= NPR) {
#pragma unroll
    for (int k = 0; k < 5; ++k) {
      const float* q = (const float*)(p.ws + WS_PART) + ((size_t)k * 1024 + (g - NPR)) * DM;
#pragma unroll
      for (int i = 0; i < 4; ++i) { const float4 t = *(const float4*)(q + lane * 4 + i * 256); x[i].x += t.x; x[i].y += t.y; x[i].z += t.z; x[i].w += t.w; }
    }
  }
}
__device__ __forceinline__ void prep_phase(const Params& p, int l) {
  const int tid = tidx(), wid = tid >> 6, lane = tid & 63;
  const bool rw = (l & 1);
  const int j = l >> 1;
  const float* xres = (const float*)(p.ws + WS_XRES);
  bfr* hA = (bfr*)(p.ws + WS_HA);
  const float* ng = pin(p, I_NG) + l * DM;
  const float* mu = pin(p, I_MU) + (size_t)j * 5 * DM;
  const int gw = bidx() * 8 + wid, nw = gridDim.x * 8;
  for (int task = gw; task < NPR / 4 + 128; task += nw) {
    const int g0 = task < NPR / 4 ? task * 4 : NPR + (task - NPR / 4) * 8;
    const int nrows = task < NPR / 4 ? 4 : 8;
    float hp[16];
    if (rw) {
      const bool smp = g0 >= NPR;
      const int t0 = smp ? ((g0 - NPR) & 7) : (g0 & 2047);
      if (t0 == 0) {
        if (smp) {
          const float* s = pin(p, I_SS) + ((size_t)j * 128 + ((g0 - NPR) >> 3)) * DM;
#pragma unroll
          for (int i = 0; i < 4; ++i) { const float4 v = *(const float4*)(s + lane * 4 + i * 256); hp[i * 4] = v.x; hp[i * 4 + 1] = v.y; hp[i * 4 + 2] = v.z; hp[i * 4 + 3] = v.w; }
        } else {
#pragma unroll
          for (int i = 0; i < 16; ++i) hp[i] = 0.f;
        }
      } else {
        float4 x[4]; float ss = 0.f;
        load_xrow(p, g0 - 1, lane, x);
#pragma unroll
        for (int i = 0; i < 4; ++i) ss += x[i].x * x[i].x + x[i].y * x[i].y + x[i].z * x[i].z + x[i].w * x[i].w;
        ss = wave_sum(ss);
        const float rs = rsqrtf(ss * (1.f / 1024.f) + 1e-6f);
#pragma unroll
        for (int i = 0; i < 4; ++i) {
          const float4 g = *(const float4*)(ng + lane * 4 + i * 256);
          hp[i * 4] = x[i].x * rs * g.x; hp[i * 4 + 1] = x[i].y * rs * g.y; hp[i * 4 + 2] = x[i].z * rs * g.z; hp[i * 4 + 3] = x[i].w * rs * g.w;
        }
      }
    }
    for (int r = 0; r < nrows; ++r) {
      const int g = g0 + r;
      float4 x[4]; float ss = 0.f;
      load_xrow(p, g, lane, x);
      if (g >= NPR) {
        float* xw = (float*)(p.ws + WS_XRES) + (size_t)g * DM;
#pragma unroll
        for (int i = 0; i < 4; ++i) *(float4*)(xw + lane * 4 + i * 256) = x[i];
      }
#pragma unroll
      for (int i = 0; i < 4; ++i) ss += x[i].x * x[i].x + x[i].y * x[i].y + x[i].z * x[i].z + x[i].w * x[i].w;
      ss = wave_sum(ss);
      const float rs = rsqrtf(ss * (1.f / 1024.f) + 1e-6f);
      float h[16];
#pragma unroll
      for (int i = 0; i < 4; ++i) {
        const float4 gg = *(const float4*)(ng + lane * 4 + i * 256);
        h[i * 4] = x[i].x * rs * gg.x; h[i * 4 + 1] = x[i].y * rs * gg.y; h[i * 4 + 2] = x[i].z * rs * gg.z; h[i * 4 + 3] = x[i].w * rs * gg.w;
        u32x2 o; o.x = cvt_pk(h[i * 4], h[i * 4 + 1]); o.y = cvt_pk(h[i * 4 + 2], h[i * 4 + 3]);
        *(u32x2*)(hA + (size_t)g * DM + lane * 4 + i * 256) = o;
      }
      if (rw) {
#pragma unroll
        for (int m = 0; m < 5; ++m) {
          bfr* dst = hA + (size_t)(1 + m) * HA_SZ + (size_t)g * DM;
#pragma unroll
          for (int i = 0; i < 4; ++i) {
            const float4 mm = *(const float4*)(mu + m * DM + lane * 4 + i * 256);
            const float a0 = h[i * 4] + (hp[i * 4] - h[i * 4]) * mm.x, a1 = h[i * 4 + 1] + (hp[i * 4 + 1] - h[i * 4 + 1]) * mm.y;
            const float a2 = h[i * 4 + 2] + (hp[i * 4 + 2] - h[i * 4 + 2]) * mm.z, a3 = h[i * 4 + 3] + (hp[i * 4 + 3] - h[i * 4 + 3]) * mm.w;
            u32x2 o; o.x = cvt_pk(a0, a1); o.y = cvt_pk(a2, a3);
            *(u32x2*)(dst + lane * 4 + i * 256) = o;
          }
        }
        const bool smp = g >= NPR;
        const int t = smp ? ((g - NPR) & 7) : (g & 2047);
        if (t == (smp ? 7 : 2047)) {
          float* o = p.out + (smp ? O_SSS + ((size_t)j * 128 + ((g - NPR) >> 3)) * DM : O_SSP + ((size_t)j * 8 + (g >> 11)) * DM);
#pragma unroll
          for (int i = 0; i < 4; ++i) *(float4*)(o + lane * 4 + i * 256) = make_float4(h[i * 4], h[i * 4 + 1], h[i * 4 + 2], h[i * 4 + 3]);
        }
#pragma unroll
        for (int i = 0; i < 16; ++i) hp[i] = h[i];
      }
    }
  }
}

__device__ __forceinline__ void final_phase(const Params& p) {
  const int tid = tidx(), wid = tid >> 6, lane = tid & 63;
  const float* xres = (const float*)(p.ws + WS_XRES);
  const float* fg = pin(p, I_FG);
  const int gw = bidx() * 8 + wid, nw = gridDim.x * 8;
  for (int g = gw; g < NTOK; g += nw) {
    float4 x[4]; float ss = 0.f;
    load_xrow(p, g, lane, x);
#pragma unroll
    for (int i = 0; i < 4; ++i) ss += x[i].x * x[i].x + x[i].y * x[i].y + x[i].z * x[i].z + x[i].w * x[i].w;
    ss = wave_sum(ss);
    const float rs = rsqrtf(ss * (1.f / 1024.f) + 1e-6f);
    float* o = p.out + O_YP + (size_t)g * DM;
#pragma unroll
    for (int i = 0; i < 4; ++i) {
      const float4 gg = *(const float4*)(fg + lane * 4 + i * 256);
      *(float4*)(o + lane * 4 + i * 256) = make_float4(x[i].x * rs * gg.x, x[i].y * rs * gg.y, x[i].z * rs * gg.z, x[i].w * rs * gg.w);
    }
  }
}

constexpr int BM = 256, BK = 64, HALF = 128, HT = HALF * BK;
__device__ __forceinline__ int lds_byte(int r, int c) {
  int st = (r >> 4) * 2 + (c >> 5), rr = r & 15, cc = c & 31, ob = rr * 64 + cc * 2;
  return st * 1024 + (ob ^ (((ob >> 9) & 1) << 5));
}
__device__ __forceinline__ void stage_rc(int b, int& R, int& C) {
  int st = b / 1024, sb = b % 1024, swz = sb ^ (((sb >> 9) & 1) << 5);
  R = (st >> 1) * 16 + swz / 64; C = (st & 1) * 32 + (swz % 64) / 2;
}

enum { EM_PROJ = 0, EM_G1R, EM_MEM, EM_LUP, EM_OUT, EM_OUTA };

__device__ __forceinline__ void epilogue(const Params& p, const int mode, const int l, const f32x4 (&acc)[2][2][4][2],
                                         const int pm, const int pn, const int wr, const int wc, const int fr, const int fq) {
  const int j = (l & 255) >> 1;
#pragma unroll
  for (int ai = 0; ai < 2; ++ai)
#pragma unroll
    for (int m = 0; m < 4; ++m) {
      const int row = pm * BM + ai * HALF + wr * 64 + m * 16 + fr;
#pragma unroll
      for (int bj = 0; bj < 2; ++bj)
#pragma unroll
        for (int n = 0; n < 2; ++n) {
          const int col = pn * BM + bj * HALF + wc * 32 + fq * 8 + n * 4;
          const f32x4 v = acc[ai][bj][m][n];
          if (mode == EM_PROJ || (mode == EM_G1R && pn < 20)) {
            if (n == 0) {
              const f32x4 v1 = acc[ai][bj][m][1];
              u32x4 o; o.x = cvt_pk(v[0], v[1]); o.y = cvt_pk(v[2], v[3]); o.z = cvt_pk(v1[0], v1[1]); o.w = cvt_pk(v1[2], v1[3]);
              *(u32x4*)((bfr*)(p.ws + WS_PROJ) + (size_t)row * INC + col) = o;
            }
          } else if (mode == EM_G1R) {
            bfr* al = (bfr*)(p.ws + WS_ALORA) + (size_t)row * 256;
            const int c = col & 255;
            if (pn == 20) {
              if (c < 64) {
                float t[4];
#pragma unroll
                for (int e = 0; e < 4; ++e) { const float ex = __expf(2.f * v[e]); t[e] = 1.f - 2.f * frcp(ex + 1.f); }
                u32x2 o; o.x = cvt_pk(t[0], t[1]); o.y = cvt_pk(t[2], t[3]);
                *(u32x2*)(al + c) = o;
              }
            } else if (pn == 21) {
              const int lim = (l == 3) ? 128 : 256;
              if (64 + c < lim) {
                u32x2 o; o.x = 0u; o.y = 0u;
                if (c < 64) { o.x = cvt_pk(v[0], v[1]); o.y = cvt_pk(v[2], v[3]); }
                *(u32x2*)(al + 64 + c) = o;
              }
            } else {
              if (128 + c < 256) {
                u32x2 o; o.x = 0u; o.y = 0u;
                if (c < 32) { o.x = cvt_pk(v[0], v[1]); o.y = cvt_pk(v[2], v[3]); }
                *(u32x2*)(al + 128 + c) = o;
              }
            }
          } else if (mode == EM_MEM) {
            const int lm = pm >> 3, r2 = row & 2047;
            float* o = p.out + (col < 512 ? O_MK : O_MV) + ((size_t)lm * 2048 + r2) * 512 + (col & 511);
            *(f32x4*)o = v;
          } else if (mode == EM_LUP) {
            const int seg = col >> 10, c = col & 1023;
            float t[4];
            if (seg == 0) {
              const float4 b = *(const float4*)(pin(p, I_W0) + j * DM + c);
              const float bb[4] = {b.x, b.y, b.z, b.w};
#pragma unroll
              for (int e = 0; e < 4; ++e) {
                const float x = bb[e] + v[e];
                const float sp = fmaxf(-x, 0.f) + __logf(1.f + __expf(-fabsf(x)));
                t[e] = -__expf(-sp - 0.5f);
              }
            } else if (seg == 1) {
              const float4 b = *(const float4*)(pin(p, I_A0) + j * DM + c);
              t[0] = sigmoidf_(b.x + v[0]); t[1] = sigmoidf_(b.y + v[1]); t[2] = sigmoidf_(b.z + v[2]); t[3] = sigmoidf_(b.w + v[3]);
            } else {
              const float4 b = *(const float4*)(pin(p, I_V0) + c);
              t[0] = sigmoidf_(b.x + v[0]); t[1] = sigmoidf_(b.y + v[1]); t[2] = sigmoidf_(b.z + v[2]); t[3] = sigmoidf_(b.w + v[3]);
            }
            u32x2 o; o.x = cvt_pk(t[0], t[1]); o.y = cvt_pk(t[2], t[3]);
            *(u32x2*)((bfr*)(p.ws + WS_LUP) + (size_t)row * 3072 + col) = o;
          } else if (mode == EM_OUT) {
            float* xo = (float*)(p.ws + WS_XRES) + (size_t)row * DM + col;
            const f32x4 x = *(const f32x4*)xo;
            *(f32x4*)xo = x + v;
          } else {
            *(f32x4*)((float*)(p.ws + WS_PART) + ((size_t)((l >> 8) - 1) * 1024 + (row - NPR)) * DM + col) = v;
          }
        }
    }
}

__device__ __forceinline__ void gemm_unit(const Params& p, const bfr* __restrict__ A, const bfr* __restrict__ Bt, const int K, const int kt0, const int nt,
                                          const int pm, const int pn, const int mode, const int l) {
  extern __shared__ __attribute__((aligned(16))) char smem[];
  bfr* shm = (bfr*)smem;
#define SA(b, h) (shm + ((b) * 2 + (h)) * HT)
#define SB(b, h) (shm + (4 + (b) * 2 + (h)) * HT)
#define STAGE(P, BASE, br, kt) do { const bfr* _g = (BASE) + (size_t)(br) * K + (kt0 + (kt)) * BK + goff; \
    __builtin_amdgcn_global_load_lds((const unsigned*)_g, (unsigned*)((char*)(P) + tid * 16), 16, 0, 0); \
    __builtin_amdgcn_global_load_lds((const unsigned*)(_g + (size_t)64 * K), (unsigned*)((char*)(P) + tid * 16 + 8192), 16, 0, 0); } while (0)
#define LDA(dst, b, h) for (int m = 0; m < 4; ++m) for (int k = 0; k < 2; ++k) \
    dst[m][k] = *reinterpret_cast<const bf16x8*>((char*)SA(b, h) + lds_byte(wr * 64 + m * 16 + fr, k * 32 + fq * 8))
#define LDB(dst, b, h) for (int n = 0; n < 2; ++n) for (int k = 0; k < 2; ++k) \
    dst[n][k] = *reinterpret_cast<const bf16x8*>((char*)SB(b, h) + lds_byte(wc * 32 + n * 16 + fr, k * 32 + fq * 8))
#define MMA(ai, bj, At, Bt_) do { __builtin_amdgcn_s_setprio(1); \
    for (int m = 0; m < 4; ++m) for (int n = 0; n < 2; ++n) for (int k = 0; k < 2; ++k) \
      acc[ai][bj][m][n] = __builtin_amdgcn_mfma_f32_16x16x32_bf16(Bt_[n][k], At[m][k], acc[ai][bj][m][n], 0, 0, 0); \
    __builtin_amdgcn_s_setprio(0); } while (0)
#define WAIT_V(n) asm volatile("s_waitcnt vmcnt(" #n ")" ::: "memory")
#define WAIT_L(n) asm volatile("s_waitcnt lgkmcnt(" #n ")" ::: "memory")
#define BAR __builtin_amdgcn_s_barrier()
#define SCHED __builtin_amdgcn_sched_barrier(0)
  const int tid = tidx();
  const int brow = pm * BM, bcol = pn * BM;
  const int wid = tid >> 6, lane = tid & 63, wr = wid >> 2, wc = wid & 3, fr = lane & 15, fq = lane >> 4;
  int R0, C0; stage_rc(tid * 16, R0, C0);
  const int goff = R0 * K + C0;
  f32x4 acc[2][2][4][2] = {};
  bf16x8 At[4][2], B0[2][2], B1[2][2];
  STAGE(SB(0, 0), Bt, bcol, 0); STAGE(SA(0, 0), A, brow, 0);
  STAGE(SB(0, 1), Bt, bcol + HALF, 0); STAGE(SA(0, 1), A, brow + HALF, 0);
  if (wr == 1) BAR;
  WAIT_V(4); BAR;
  STAGE(SB(1, 0), Bt, bcol, 1); STAGE(SA(1, 0), A, brow, 1); STAGE(SB(1, 1), Bt, bcol + HALF, 1);
  WAIT_V(6); BAR;
  for (int t = 0; t < nt - 2; t += 2) {
    LDB(B0, 0, 0); SCHED; LDA(At, 0, 0); STAGE(SA(1, 1), A, brow + HALF, t + 1);
    WAIT_L(8); BAR; WAIT_L(0); MMA(0, 0, At, B0); BAR; SCHED;
    LDB(B1, 0, 1); STAGE(SB(0, 0), Bt, bcol, t + 2);
    BAR; WAIT_L(0); MMA(0, 1, At, B1); BAR;
    LDA(At, 0, 1); STAGE(SA(0, 0), A, brow, t + 2);
    BAR; WAIT_L(0); MMA(1, 0, At, B0); BAR; SCHED;
    STAGE(SB(0, 1), Bt, bcol + HALF, t + 2);
    WAIT_V(6); BAR; MMA(1, 1, At, B1); BAR;
    LDB(B0, 1, 0); SCHED; LDA(At, 1, 0); STAGE(SA(0, 1), A, brow + HALF, t + 2);
    WAIT_L(8); BAR; WAIT_L(0); MMA(0, 0, At, B0); BAR; SCHED;
    LDB(B1, 1, 1); STAGE(SB(1, 0), Bt, bcol, t + 3);
    BAR; WAIT_L(0); MMA(0, 1, At, B1); BAR;
    LDA(At, 1, 1); STAGE(SA(1, 0), A, brow, t + 3);
    BAR; WAIT_L(0); MMA(1, 0, At, B0); BAR; SCHED;
    STAGE(SB(1, 1), Bt, bcol + HALF, t + 3);
    WAIT_V(6); BAR; MMA(1, 1, At, B1); BAR;
  }
  { LDB(B0, 0, 0); LDA(At, 0, 0); STAGE(SA(1, 1), A, brow + HALF, nt - 1);
    BAR; WAIT_L(0); MMA(0, 0, At, B0); BAR;
    LDB(B1, 0, 1); BAR; WAIT_L(0); MMA(0, 1, At, B1); BAR;
    LDA(At, 0, 1); WAIT_V(4); BAR; WAIT_L(0); MMA(1, 0, At, B0); MMA(1, 1, At, B1); BAR; }
  { LDB(B0, 1, 0); LDA(At, 1, 0); WAIT_V(2); BAR; WAIT_L(0); MMA(0, 0, At, B0); BAR;
    LDB(B1, 1, 1); WAIT_V(0); BAR; WAIT_L(0); MMA(0, 1, At, B1); BAR;
    LDA(At, 1, 1); BAR; WAIT_L(0); MMA(1, 0, At, B0); MMA(1, 1, At, B1); BAR; }
  if (wr == 0) BAR;
  epilogue(p, mode, l, acc, pm, pn, wr, wc, fr, fq);
  WAIT_V(0);
#undef SA
#undef SB
}

__device__ __forceinline__ bool unit_order(int i, int c, int G, int nM, int nN, int& pm, int& pn) {
  const int nwg = nM * nN;
  const long L = (long)i * G + c; if (L >= nwg) return false;
  int wgid = (int)L; { const int q = nwg / 8, r = nwg % 8, xcd = wgid % 8, off = wgid / 8; wgid = (xcd < r ? xcd * (q + 1) : r * (q + 1) + (xcd - r) * q) + off; }
  const int nig = 8 * nN, gid = wgid / nig, fm = gid * 8, gsz = (nM - fm) < 8 ? (nM - fm) : 8;
  pm = fm + ((wgid % nig) % gsz); pn = (wgid % nig) / gsz; return true;
}

__device__ __forceinline__ void gemm_phase(const Params& p, const int kind, const int l) {
  const int G = gridDim.x;
  const int j = l >> 1;
  const bool rw = l & 1;
  char* ws = p.ws;
  const bfr* hA = (const bfr*)(ws + WS_HA);
  int nM = NTOK / BM, nN, K, mode;
  const bfr* Bt;
  if (kind == 0) { nN = rw ? (l == 3 ? 23 : 22) : 20; K = 1024; mode = rw ? EM_G1R : EM_PROJ; Bt = (const bfr*)(ws + WS_WTIN) + l * WTIN_L; }
  else if (kind == 1) { nN = (l == 3) ? 12 : 8; K = 256; mode = EM_LUP; Bt = (const bfr*)(ws + WS_W2T) + (size_t)j * 3072 * 256; }
  else { nN = 4; K = 1536; mode = EM_OUT; Bt = (const bfr*)(ws + WS_WTOUT) + (size_t)l * DM * BRW; }
  int pm, pn;
  const int nwg1 = nM * nN;
  const bool withmem = (kind == 0 && l == 0);
  const int c2 = (bidx() + G - (nwg1 % G)) % G;
  int seg = 0, i = 0;
  for (;;) {
    const bfr* A; const bfr* B = Bt; int KK = K, md = mode, kt0 = 0, nt = K / BK, lk = l;
    if (kind == 2) {
      const int t = bidx() + G * i;
      if (t >= 256 + 96) break;
      ++i;
      A = (const bfr*)(ws + WS_BRANCH);
      if (t < 256) { pm = (t & 7) * 8 + (t >> 5); pn = (t >> 3) & 3; }
      else { const int v = t - 256, rem = v % 24, ks = rem % 6; pm = 64 + v / 24; pn = rem / 6; kt0 = ks * 4; nt = 4; if (ks) { md = EM_OUTA; lk = l | (ks << 8); } }
    } else {
      bool ok;
      if (seg == 0) ok = unit_order(i, bidx(), G, nM, nN, pm, pn);
      else ok = unit_order(i, c2, G, 32, 4, pm, pn);
      if (!ok) { if (seg == 0 && withmem) { seg = 1; i = 0; continue; } break; }
      ++i;
      if (seg == 1) { A = (const bfr*)(ws + WS_MEMN); B = (const bfr*)(ws + WS_WTMEM) + (size_t)(pm >> 3) * DM * DM; KK = 1024; nt = 16; md = EM_MEM; }
      else if (kind == 0) {
        int sel = 0;
        if (rw) sel = pn < 4 ? 1 : pn < 8 ? 3 : pn < 12 ? 4 : pn < 20 ? 0 : pn == 20 ? 2 : pn == 21 ? 5 : 4;
        A = hA + (size_t)sel * HA_SZ;
      } else A = (const bfr*)(ws + WS_ALORA);
    }
    gemm_unit(p, A, B, KK, kt0, nt, pm, pn, md, lk);
  }
}

__device__ __forceinline__ void xattn_unit(const Params& p, const float* __restrict__ kb, const float* __restrict__ vb, const int g0, const int ntok, const int head) {
  extern __shared__ __attribute__((aligned(16))) char smem[];
  bfr* Ks = (bfr*)smem;
  bfr* Vt = Ks + 256 * 136;
  const int tid = tidx(), wid = tid >> 6, lane = tid & 63, fr = lane & 15, fq = lane >> 4;
#pragma unroll 4
  for (int i = 0; i < 16; ++i) {
    const int idx = tid + i * 512, row = idx >> 5, c4 = (idx & 31) << 2;
    const float4 v = *(const float4*)(kb + (size_t)row * 512 + c4);
    u32x2 o; o.x = cvt_pk(v.x, v.y); o.y = cvt_pk(v.z, v.w);
    *(u32x2*)(Ks + row * 136 + c4) = o;
  }
  {
    const int pp = lane & 7, dd = lane >> 3;
#pragma unroll 4
    for (int it = 0; it < 8; ++it) {
      const int wq = it * 8 + wid, mb = wq & 15, db = wq >> 4;
      const int m0 = mb * 16 + 2 * pp, d0 = db * 32 + dd * 4;
      const float4 a = *(const float4*)(vb + (size_t)m0 * 512 + d0);
      const float4 b = *(const float4*)(vb + (size_t)(m0 + 1) * 512 + d0);
      *(unsigned*)(Vt + (d0 + 0) * 260 + m0) = cvt_pk(a.x, b.x);
      *(unsigned*)(Vt + (d0 + 1) * 260 + m0) = cvt_pk(a.y, b.y);
      *(unsigned*)(Vt + (d0 + 2) * 260 + m0) = cvt_pk(a.z, b.z);
      *(unsigned*)(Vt + (d0 + 3) * 260 + m0) = cvt_pk(a.w, b.w);
    }
  }
  __syncthreads();
  if (wid * 16 < ntok) {
    const bfr* proj = (const bfr*)(p.ws + WS_PROJ);
    int tl = wid * 16 + fr; if (tl > ntok - 1) tl = ntok - 1;
    const bfr* qrow = proj + (size_t)(g0 + tl) * INC + 3072 + head * 128;
    bf16x8 qf[4];
#pragma unroll
    for (int ks = 0; ks < 4; ++ks) qf[ks] = *(const bf16x8*)(qrow + ks * 32 + fq * 8);
    f32x4 sc[16];
#pragma unroll
    for (int mt = 0; mt < 16; ++mt) {
      f32x4 a = {0.f, 0.f, 0.f, 0.f};
#pragma unroll
      for (int ks = 0; ks < 4; ++ks) {
        const bf16x8 kf = *(const bf16x8*)(Ks + (mt * 16 + fr) * 136 + ks * 32 + fq * 8);
        a = __builtin_amdgcn_mfma_f32_16x16x32_bf16(kf, qf[ks], a, 0, 0, 0);
      }
      sc[mt] = a;
    }
    float mx = -3.0e38f;
#pragma unroll
    for (int mt = 0; mt < 16; ++mt) mx = fmaxf(mx, fmaxf(fmaxf(sc[mt][0], sc[mt][1]), fmaxf(sc[mt][2], sc[mt][3])));
    mx = fmaxf(mx, bperm(mx, lane ^ 16)); mx = fmaxf(mx, bperm(mx, lane ^ 32));
    const float cs = 0.08838834764831845f * 1.4426950408889634f;
    float sum = 0.f;
#pragma unroll
    for (int mt = 0; mt < 16; ++mt)
#pragma unroll
      for (int e = 0; e < 4; ++e) { const float pe = exp2f((sc[mt][e] - mx) * cs); sc[mt][e] = pe; sum += pe; }
    sum += bperm(sum, lane ^ 16); sum += bperm(sum, lane ^ 32);
    const float inv = frcp(sum);
    bf16x8 pf[8];
#pragma unroll
    for (int u = 0; u < 8; ++u) {
      u32x4 w; w.x = cvt_pk(sc[2 * u][0], sc[2 * u][1]); w.y = cvt_pk(sc[2 * u][2], sc[2 * u][3]);
      w.z = cvt_pk(sc[2 * u + 1][0], sc[2 * u + 1][1]); w.w = cvt_pk(sc[2 * u + 1][2], sc[2 * u + 1][3]);
      pf[u] = __builtin_bit_cast(bf16x8, w);
    }
    const bool tvalid = (wid * 16 + fr) < ntok;
    const int g = g0 + tl;
    const bfr* gate = proj + (size_t)g * INC + 3584 + 1024 + head * 128;
    bfr* br = (bfr*)(p.ws + WS_BRANCH) + (size_t)g * BRW + 1024 + head * 128;
#pragma unroll
    for (int dt = 0; dt < 8; ++dt) {
      f32x4 a = {0.f, 0.f, 0.f, 0.f};
#pragma unroll
      for (int u = 0; u < 8; ++u) {
        const bfr* vr = Vt + (dt * 16 + fr) * 260 + fq * 4;
        u32x4 w;
        const u32x2 lo = *(const u32x2*)(vr + (2 * u) * 16), hi = *(const u32x2*)(vr + (2 * u + 1) * 16);
        w.x = lo.x; w.y = lo.y; w.z = hi.x; w.w = hi.y;
        a = __builtin_amdgcn_mfma_f32_16x16x32_bf16(__builtin_bit_cast(bf16x8, w), pf[u], a, 0, 0, 0);
      }
      if (tvalid) {
        const u32x2 gw = *(const u32x2*)(gate + dt * 16 + fq * 4);
        const float g0f = bflo(gw.x), g1f = bfhi(gw.x), g2f = bflo(gw.y), g3f = bfhi(gw.y);
        u32x2 o;
        o.x = cvt_pk(a[0] * inv * g0f * sigmoidf_(g0f), a[1] * inv * g1f * sigmoidf_(g1f));
        o.y = cvt_pk(a[2] * inv * g2f * sigmoidf_(g2f), a[3] * inv * g3f * sigmoidf_(g3f));
        *(u32x2*)(br + dt * 16 + fq * 4) = o;
      }
    }
  }
  __syncthreads();
}

struct HgRaw { u32x2 q, f, v, g; };
__device__ __forceinline__ void hg_load(HgRaw& r, const bfr* __restrict__ proj, const int g0, const int T, const int sbi, const int h,
                                        const int wid, const int fr, const int fq, const int tid) {
  const int t0 = sbi * 16;
  if (t0 + fr < T) {
    const bfr* pr = proj + (size_t)(g0 + t0 + fr) * INC + h * 128 + wid * 16 + fq * 4;
    r.q = *(const u32x2*)pr; r.f = *(const u32x2*)(pr + 1024); r.g = *(const u32x2*)(pr + 3584);
  }
  const int vt = tid >> 5, dv4 = (tid & 31) << 2;
  if (t0 + vt < T) r.v = *(const u32x2*)(proj + (size_t)(g0 + t0 + vt) * INC + 2048 + h * 128 + dv4);
}
constexpr int KTS = 18;
constexpr int HG_SET = 16 * 136 * 2 + 128 * KTS * 2;

__device__ __forceinline__ void hgrn_unit(const Params& p, const int l, const bool smp, const int b, const int h) {
  extern __shared__ __attribute__((aligned(16))) char smem[];
  bfr* lds0 = (bfr*)smem;
  float* decb = (float*)(lds0 + 2 * HG_SET);
  float* redb = decb + 256;
  const int tid = tidx(), wid = tid >> 6, lane = tid & 63, fr = lane & 15, fq = lane >> 4;
  const int j = l >> 1;
  const bfr* proj = (const bfr*)(p.ws + WS_PROJ);
  bfr* branch = (bfr*)(p.ws + WS_BRANCH);
  const int g0 = smp ? NPR + b * 8 : b * 2048;
  const int T = smp ? 8 : 2048;
  const int nsub = (T + 15) >> 4;
  f32x4 S[8];
  if (smp) {
    const float* s0 = pin(p, I_SH) + (((size_t)j * 128 + b) * 8 + h) * 16384;
#pragma unroll
    for (int kt = 0; kt < 8; ++kt)
#pragma unroll
      for (int e = 0; e < 4; ++e) S[kt][e] = s0[(kt * 16 + fq * 4 + e) * 128 + wid * 16 + fr];
  } else {
#pragma unroll
    for (int kt = 0; kt < 8; ++kt) S[kt] = (f32x4){0.f, 0.f, 0.f, 0.f};
  }
  const int dkp = wid * 16 + fq * 4;
  float lb[4];
#pragma unroll
  for (int e = 0; e < 4; ++e) {
    if (j == 0) lb[e] = 0.f;
    else { const int c = h * 128 + dkp + e; lb[e] = sigmoidf_(pin(p, I_LB)[1024 + c] - pin(p, I_LB)[c]); }
  }
  float og[4];
#pragma unroll
  for (int e = 0; e < 4; ++e) og[e] = pin(p, I_ONG)[j * 128 + wid * 16 + fq * 4 + e];

  HgRaw raw[4];
#pragma unroll
  for (int u = 0; u < 4; ++u) { raw[u].q = raw[u].f = raw[u].v = raw[u].g = (u32x2){0u, 0u}; hg_load(raw[u], proj, g0, T, u, h, wid, fr, fq, tid); }
  u32x2 gsave[2] = {(u32x2){0u, 0u}, (u32x2){0u, 0u}};
  f32x4 oprev = {0.f, 0.f, 0.f, 0.f};

  for (int i4 = 0; i4 < nsub; i4 += 4) {
#pragma unroll
    for (int u = 0; u < 4; ++u) {
      const int i = i4 + u;
      if (i < nsub) {
        const int s = u & 1;
        bfr* Qs = lds0 + s * HG_SET; bfr* Kh = Qs + 16 * 136; bfr* Kt = Kh + 16 * 136; bfr* Vt = Kt + 128 * KTS;
        float* dec = decb + s * 128; float* red = redb + s * 128;
        {
          const int sb = i * 16;
          const bool valid = (sb + fr) < T;
          float q[4], P[4], kv[4];
          const float qz[4] = {bflo(raw[u].q.x), bfhi(raw[u].q.x), bflo(raw[u].q.y), bfhi(raw[u].q.y)};
          const float fz[4] = {bflo(raw[u].f.x), bfhi(raw[u].f.x), bflo(raw[u].f.y), bfhi(raw[u].f.y)};
#pragma unroll
          for (int e = 0; e < 4; ++e) {
            const float sg = sigmoidf_(fz[e]);
            const float f = fmaxf(lb[e] + (1.f - lb[e]) * sg, 1e-30f);
            P[e] = valid ? f : 1.f;
            kv[e] = valid ? (1.f - lb[e]) * (1.f - sg) : 0.f;
            q[e] = valid ? qz[e] * sigmoidf_(qz[e]) : 0.f;
          }
#pragma unroll
          for (int e = 0; e < 4; ++e) {
            P[e] *= __builtin_bit_cast(float, __builtin_amdgcn_update_dpp(0x3f800000, __builtin_bit_cast(int, P[e]), 0x111, 0xf, 0xf, false));
            P[e] *= __builtin_bit_cast(float, __builtin_amdgcn_update_dpp(0x3f800000, __builtin_bit_cast(int, P[e]), 0x112, 0xf, 0xf, false));
            P[e] *= __builtin_bit_cast(float, __builtin_amdgcn_update_dpp(0x3f800000, __builtin_bit_cast(int, P[e]), 0x114, 0xf, 0xf, false));
            P[e] *= __builtin_bit_cast(float, __builtin_amdgcn_update_dpp(0x3f800000, __builtin_bit_cast(int, P[e]), 0x118, 0xf, 0xf, false));
          }
          float qt[4], kh[4], kt[4];
#pragma unroll
          for (int e = 0; e < 4; ++e) {
            const float Pl = bperm(P[e], lane | 15);
            const float inv = frcp(fmaxf(P[e], 1e-30f));
            qt[e] = q[e] * P[e]; kh[e] = kv[e] * inv; kt[e] = kh[e] * Pl;
          }
          if (fr == 15) *(f32x4*)(dec + dkp) = (f32x4){P[0], P[1], P[2], P[3]};
          const int kpos = (wid >> 1) * 32 + fq * 8 + (wid & 1) * 4;
          u32x2 o; o.x = cvt_pk(qt[0], qt[1]); o.y = cvt_pk(qt[2], qt[3]);
          *(u32x2*)(Qs + fr * 136 + kpos) = o;
          o.x = cvt_pk(kh[0], kh[1]); o.y = cvt_pk(kh[2], kh[3]);
          *(u32x2*)(Kh + fr * 136 + kpos) = o;
          { const unsigned k01 = cvt_pk(kt[0], kt[1]), k23 = cvt_pk(kt[2], kt[3]);
            Kt[(dkp + 0) * KTS + fr] = (bfr)(k01 & 0xffff); Kt[(dkp + 1) * KTS + fr] = (bfr)(k01 >> 16);
            Kt[(dkp + 2) * KTS + fr] = (bfr)(k23 & 0xffff); Kt[(dkp + 3) * KTS + fr] = (bfr)(k23 >> 16); }
          const int vt = tid >> 5, dv4 = (tid & 31) << 2;
          const bool vv = (sb + vt) < T;
          const unsigned vx = vv ? raw[u].v.x : 0u, vy = vv ? raw[u].v.y : 0u;
          Vt[(dv4 + 0) * KTS + vt] = (bfr)(vx & 0xffff); Vt[(dv4 + 1) * KTS + vt] = (bfr)(vx >> 16);
          Vt[(dv4 + 2) * KTS + vt] = (bfr)(vy & 0xffff); Vt[(dv4 + 3) * KTS + vt] = (bfr)(vy >> 16);
          gsave[s] = raw[u].g;
          hg_load(raw[u], proj, g0, T, i + 4, h, wid, fr, fq, tid);
        }
        __syncthreads();
        if (i > 0) {
          const float* redp = redb + (s ^ 1) * 128;
          float tot = 0.f;
#pragma unroll
          for (int w = 0; w < 8; ++w) tot += redp[fr * 8 + w];
          const float rs = rsqrtf(tot * (1.f / 128.f) + 1e-6f);
          const int tk = (i - 1) * 16 + fr;
          if (tk < T) {
            const u32x2 gw = gsave[s ^ 1];
            const float gg[4] = {bflo(gw.x), bfhi(gw.x), bflo(gw.y), bfhi(gw.y)};
            float r[4];
#pragma unroll
            for (int e = 0; e < 4; ++e) r[e] = oprev[e] * rs * og[e] * gg[e] * sigmoidf_(gg[e]);
            u32x2 o; o.x = cvt_pk(r[0], r[1]); o.y = cvt_pk(r[2], r[3]);
            *(u32x2*)(branch + (size_t)(g0 + tk) * BRW + h * 128 + wid * 16 + fq * 4) = o;
          }
        }
        {
          bf16x8 qp[4], kp[4];
#pragma unroll
          for (int uu = 0; uu < 4; ++uu) {
            qp[uu] = *(const bf16x8*)(Qs + fr * 136 + uu * 32 + fq * 8);
            kp[uu] = *(const bf16x8*)(Kh + fr * 136 + uu * 32 + fq * 8);
          }
          f32x4 at = {0.f, 0.f, 0.f, 0.f};
#pragma unroll
          for (int uu = 0; uu < 4; ++uu) at = __builtin_amdgcn_mfma_f32_16x16x32_bf16(kp[uu], qp[uu], at, 0, 0, 0);
#pragma unroll
          for (int e = 0; e < 4; ++e) if (fq * 4 + e > fr) at[e] = 0.f;
          u32x2 aw; aw.x = cvt_pk(at[0], at[1]); aw.y = cvt_pk(at[2], at[3]);
          const bf16x4 a4 = __builtin_bit_cast(bf16x4, aw);
          u32x2 vfw; { const unsigned* q2 = (const unsigned*)(Vt + (wid * 16 + fr) * KTS + fq * 4); vfw.x = q2[0]; vfw.y = q2[1]; }
          const bf16x4 vf = __builtin_bit_cast(bf16x4, vfw);
          const bf16x8 vf8 = {vf[0], vf[1], vf[2], vf[3], 0, 0, 0, 0}, a8 = {a4[0], a4[1], a4[2], a4[3], 0, 0, 0, 0};
          f32x4 oacc = __builtin_amdgcn_mfma_f32_16x16x32_bf16(vf8, a8, (f32x4){0.f, 0.f, 0.f, 0.f}, 0, 0, 0);
#pragma unroll
          for (int uu = 0; uu < 4; ++uu) {
            u32x4 w; w.x = cvt_pk(S[2 * uu][0], S[2 * uu][1]); w.y = cvt_pk(S[2 * uu][2], S[2 * uu][3]);
            w.z = cvt_pk(S[2 * uu + 1][0], S[2 * uu + 1][1]); w.w = cvt_pk(S[2 * uu + 1][2], S[2 * uu + 1][3]);
            oacc = __builtin_amdgcn_mfma_f32_16x16x32_bf16(__builtin_bit_cast(bf16x8, w), qp[uu], oacc, 0, 0, 0);
          }
#pragma unroll
          for (int kt = 0; kt < 8; ++kt) {
            const f32x4 d = *(const f32x4*)(dec + kt * 16 + fq * 4);
            u32x2 kfw; { const unsigned* q2 = (const unsigned*)(Kt + (kt * 16 + fr) * KTS + fq * 4); kfw.x = q2[0]; kfw.y = q2[1]; }
            const bf16x4 kf = __builtin_bit_cast(bf16x4, kfw);
            const bf16x8 kf8 = {kf[0], kf[1], kf[2], kf[3], 0, 0, 0, 0};
            S[kt] = __builtin_amdgcn_mfma_f32_16x16x32_bf16(kf8, vf8, S[kt] * d, 0, 0, 0);
          }
          float ss = oacc[0] * oacc[0] + oacc[1] * oacc[1] + oacc[2] * oacc[2] + oacc[3] * oacc[3];
          ss += bperm(ss, lane ^ 16); ss += bperm(ss, lane ^ 32);
          if (fq == 0) red[fr * 8 + wid] = ss;
          oprev = oacc;
        }
      }
    }
  }
  __syncthreads();
  {
    const int i = nsub - 1, s = i & 1;
    const float* redp = redb + s * 128;
    float tot = 0.f;
#pragma unroll
    for (int w = 0; w < 8; ++w) tot += redp[fr * 8 + w];
    const float rs = rsqrtf(tot * (1.f / 128.f) + 1e-6f);
    const int tk = i * 16 + fr;
    if (tk < T) {
      const u32x2 gw = gsave[s];
      const float gg[4] = {bflo(gw.x), bfhi(gw.x), bflo(gw.y), bfhi(gw.y)};
      float r[4];
#pragma unroll
      for (int e = 0; e < 4; ++e) r[e] = oprev[e] * rs * og[e] * gg[e] * sigmoidf_(gg[e]);
      u32x2 o; o.x = cvt_pk(r[0], r[1]); o.y = cvt_pk(r[2], r[3]);
      *(u32x2*)(branch + (size_t)(g0 + tk) * BRW + h * 128 + wid * 16 + fq * 4) = o;
    }
  }
  float* so = p.out + (smp ? O_SHS + (((size_t)j * 128 + b) * 8 + h) * 16384 : O_SHP + (((size_t)j * 8 + b) * 8 + h) * 16384);
#pragma unroll
  for (int kt = 0; kt < 8; ++kt)
#pragma unroll
    for (int e = 0; e < 4; ++e) so[(kt * 16 + fq * 4 + e) * 128 + wid * 16 + fr] = S[kt][e];
  __syncthreads();
}

#define LDS_BARRIER() do { asm volatile("s_waitcnt lgkmcnt(0)" ::: "memory"); __builtin_amdgcn_s_barrier(); asm volatile("" ::: "memory"); } while (0)
typedef float f32x2 __attribute__((ext_vector_type(2)));
struct RwRaw { u32x2 r, k, v, gt, ew, a, vg, vf; };
constexpr int RW_SET = 7 * 1024;
struct RwCtx {
  const bfr* proj; const bfr* lup; const bfr* vfsrc; bfr* vdst; bfr* branch;
  int vgoff, vfld;
  int g0, T, tsl, cq4, C4;
  f32x4 kkw, kaw, rkw, lng, lnb;
};
__device__ __forceinline__ float sum16(float v) {
  v += dppf<0xB1>(v); v += dppf<0x4E>(v); v += dppf<0x141>(v); v += dppf<0x140>(v);
  return v;
}
__device__ __forceinline__ f32x4 unpk4(const u32x2 w) { return (f32x4){bflo(w.x), bfhi(w.x), bflo(w.y), bfhi(w.y)}; }
__device__ __forceinline__ void rw_load(RwRaw& raw, const RwCtx& c, const int tile) {
  int tok = tile * 16 + c.tsl; tok = tok < c.T ? tok : c.T - 1;
  const size_t g = (size_t)(c.g0 + tok);
  const bfr* pr = c.proj + g * INC + c.C4;
  raw.r = *(const u32x2*)pr; raw.k = *(const u32x2*)(pr + 1024); raw.v = *(const u32x2*)(pr + 2048); raw.gt = *(const u32x2*)(pr + 3584);
  const bfr* pl = c.lup + g * 3072 + c.C4;
  raw.ew = *(const u32x2*)pl; raw.a = *(const u32x2*)(pl + 1024); raw.vg = *(const u32x2*)(pl + c.vgoff);
  raw.vf = *(const u32x2*)(c.vfsrc + g * c.vfld + c.C4);
}
__device__ __forceinline__ void rw_prep(const RwRaw& raw, f32x4& bon, f32x4& gt, float* __restrict__ L, const RwCtx& c, const int tile) {
  int tok = tile * 16 + c.tsl; tok = tok < c.T ? tok : c.T - 1;
  const int tt = tok & 15;
  const size_t g = (size_t)(c.g0 + tok);
  const f32x4 r = unpk4(raw.r), k = unpk4(raw.k), ew = unpk4(raw.ew), a = unpk4(raw.a);
  f32x4 v = unpk4(raw.v);
  *(u32x2*)(c.vdst + g * DM + c.C4) = raw.v;
  v = v + (unpk4(raw.vf) - v) * unpk4(raw.vg);
  f32x4 dcy; dcy[0] = __expf(ew[0]); dcy[1] = __expf(ew[1]); dcy[2] = __expf(ew[2]); dcy[3] = __expf(ew[3]);
  f32x4 kk = k * c.kkw;
  const float n2 = sum16((kk[0] * kk[0] + kk[1] * kk[1]) + (kk[2] * kk[2] + kk[3] * kk[3]));
  const float inv = __builtin_amdgcn_rsqf(fmaxf(n2, 1e-24f));
  kk = kk * inv;
  const f32x4 k2 = k * (1.f + (a - 1.f) * c.kaw);
  const f32x4 rk = r * k2 * c.rkw;
  const float sb = sum16((rk[0] + rk[1]) + (rk[2] + rk[3]));
  bon = v * sb;
  gt = unpk4(raw.gt);
  const int o = tt * 64 + c.cq4;
  *(f32x4*)(L + 0 * 1024 + o) = r; *(f32x4*)(L + 1 * 1024 + o) = dcy; *(f32x4*)(L + 2 * 1024 + o) = k2; *(f32x4*)(L + 3 * 1024 + o) = v;
  *(f32x4*)(L + 4 * 1024 + o) = -kk; *(f32x4*)(L + 5 * 1024 + o) = kk * a;
}
__device__ __forceinline__ void rw_post(const f32x4 bon, const f32x4 gt, const float* __restrict__ L, const RwCtx& c, const int tile) {
  int tok = tile * 16 + c.tsl; tok = tok < c.T ? tok : c.T - 1;
  const int tt = tok & 15;
  const size_t g = (size_t)(c.g0 + tok);
  const f32x4 y = *(const f32x4*)(L + 6 * 1024 + tt * 64 + c.cq4);
  const float mean = sum16((y[0] + y[1]) + (y[2] + y[3])) * (1.f / 64.f);
  const f32x4 d = y - mean;
  const float var = sum16((d[0] * d[0] + d[1] * d[1]) + (d[2] * d[2] + d[3] * d[3])) * (1.f / 64.f);
  f32x4 o = d * rsqrtf(var + 64e-5f) * c.lng + c.lnb + bon;
  o[0] *= gt[0] * sigmoidf_(gt[0]); o[1] *= gt[1] * sigmoidf_(gt[1]); o[2] *= gt[2] * sigmoidf_(gt[2]); o[3] *= gt[3] * sigmoidf_(gt[3]);
  u32x2 w; w.x = cvt_pk(o[0], o[1]); w.y = cvt_pk(o[2], o[3]);
  *(u32x2*)(c.branch + g * BRW + c.C4) = w;
}
struct RwVec { f32x4 r0, r1, w0, w1, k0, k1, a0, a1, b0, b1; float v; };
__device__ __forceinline__ void rw_ldvec(RwVec& x, const float* __restrict__ L, const int t, const int row, const int c0) {
  x.r0 = *(const f32x4*)(L + 0 * 1024 + t * 64 + c0); x.r1 = *(const f32x4*)(L + 0 * 1024 + t * 64 + c0 + 4);
  x.w0 = *(const f32x4*)(L + 1 * 1024 + t * 64 + c0); x.w1 = *(const f32x4*)(L + 1 * 1024 + t * 64 + c0 + 4);
  x.k0 = *(const f32x4*)(L + 2 * 1024 + t * 64 + c0); x.k1 = *(const f32x4*)(L + 2 * 1024 + t * 64 + c0 + 4);
  x.v = L[3 * 1024 + t * 64 + row];
  x.a0 = *(const f32x4*)(L + 4 * 1024 + t * 64 + c0); x.a1 = *(const f32x4*)(L + 4 * 1024 + t * 64 + c0 + 4);
  x.b0 = *(const f32x4*)(L + 5 * 1024 + t * 64 + c0); x.b1 = *(const f32x4*)(L + 5 * 1024 + t * 64 + c0 + 4);
}
template <int NST>
__device__ __forceinline__ void rw_scan(f32x2 (&S)[4], float* __restrict__ L, const int row, const int c0, const int cg) {
  RwVec cur, nxt;
  rw_ldvec(cur, L, 0, row, c0);
  float yp[NST / 2], ra[NST / 2];
  const bool hi = (cg & 4) != 0, b1 = (cg & 2) != 0, b0 = (cg & 1) != 0;
#pragma unroll
  for (int t = 0; t < NST; ++t) {
    if (t + 1 < NST) rw_ldvec(nxt, L, t + 1, row, c0);
    const f32x2 av[4] = {{cur.a0[0], cur.a0[1]}, {cur.a0[2], cur.a0[3]}, {cur.a1[0], cur.a1[1]}, {cur.a1[2], cur.a1[3]}};
    const f32x2 wv[4] = {{cur.w0[0], cur.w0[1]}, {cur.w0[2], cur.w0[3]}, {cur.w1[0], cur.w1[1]}, {cur.w1[2], cur.w1[3]}};
    const f32x2 bv[4] = {{cur.b0[0], cur.b0[1]}, {cur.b0[2], cur.b0[3]}, {cur.b1[0], cur.b1[1]}, {cur.b1[2], cur.b1[3]}};
    const f32x2 kv[4] = {{cur.k0[0], cur.k0[1]}, {cur.k0[2], cur.k0[3]}, {cur.k1[0], cur.k1[1]}, {cur.k1[2], cur.k1[3]}};
    const f32x2 rv[4] = {{cur.r0[0], cur.r0[1]}, {cur.r0[2], cur.r0[3]}, {cur.r1[0], cur.r1[1]}, {cur.r1[2], cur.r1[3]}};
    const f32x2 vi2 = {cur.v, cur.v};
    f32x2 pa = S[0] * av[0] + S[1] * av[1];
    const f32x2 pb = S[2] * av[2] + S[3] * av[3];
    f32x2 n[4];
#pragma unroll
    for (int q = 0; q < 4; ++q) n[q] = S[q] * wv[q] + vi2 * kv[q];
    pa += pb;
    const float sa = sum8(pa[0] + pa[1]);
    const f32x2 sa2 = {sa, sa};
#pragma unroll
    for (int q = 0; q < 4; ++q) S[q] = sa2 * bv[q] + n[q];
    f32x2 ya = S[0] * rv[0] + S[1] * rv[1];
    const f32x2 yb = S[2] * rv[2] + S[3] * rv[3];
    ya += yb;
    if (t < NST / 2) yp[t] = ya[0] + ya[1];
    else { const float lo = yp[t - NST / 2], hv = ya[0] + ya[1]; const float mine = hi ? hv : lo, send = hi ? lo : hv; ra[t - NST / 2] = mine + dppf<0x141>(send); }
    cur = nxt;
  }
  float rb[NST / 4], rc[NST / 8];
#pragma unroll
  for (int k = 0; k < NST / 4; ++k) { const float mine = b1 ? ra[k + NST / 4] : ra[k], send = b1 ? ra[k] : ra[k + NST / 4]; rb[k] = mine + dppf<0x4E>(send); }
#pragma unroll
  for (int k = 0; k < NST / 8; ++k) { const float mine = b0 ? rb[k + NST / 8] : rb[k], send = b0 ? rb[k] : rb[k + NST / 8]; rc[k] = mine + dppf<0xB1>(send); }
  const int base = (hi ? NST / 2 : 0) + (b1 ? NST / 4 : 0) + (b0 ? NST / 8 : 0);
#pragma unroll
  for (int k = 0; k < NST / 8; ++k) L[6 * 1024 + (base + k) * 64 + row] = rc[k];
}

__device__ __forceinline__ void rwkv_unit(const Params& p, const int l, const bool smp, const int b, const int head) {
  extern __shared__ __attribute__((aligned(16))) char smem[];
  float* L0 = (float*)smem;
  float* L1 = L0 + RW_SET;
  RwCtx c;
  const int tid = tidx();
  const int wid = tid >> 6, lane = tid & 63;
  const int j = l >> 1;
  c.proj = (const bfr*)(p.ws + WS_PROJ);
  c.lup = (const bfr*)(p.ws + WS_LUP);
  c.vfsrc = (j == 0) ? c.proj + 2048 : (const bfr*)(p.ws + WS_VFIRST);
  c.vfld = (j == 0) ? INC : DM;
  c.vgoff = (j == 0) ? 1024 : 2048;
  c.vdst = (j == 0) ? (bfr*)(p.ws + WS_VFIRST) : (bfr*)(p.ws + WS_HA + 2 * HA_SZ * 2);
  c.branch = (bfr*)(p.ws + WS_BRANCH);
  c.g0 = smp ? NPR + b * 8 : b * 2048;
  c.T = smp ? 8 : 2048;
  c.tsl = 2 * wid + ((lane >> 4) & 1);
  c.cq4 = (lane & 15) * 4;
  c.C4 = head * 64 + c.cq4;
  const int cg = lane & 7, row = wid * 8 + (lane >> 3), c0 = cg * 8;
  f32x2 S[4];
  if (smp) {
    const float* s0 = pin(p, I_SR) + ((((size_t)j * 128 + b) * 16 + head) * 64 + row) * 64 + c0;
    const float4 a = *(const float4*)s0, bq = *(const float4*)(s0 + 4);
    S[0] = (f32x2){a.x, a.y}; S[1] = (f32x2){a.z, a.w}; S[2] = (f32x2){bq.x, bq.y}; S[3] = (f32x2){bq.z, bq.w};
  } else {
    S[0] = S[1] = S[2] = S[3] = (f32x2){0.f, 0.f};
  }
  c.kkw = *(const f32x4*)(pin(p, I_KK) + j * DM + c.C4); c.kaw = *(const f32x4*)(pin(p, I_KA) + j * DM + c.C4); c.rkw = *(const f32x4*)(pin(p, I_RK) + j * DM + c.C4);
  c.lng = *(const f32x4*)(pin(p, I_LG) + j * DM + c.C4); c.lnb = *(const f32x4*)(pin(p, I_LBI) + j * DM + c.C4);
  RwRaw rawA, rawB;
  f32x4 bonA, bonB, gtA, gtB;
  if (smp) {
    rw_load(rawA, c, 0);
    rw_prep(rawA, bonA, gtA, L0, c, 0);
    LDS_BARRIER();
    rw_scan<8>(S, L0, row, c0, cg);
    LDS_BARRIER();
    rw_post(bonA, gtA, L0, c, 0);
  } else {
    const int ntile = 128;
    rw_load(rawA, c, 0); rw_load(rawB, c, 1);
    rw_prep(rawA, bonA, gtA, L0, c, 0); rw_load(rawA, c, 2);
    LDS_BARRIER();
    rw_scan<16>(S, L0, row, c0, cg); rw_prep(rawB, bonB, gtB, L1, c, 1); rw_load(rawB, c, 3);
    LDS_BARRIER();
    for (int i = 1; i < ntile - 1; i += 2) {
      rw_post(bonA, gtA, L0, c, i - 1); rw_scan<16>(S, L1, row, c0, cg); rw_prep(rawA, bonA, gtA, L0, c, i + 1); rw_load(rawA, c, i + 3);
      LDS_BARRIER();
      rw_post(bonB, gtB, L1, c, i); rw_scan<16>(S, L0, row, c0, cg); rw_prep(rawB, bonB, gtB, L1, c, i + 2); rw_load(rawB, c, i + 4);
      LDS_BARRIER();
    }
    rw_post(bonA, gtA, L0, c, ntile - 2); rw_scan<16>(S, L1, row, c0, cg);
    LDS_BARRIER();
    rw_post(bonB, gtB, L1, c, ntile - 1);
  }
  float* so = p.out + (smp ? O_SRS + ((((size_t)j * 128 + b) * 16 + head) * 64 + row) * 64 + c0 : O_SRP + ((((size_t)j * 8 + b) * 16 + head) * 64 + row) * 64 + c0);
  *(float4*)so = make_float4(S[0][0], S[0][1], S[1][0], S[1][1]); *(float4*)(so + 4) = make_float4(S[2][0], S[2][1], S[3][0], S[3][1]);
  __syncthreads();
}

__device__ __forceinline__ void mix_phase(const Params& p, const int l, const int rep) {
  __shared__ int s_item;
  unsigned* ctr = (unsigned*)(p.ws + WS_CTRL) + l + 4 * rep;
  const bool rw = l & 1;
  const int nP = rw ? 128 : 64, nS = rw ? 2048 : 1024;
  const int nitems = nP + nS + 1024;
  for (;;) {
    __syncthreads();
    if (tidx() == 0) s_item = (int)atomicAdd(ctr, 1u);
    __syncthreads();
    int it = s_item;
    if (rep > 0 && PROBE_SUB == 1) { if (it >= nP) break; }
    if (rep > 0 && PROBE_SUB == 2) { it += nP; if (it >= nP + nS) break; }
    if (rep > 0 && PROBE_SUB == 3) { it += nP + nS; }
    if (it >= nitems) break;
    if (it < nP + nS) {
      const bool smp = it >= nP;
      if (smp) it -= nP;
      if (rw) rwkv_unit(p, l, smp, it >> 4, it & 15); else hgrn_unit(p, l, smp, it >> 3, it & 7);
    } else {
      it -= nP + nS;
      const float* kb; const float* vb; int g0, ntok, head;
      if (it < 512) {
        const int b = it >> 6, blk = it & 15; head = (it >> 4) & 3;
        const size_t off = ((size_t)(l * 8 + b) * 256) * 512 + head * 128;
        kb = p.out + O_MK + off; vb = p.out + O_MV + off; g0 = b * 2048 + blk * 128; ntok = 128;
      } else {
        it -= 512;
        const int b = it >> 2; head = it & 3;
        const size_t off = ((size_t)(l * 128 + b) * 256) * 512 + head * 128;
        kb = pin(p, I_CK) + off; vb = pin(p, I_CV) + off; g0 = NPR + b * 8; ntok = 8;
      }
      xattn_unit(p, kb, vb, g0, ntok, head);
    }
  }
}

#define XB_TMO      128
#define XB_XCNT(j)  (256  + 64 * (j))
#define XB_XSUB(j)  (1280 + 64 * (j))
#define XB_XGEN(j)  (2304 + 64 * (j))
#define XB_TOP      3328
#define XB_TOPGEN   3392
#define XB_SPIN_CAP (1u << 18)
#define XB_LAS __attribute__((address_space(3)))
__device__ __forceinline__ unsigned xb_ld(unsigned* p)              { return __hip_atomic_load(p, __ATOMIC_RELAXED, __HIP_MEMORY_SCOPE_AGENT); }
__device__ __forceinline__ unsigned xb_add(unsigned* p, unsigned v) { return __hip_atomic_fetch_add(p, v, __ATOMIC_RELAXED, __HIP_MEMORY_SCOPE_AGENT); }
__device__ __forceinline__ unsigned xb_xcc_id() { return (unsigned)__builtin_amdgcn_s_getreg((3 << 11) | 20) & 0xFu; }
#define XB_SPIN(cond, bar) do { unsigned _sp = 0; while (cond) { __builtin_amdgcn_s_sleep(1); \
    if ((++_sp & 255u) == 0u) { if (xb_ld(&(bar)[XB_TMO])) break; if (_sp > XB_SPIN_CAP) { atomicAdd(&(bar)[XB_TMO], 1u); break; } } } } while (0)
__device__ __forceinline__ void xcd_barrier_complete(unsigned* bar, unsigned x, unsigned& nloc, unsigned& nx) {
  const unsigned G = gridDim.x;
  unsigned sum, cnt, mine, sp = 0u;
  for (;;) {
    sum = 0u; cnt = 0u; mine = 0u;
#pragma unroll
    for (unsigned j = 0; j < 16; ++j) { const unsigned c = xb_ld(&bar[XB_XCNT(j)]); sum += c; cnt += (c > 0u) ? 1u : 0u; mine = (j == x) ? c : mine; }
    if (sum == G) break;
    __builtin_amdgcn_s_sleep(1);
    if ((++sp & 255u) == 0u) { if (xb_ld(&bar[XB_TMO])) break; if (sp > XB_SPIN_CAP) { atomicAdd(&bar[XB_TMO], 1u); break; } }
  }
  nloc = mine > 0u ? mine : 1u; nx = cnt > 0u ? cnt : 1u;
}
__device__ __forceinline__ void grid_barrier(unsigned* bar, volatile XB_LAS unsigned* st) {
  asm volatile("s_waitcnt vmcnt(0)" ::: "memory");
  __syncthreads();
  if (threadIdx.x == 0) {
    const unsigned x = xb_xcc_id();
    __builtin_amdgcn_s_waitcnt(0);
    unsigned nloc = st[0], nx = st[1];
    if (nloc == 0u) { xcd_barrier_complete(bar, x, nloc, nx); st[0] = nloc; st[1] = nx; }
    const unsigned old = xb_add(&bar[XB_XSUB(x)], 1u);
    const unsigned gen = old / nloc;
    if (old + 1u == (gen + 1u) * nloc) {
      __builtin_amdgcn_fence(__ATOMIC_RELEASE, "agent");
      asm volatile("s_waitcnt vmcnt(0)" ::: "memory");
      const unsigned og = xb_add(&bar[XB_TOP], 1u);
      const unsigned tg = og / nx;
      if (og + 1u == (tg + 1u) * nx) xb_add(&bar[XB_TOPGEN], 1u);
      else XB_SPIN(xb_ld(&bar[XB_TOPGEN]) == tg, bar);
      __builtin_amdgcn_fence(__ATOMIC_ACQUIRE, "agent");
      xb_add(&bar[XB_XGEN(x)], 1u);
      asm volatile("s_waitcnt vmcnt(0)" ::: "memory");
    } else {
      XB_SPIN(xb_ld(&bar[XB_XGEN(x)]) == gen, bar);
      __builtin_amdgcn_fence(__ATOMIC_ACQUIRE, "agent");
      asm volatile("s_waitcnt vmcnt(0)" ::: "memory");
    }
  }
  __syncthreads();
}
__device__ __forceinline__ void run_phase(const Params& p, const int ph, const int rep) {
  int code;
  switch (ph) {
    case 0: code = 0; break;
    case 1: code = 1 | (0 << 4) | (0 << 8); break;
    case 2: code = 2 | (0 << 8); break;
    case 3: code = 1 | (2 << 4) | (0 << 8); break;
    case 4: code = 3 | (1 << 8); break;
    case 5: code = 1 | (0 << 4) | (1 << 8); break;
    case 6: code = 1 | (1 << 4) | (1 << 8); break;
    case 7: code = 2 | (1 << 8); break;
    case 8: code = 1 | (2 << 4) | (1 << 8); break;
    case 9: code = 3 | (2 << 8); break;
    case 10: code = 1 | (0 << 4) | (2 << 8); break;
    case 11: code = 2 | (2 << 8); break;
    case 12: code = 1 | (2 << 4) | (2 << 8); break;
    case 13: code = 3 | (3 << 8); break;
    case 14: code = 1 | (0 << 4) | (3 << 8); break;
    case 15: code = 1 | (1 << 4) | (3 << 8); break;
    case 16: code = 2 | (3 << 8); break;
    case 17: code = 1 | (2 << 4) | (3 << 8); break;
    default: code = 4; break;
  }
  const int type = code & 15, kind = (code >> 4) & 15, l = code >> 8;
  if (type == 0) prologue(p);
  else if (type == 1) gemm_phase(p, kind, l);
  else if (type == 2) mix_phase(p, l, rep);
  else if (type == 3) prep_phase(p, l);
  else final_phase(p);
}
constexpr int NPHASE = 19;

__global__ void __launch_bounds__(512) mega(Params p) {
  __shared__ uint4 xb_words;
  if (threadIdx.x == 0) {
    xb_words = make_uint4(0u, 0u, 0u, 0u);
    (void)xb_add(&((unsigned*)(p.ws + WS_XBAR))[XB_XCNT(xb_xcc_id())], 1u);
  }
  __syncthreads();
  for (int ph = p.ph_lo; ph <= p.ph_hi; ++ph) {
    const int nrep = ((PROBE_MASK >> ph) & 1u) ? 2 : 1;
    for (int rep = 0; rep < nrep; ++rep) {
      run_phase(p, ph, rep);
      if (ph < p.ph_hi || rep + 1 < nrep) {
        if (p.ph_hi < 0) cg::this_grid().sync();
        grid_barrier((unsigned*)(p.ws + WS_XBAR), (volatile XB_LAS unsigned*)&xb_words);
      }
    }
  }
}

extern "C" void kernel_launch(void* const* d_in, const int* in_sizes, int n_in, void* d_out, int out_size, void* d_ws, size_t ws_size,
                              hipStream_t stream) {
  static int grid = 0;
  if (grid == 0) {
    if (n_in != 31 || ws_size < WS_END) { fprintf(stderr, "kernel_launch: unexpected n_in %d / ws %zu (need %zu)\n", n_in, ws_size, (size_t)WS_END); grid = -1; return; }
    int dev = 0, cus = 0, per_cu = 0;
    hipGetDevice(&dev);
    hipDeviceGetAttribute(&cus, hipDeviceAttributeMultiprocessorCount, dev);
    if (hipFuncSetAttribute((const void*)mega, hipFuncAttributeMaxDynamicSharedMemorySize, LDS_BYTES) != hipSuccess) { fprintf(stderr, "hipFuncSetAttribute failed\n"); grid = -1; return; }
    hipOccupancyMaxActiveBlocksPerMultiprocessor(&per_cu, (const void*)mega, 512, LDS_BYTES);
    if (per_cu < 1) { fprintf(stderr, "occupancy query says %d blocks/CU\n", per_cu); per_cu = 1; }
    (void)hipGetLastError();
    grid = cus * per_cu;
  }
  if (grid < 0) return;
  Params p{};
  for (int i = 0; i < 31; ++i) p.in[i] = (const float*)d_in[i];
  p.out = (float*)d_out; p.ws = (char*)d_ws;
  if (hipMemsetAsync((char*)d_ws + WS_XBAR, 0, 16384, stream) != hipSuccess) { fprintf(stderr, "kernel_launch: barrier-word memset failed\n"); return; }
  if (hipMemsetAsync((char*)d_ws + WS_CTRL, 0, 4096, stream) != hipSuccess) { fprintf(stderr, "kernel_launch: control-word memset failed\n"); return; }
#if COOP
  p.ph_lo = 0; p.ph_hi = NPHASE - 1;
  void* args[] = {&p};
  hipError_t e = hipLaunchCooperativeKernel((const void*)mega, dim3(grid), dim3(512), args, LDS_BYTES, stream);
  if (e != hipSuccess) fprintf(stderr, "cooperative launch failed: %s (grid %d)\n", hipGetErrorString(e), grid);
#else
  for (int ph = 0; ph < NPHASE; ++ph) {
    p.ph_lo = ph; p.ph_hi = ph;
    hipLaunchKernelGGL(mega, dim3(grid), dim3(512), LDS_BYTES, stream, p);
  }
#endif
}
```

```cpp
#include <hip/hip_runtime.h>
#include <hip/hip_cooperative_groups.h>
#include <cstdio>
#include <cstdint>
namespace cg = cooperative_groups;

#ifndef COOP
#define COOP 1
#endif
#ifndef PROBE_SUB
#define PROBE_SUB 0
#endif
#ifndef PROBE_MASK
#define PROBE_MASK 0u
#endif

typedef unsigned short bfr;
typedef short bf16x8 __attribute__((ext_vector_type(8)));
typedef short bf16x4 __attribute__((ext_vector_type(4)));
typedef float f32x4 __attribute__((ext_vector_type(4)));
typedef unsigned u32x2 __attribute__((ext_vector_type(2)));
typedef unsigned u32x4 __attribute__((ext_vector_type(4)));

constexpr int NTOK = 17408, NPR = 16384, DM = 1024, INC = 5120, BRW = 1536;
constexpr int LDS_BYTES = 139264;
constexpr size_t O_YP = 0, O_SHP = 17825792, O_SRP = 19922944, O_SSP = 20971520, O_MK = 20987904, O_MV = 25182208,
                 O_SHS = 29376512, O_SRS = 62930944, O_SSS = 79708160;
constexpr size_t WS_CTRL = 0;
constexpr size_t WS_XBAR = 4096;
constexpr size_t WS_WTIN = 4096 + 16384;
constexpr size_t WTIN_L = (size_t)5888 * 1024;
constexpr size_t WS_WTOUT = WS_WTIN + 4 * WTIN_L * 2;
constexpr size_t WS_WTMEM = WS_WTOUT + (size_t)4 * 1024 * 1536 * 2;
constexpr size_t WS_W2T = WS_WTMEM + (size_t)4 * 1024 * 1024 * 2;
constexpr size_t WS_MEMN = WS_W2T + (size_t)2 * 3072 * 256 * 2;
constexpr size_t WS_XRES = WS_MEMN + (size_t)4 * 2048 * 1024 * 2;
constexpr size_t HA_SZ = (size_t)NTOK * 1024;
constexpr size_t WS_HA = WS_XRES + (size_t)NTOK * 1024 * 4;
constexpr size_t WS_PROJ = WS_HA + 6 * HA_SZ * 2;
constexpr size_t WS_ALORA = WS_PROJ + (size_t)NTOK * INC * 2;
constexpr size_t WS_LUP = WS_ALORA + (size_t)NTOK * 256 * 2;
constexpr size_t WS_VFIRST = WS_LUP + (size_t)NTOK * 3072 * 2;
constexpr size_t WS_BRANCH = WS_VFIRST + HA_SZ * 2;
constexpr size_t WS_PART = WS_BRANCH + (size_t)NTOK * BRW * 2;
constexpr size_t WS_END = WS_PART + (size_t)5 * 1024 * 1024 * 4;

struct Params {
  const float* in[31];
  float* out;
  char* ws;
  int ph_lo, ph_hi;
};
enum { I_XP = 0, I_XS, I_MEM, I_SH, I_SR, I_SS, I_CK, I_CV, I_NG, I_WIN, I_WOUT, I_MNG, I_WMEM, I_LB, I_ONG, I_MU, I_W0, I_W1, I_W2,
       I_A0, I_A1, I_A2, I_V0, I_V1, I_V2, I_KK, I_KA, I_RK, I_LG, I_LBI, I_FG };

__device__ __forceinline__ unsigned cvt_pk(float lo, float hi) { unsigned r; asm("v_cvt_pk_bf16_f32 %0, %1, %2" : "=v"(r) : "v"(lo), "v"(hi)); return r; }
__device__ __forceinline__ bfr f2bf(float f) { return (bfr)(cvt_pk(f, 0.f) & 0xffff); }
__device__ __forceinline__ float bf2f(unsigned h) { return __uint_as_float(h << 16); }
__device__ __forceinline__ float bflo(unsigned w) { return __uint_as_float(w << 16); }
__device__ __forceinline__ float bfhi(unsigned w) { return __uint_as_float(w & 0xffff0000u); }
__device__ __forceinline__ float frcp(float x) { return __builtin_amdgcn_rcpf(x); }
__device__ __forceinline__ float sigmoidf_(float x) { return frcp(1.f + __expf(-x)); }
template <int CTRL> __device__ __forceinline__ float dppf(float x) {
  return __builtin_bit_cast(float, __builtin_amdgcn_update_dpp(0, __builtin_bit_cast(int, x), CTRL, 0xf, 0xf, true));
}
__device__ __forceinline__ float wave_sum(float v) {
  v += dppf<0xB1>(v); v += dppf<0x4E>(v); v += dppf<0x141>(v); v += dppf<0x140>(v);
  const int iv = __builtin_bit_cast(int, v);
  float r = __builtin_bit_cast(float, __builtin_amdgcn_readlane(iv, 0));
  r += __builtin_bit_cast(float, __builtin_amdgcn_readlane(iv, 16));
  r += __builtin_bit_cast(float, __builtin_amdgcn_readlane(iv, 32));
  r += __builtin_bit_cast(float, __builtin_amdgcn_readlane(iv, 48));
  return r;
}
__device__ __forceinline__ float bperm(float v, int srclane) { return __builtin_bit_cast(float, __builtin_amdgcn_ds_bpermute(srclane << 2, __builtin_bit_cast(int, v))); }
__device__ __forceinline__ float sum8(float v) {
  v += dppf<0xB1>(v);
  v += dppf<0x4E>(v);
  v += dppf<0x141>(v);
  return v;
}
__device__ __forceinline__ const float* pin(const Params& p, int i) { asm volatile("" : "+s"(i)); return p.in[i]; }
__device__ __forceinline__ const float* xin_row(const Params& p, int g) {
  return g < NPR ? pin(p, I_XP) + (size_t)g * DM : pin(p, I_XS) + (size_t)(g - NPR) * DM;
}

__device__ __forceinline__ int tidx() { int t = threadIdx.x; asm volatile("" : "+v"(t)); return t; }
__device__ __forceinline__ int bidx() { int b = blockIdx.x; asm volatile("" : "+s"(b)); return b; }
__device__ __forceinline__ int wperm(int n) { const int c = n & 31; return (n & ~31) + ((c >> 2) & 1) * 16 + (c >> 3) * 4 + (c & 3); }

__device__ __forceinline__ void transpose_job(const float* __restrict__ src, int Ks, int Ns, bfr* __restrict__ dst, int ldd, int rot) {
  extern __shared__ __attribute__((aligned(16))) char smem[];
  bfr* T = (bfr*)smem;
  const int tid = tidx();
  const int tn = Ns >> 6, ntile = (Ks >> 6) * tn;
  const int G = gridDim.x;
  for (int tile = (bidx() + rot) % G; tile < ntile; tile += G) {
    const int k0 = (tile / tn) << 6, n0 = (tile % tn) << 6;
    const int kl = tid >> 3, nc = (tid & 7) << 3;
    const float* s = src + (size_t)(k0 + kl) * Ns + n0 + nc;
    const float4 a = *(const float4*)s, b = *(const float4*)(s + 4);
    __syncthreads();
    T[(nc + 0) * 72 + kl] = f2bf(a.x); T[(nc + 1) * 72 + kl] = f2bf(a.y); T[(nc + 2) * 72 + kl] = f2bf(a.z); T[(nc + 3) * 72 + kl] = f2bf(a.w);
    T[(nc + 4) * 72 + kl] = f2bf(b.x); T[(nc + 5) * 72 + kl] = f2bf(b.y); T[(nc + 6) * 72 + kl] = f2bf(b.z); T[(nc + 7) * 72 + kl] = f2bf(b.w);
    __syncthreads();
    const int nl = tid >> 3, kc = (tid & 7) << 3;
    const u32x4 v = *(const u32x4*)(T + nl * 72 + kc);
    *(u32x4*)(dst + (size_t)wperm(n0 + nl) * ldd + k0 + kc) = v;
  }
}

__device__ __forceinline__ void prologue(const Params& p) {
  const int tid = tidx(), wid = tid >> 6, lane = tid & 63;
  const int G = gridDim.x;
  char* ws = p.ws;
  int rot = 0;
  for (int l = 0; l < 4; ++l) {
    transpose_job(pin(p, I_WIN) + (size_t)l * DM * INC, DM, INC, (bfr*)(ws + WS_WTIN) + l * WTIN_L, DM, rot); rot = (rot + G - (1280 % G)) % G;
    transpose_job(pin(p, I_WOUT) + (size_t)l * BRW * DM, BRW, DM, (bfr*)(ws + WS_WTOUT) + (size_t)l * DM * BRW, BRW, rot); rot = (rot + G - (384 % G)) % G;
    transpose_job(pin(p, I_WMEM) + (size_t)l * DM * DM, DM, DM, (bfr*)(ws + WS_WTMEM) + (size_t)l * DM * DM, DM, rot); rot = (rot + G - (256 % G)) % G;
  }
  const int gt = bidx() * 512 + tid, nth = G * 512;
  for (int j = 0; j < 2; ++j) {
    bfr* dst = (bfr*)(ws + WS_WTIN) + (size_t)(2 * j + 1) * WTIN_L + (size_t)5120 * 1024;
    const float* w1 = pin(p, I_W1) + (size_t)j * 1024 * 64;
    const float* a1 = pin(p, I_A1) + (size_t)j * 1024 * 64;
    const float* v1 = pin(p, I_V1);
    for (int it = gt; it < 768 * 128; it += nth) {
      const int n = it % 768, kc = it / 768;
      const int seg = n >> 8, c = n & 255;
      float v[8];
#pragma unroll
      for (int e = 0; e < 8; ++e) {
        const int k = kc * 8 + e;
        float x = 0.f;
        if (seg == 0) { if (c < 64) x = w1[k * 64 + c]; }
        else if (seg == 1) { if (c < 64) x = a1[k * 64 + c]; }
        else { if (j == 1 && c < 32) x = v1[k * 32 + c]; }
        v[e] = x;
      }
      u32x4 o; o.x = cvt_pk(v[0], v[1]); o.y = cvt_pk(v[2], v[3]); o.z = cvt_pk(v[4], v[5]); o.w = cvt_pk(v[6], v[7]);
      *(u32x4*)(dst + (size_t)wperm(n) * 1024 + kc * 8) = o;
    }
    bfr* d2 = (bfr*)(ws + WS_W2T) + (size_t)j * 3072 * 256;
    const float* w2 = pin(p, I_W2) + (size_t)j * 64 * 1024;
    const float* a2 = pin(p, I_A2) + (size_t)j * 64 * 1024;
    const float* v2 = pin(p, I_V2);
    for (int it = gt; it < 3072 * 32; it += nth) {
      const int n = it % 3072, kc = it / 3072;
      const int seg = n >> 10, c = n & 1023;
      float v[8];
#pragma unroll
      for (int e = 0; e < 8; ++e) {
        const int k = kc * 8 + e;
        float x = 0.f;
        if (seg == 0) { if (k < 64) x = w2[k * 1024 + c]; }
        else if (seg == 1) { if (k >= 64 && k < 128) x = a2[(k - 64) * 1024 + c]; }
        else { if (j == 1 && k >= 128 && k < 160) x = v2[(k - 128) * 1024 + c]; }
        v[e] = x;
      }
      u32x4 o; o.x = cvt_pk(v[0], v[1]); o.y = cvt_pk(v[2], v[3]); o.z = cvt_pk(v[4], v[5]); o.w = cvt_pk(v[6], v[7]);
      *(u32x4*)(d2 + (size_t)wperm(n) * 256 + kc * 8) = o;
    }
  }
  const int gw = bidx() * 8 + wid, nw = G * 8;
  for (int row = gw; row < 2048 + NTOK; row += nw) {
    const bool ismem = row < 2048;
    const float* src = ismem ? pin(p, I_MEM) + (size_t)row * DM : xin_row(p, row - 2048);
    float4 x[4]; float ss = 0.f;
#pragma unroll
    for (int i = 0; i < 4; ++i) { x[i] = *(const float4*)(src + lane * 4 + i * 256); ss += x[i].x * x[i].x + x[i].y * x[i].y + x[i].z * x[i].z + x[i].w * x[i].w; }
    ss = wave_sum(ss);
    const float rs = rsqrtf(ss * (1.f / 1024.f) + 1e-6f);
    if (ismem) {
      for (int l = 0; l < 4; ++l) {
        bfr* dst = (bfr*)(ws + WS_MEMN) + ((size_t)l * 2048 + row) * DM;
#pragma unroll
        for (int i = 0; i < 4; ++i) {
          const float4 g = *(const float4*)(pin(p, I_MNG) + l * DM + lane * 4 + i * 256);
          u32x2 o; o.x = cvt_pk(x[i].x * rs * g.x, x[i].y * rs * g.y); o.y = cvt_pk(x[i].z * rs * g.z, x[i].w * rs * g.w);
          *(u32x2*)(dst + lane * 4 + i * 256) = o;
        }
      }
    } else {
      float* xr = (float*)(ws + WS_XRES) + (size_t)(row - 2048) * DM;
#pragma unroll
      for (int i = 0; i < 4; ++i) *(float4*)(xr + lane * 4 + i * 256) = x[i];
      bfr* dst = (bfr*)(ws + WS_HA) + (size_t)(row - 2048) * DM;
#pragma unroll
      for (int i = 0; i < 4; ++i) {
        const float4 g = *(const float4*)(pin(p, I_NG) + lane * 4 + i * 256);
        u32x2 o; o.x = cvt_pk(x[i].x * rs * g.x, x[i].y * rs * g.y); o.y = cvt_pk(x[i].z * rs * g.z, x[i].w * rs * g.w);
        *(u32x2*)(dst + lane * 4 + i * 256) = o;
      }
    }
  }
}

__device__ __forceinline__ void load_xrow(const Params& p, const int g, const int lane, float4 (&x)[4]) {
  const float* s = (const float*)(p.ws + WS_XRES) + (size_t)g * DM;
#pragma unroll
  for (int i = 0; i < 4; ++i) x[i] = *(const float4*)(s + lane * 4 + i * 256);
  if (g >= NPR) {
#pragma unroll
    for (int k = 0; k < 5; ++k) {
      const float* q = (const float*)(p.ws + WS_PART) + ((size_t)k * 1024 + (g - NPR)) * DM;
#pragma unroll
      for (int i = 0; i < 4; ++i) { const float4 t = *(const float4*)(q + lane * 4 + i * 256); x[i].x += t.x; x[i].y += t.y; x[i].z += t.z; x[i].w += t.w; }
    }
  }
}
__device__ __forceinline__ void prep_phase(const Params& p, int l) {
  const int tid = tidx(), wid = tid >> 6, lane = tid & 63;
  const bool rw = (l & 1);
  const int j = l >> 1;
  const float* xres = (const float*)(p.ws + WS_XRES);
  bfr* hA = (bfr*)(p.ws + WS_HA);
  const float* ng = pin(p, I_NG) + l * DM;
  const float* mu = pin(p, I_MU) + (size_t)j * 5 * DM;
  const int gw = bidx() * 8 + wid, nw = gridDim.x * 8;
  for (int task = gw; task < NPR / 4 + 128; task += nw) {
    const int g0 = task < NPR / 4 ? task * 4 : NPR + (task - NPR / 4) * 8;
    const int nrows = task < NPR / 4 ? 4 : 8;
    float hp[16];
    if (rw) {
      const bool smp = g0 >= NPR;
      const int t0 = smp ? ((g0 - NPR) & 7) : (g0 & 2047);
      if (t0 == 0) {
        if (smp) {
          const float* s = pin(p, I_SS) + ((size_t)j * 128 + ((g0 - NPR) >> 3)) * DM;
#pragma unroll
          for (int i = 0; i < 4; ++i) { const float4 v = *(const float4*)(s + lane * 4 + i * 256); hp[i * 4] = v.x; hp[i * 4 + 1] = v.y; hp[i * 4 + 2] = v.z; hp[i * 4 + 3] = v.w; }
        } else {
#pragma unroll
          for (int i = 0; i < 16; ++i) hp[i] = 0.f;
        }
      } else {
        float4 x[4]; float ss = 0.f;
        load_xrow(p, g0 - 1, lane, x);
#pragma unroll
        for (int i = 0; i < 4; ++i) ss += x[i].x * x[i].x + x[i].y * x[i].y + x[i].z * x[i].z + x[i].w * x[i].w;
        ss = wave_sum(ss);
        const float rs = rsqrtf(ss * (1.f / 1024.f) + 1e-6f);
#pragma unroll
        for (int i = 0; i < 4; ++i) {
          const float4 g = *(const float4*)(ng + lane * 4 + i * 256);
          hp[i * 4] = x[i].x * rs * g.x; hp[i * 4 + 1] = x[i].y * rs * g.y; hp[i * 4 + 2] = x[i].z * rs * g.z; hp[i * 4 + 3] = x[i].w * rs * g.w;
        }
      }
    }
    for (int r = 0; r < nrows; ++r) {
      const int g = g0 + r;
      float4 x[4]; float ss = 0.f;
      load_xrow(p, g, lane, x);
      if (g >= NPR) {
        float* xw = (float*)(p.ws + WS_XRES) + (size_t)g * DM;
#pragma unroll
        for (int i = 0; i < 4; ++i) *(float4*)(xw + lane * 4 + i * 256) = x[i];
      }
#pragma unroll
      for (int i = 0; i < 4; ++i) ss += x[i].x * x[i].x + x[i].y * x[i].y + x[i].z * x[i].z + x[i].w * x[i].w;
      ss = wave_sum(ss);
      const float rs = rsqrtf(ss * (1.f / 1024.f) + 1e-6f);
      float h[16];
#pragma unroll
      for (int i = 0; i < 4; ++i) {
        const float4 gg = *(const float4*)(ng + lane * 4 + i * 256);
        h[i * 4] = x[i].x * rs * gg.x; h[i * 4 + 1] = x[i].y * rs * gg.y; h[i * 4 + 2] = x[i].z * rs * gg.z; h[i * 4 + 3] = x[i].w * rs * gg.w;
        u32x2 o; o.x = cvt_pk(h[i * 4], h[i * 4 + 1]); o.y = cvt_pk(h[i * 4 + 2], h[i * 4 + 3]);
        *(u32x2*)(hA + (size_t)g * DM + lane * 4 + i * 256) = o;
      }
      if (rw) {
#pragma unroll
        for (int m = 0; m < 5; ++m) {
          bfr* dst = hA + (size_t)(1 + m) * HA_SZ + (size_t)g * DM;
#pragma unroll
          for (int i = 0; i < 4; ++i) {
            const float4 mm = *(const float4*)(mu + m * DM + lane * 4 + i * 256);
            const float a0 = h[i * 4] + (hp[i * 4] - h[i * 4]) * mm.x, a1 = h[i * 4 + 1] + (hp[i * 4 + 1] - h[i * 4 + 1]) * mm.y;
            const float a2 = h[i * 4 + 2] + (hp[i * 4 + 2] - h[i * 4 + 2]) * mm.z, a3 = h[i * 4 + 3] + (hp[i * 4 + 3] - h[i * 4 + 3]) * mm.w;
            u32x2 o; o.x = cvt_pk(a0, a1); o.y = cvt_pk(a2, a3);
            *(u32x2*)(dst + lane * 4 + i * 256) = o;
          }
        }
        const bool smp = g >= NPR;
        const int t = smp ? ((g - NPR) & 7) : (g & 2047);
        if (t == (smp ? 7 : 2047)) {
          float* o = p.out + (smp ? O_SSS + ((size_t)j * 128 + ((g - NPR) >> 3)) * DM : O_SSP + ((size_t)j * 8 + (g >> 11)) * DM);
#pragma unroll
          for (int i = 0; i < 4; ++i) *(float4*)(o + lane * 4 + i * 256) = make_float4(h[i * 4], h[i * 4 + 1], h[i * 4 + 2], h[i * 4 + 3]);
        }
#pragma unroll
        for (int i = 0; i < 16; ++i) hp[i] = h[i];
      }
    }
  }
}

__device__ __forceinline__ void final_phase(const Params& p) {
  const int tid = tidx(), wid = tid >> 6, lane = tid & 63;
  const float* xres = (const float*)(p.ws + WS_XRES);
  const float* fg = pin(p, I_FG);
  const int gw = bidx() * 8 + wid, nw = gridDim.x * 8;
  for (int g = gw; g < NTOK; g += nw) {
    float4 x[4]; float ss = 0.f;
    load_xrow(p, g, lane, x);
#pragma unroll
    for (int i = 0; i < 4; ++i) ss += x[i].x * x[i].x + x[i].y * x[i].y + x[i].z * x[i].z + x[i].w * x[i].w;
    ss = wave_sum(ss);
    const float rs = rsqrtf(ss * (1.f / 1024.f) + 1e-6f);
    float* o = p.out + O_YP + (size_t)g * DM;
#pragma unroll
    for (int i = 0; i < 4; ++i) {
      const float4 gg = *(const float4*)(fg + lane * 4 + i * 256);
      *(float4*)(o + lane * 4 + i * 256) = make_float4(x[i].x * rs * gg.x, x[i].y * rs * gg.y, x[i].z * rs * gg.z, x[i].w * rs * gg.w);
    }
  }
}

constexpr int BM = 256, BK = 64, HALF = 128, HT = HALF * BK;
__device__ __forceinline__ int lds_byte(int r, int c) {
  int st = (r >> 4) * 2 + (c >> 5), rr = r & 15, cc = c & 31, ob = rr * 64 + cc * 2;
  return st * 1024 + (ob ^ (((ob >> 9) & 1) << 5));
}
__device__ __forceinline__ void stage_rc(int b, int& R, int& C) {
  int st = b / 1024, sb = b % 1024, swz = sb ^ (((sb >> 9) & 1) << 5);
  R = (st >> 1) * 16 + swz / 64; C = (st & 1) * 32 + (swz % 64) / 2;
}

enum { EM_PROJ = 0, EM_G1R, EM_MEM, EM_LUP, EM_OUT, EM_OUTA };

__device__ __forceinline__ void epilogue(const Params& p, const int mode, const int l, const f32x4 (&acc)[2][2][4][2],
                                         const int pm, const int pn, const int wr, const int wc, const int fr, const int fq) {
  const int j = (l & 255) >> 1;
#pragma unroll
  for (int ai = 0; ai < 2; ++ai)
#pragma unroll
    for (int m = 0; m < 4; ++m) {
      const int row = pm * BM + ai * HALF + wr * 64 + m * 16 + fr;
#pragma unroll
      for (int bj = 0; bj < 2; ++bj)
#pragma unroll
        for (int n = 0; n < 2; ++n) {
          const int col = pn * BM + bj * HALF + wc * 32 + fq * 8 + n * 4;
          const f32x4 v = acc[ai][bj][m][n];
          if (mode == EM_PROJ || (mode == EM_G1R && pn < 20)) {
            if (n == 0) {
              const f32x4 v1 = acc[ai][bj][m][1];
              u32x4 o; o.x = cvt_pk(v[0], v[1]); o.y = cvt_pk(v[2], v[3]); o.z = cvt_pk(v1[0], v1[1]); o.w = cvt_pk(v1[2], v1[3]);
              *(u32x4*)((bfr*)(p.ws + WS_PROJ) + (size_t)row * INC + col) = o;
            }
          } else if (mode == EM_G1R) {
            bfr* al = (bfr*)(p.ws + WS_ALORA) + (size_t)row * 256;
            const int c = col & 255;
            if (pn == 20) {
              if (c < 64) {
                float t[4];
#pragma unroll
                for (int e = 0; e < 4; ++e) { const float ex = __expf(2.f * v[e]); t[e] = 1.f - 2.f * frcp(ex + 1.f); }
                u32x2 o; o.x = cvt_pk(t[0], t[1]); o.y = cvt_pk(t[2], t[3]);
                *(u32x2*)(al + c) = o;
              }
            } else if (pn == 21) {
              const int lim = (l == 3) ? 128 : 256;
              if (64 + c < lim) {
                u32x2 o; o.x = 0u; o.y = 0u;
                if (c < 64) { o.x = cvt_pk(v[0], v[1]); o.y = cvt_pk(v[2], v[3]); }
                *(u32x2*)(al + 64 + c) = o;
              }
            } else {
              if (128 + c < 256) {
                u32x2 o; o.x = 0u; o.y = 0u;
                if (c < 32) { o.x = cvt_pk(v[0], v[1]); o.y = cvt_pk(v[2], v[3]); }
                *(u32x2*)(al + 128 + c) = o;
              }
            }
          } else if (mode == EM_MEM) {
            const int lm = pm >> 3, r2 = row & 2047;
            float* o = p.out + (col < 512 ? O_MK : O_MV) + ((size_t)lm * 2048 + r2) * 512 + (col & 511);
            *(f32x4*)o = v;
          } else if (mode == EM_LUP) {
            const int seg = col >> 10, c = col & 1023;
            float t[4];
            if (seg == 0) {
              const float4 b = *(const float4*)(pin(p, I_W0) + j * DM + c);
              const float bb[4] = {b.x, b.y, b.z, b.w};
#pragma unroll
              for (int e = 0; e < 4; ++e) {
                const float x = bb[e] + v[e];
                t[e] = -0.6065306597126334f * sigmoidf_(x);
              }
            } else if (seg == 1) {
              const float4 b = *(const float4*)(pin(p, I_A0) + j * DM + c);
              t[0] = sigmoidf_(b.x + v[0]); t[1] = sigmoidf_(b.y + v[1]); t[2] = sigmoidf_(b.z + v[2]); t[3] = sigmoidf_(b.w + v[3]);
            } else {
              const float4 b = *(const float4*)(pin(p, I_V0) + c);
              t[0] = sigmoidf_(b.x + v[0]); t[1] = sigmoidf_(b.y + v[1]); t[2] = sigmoidf_(b.z + v[2]); t[3] = sigmoidf_(b.w + v[3]);
            }
            u32x2 o; o.x = cvt_pk(t[0], t[1]); o.y = cvt_pk(t[2], t[3]);
            *(u32x2*)((bfr*)(p.ws + WS_LUP) + (size_t)row * 3072 + col) = o;
          } else if (mode == EM_OUT) {
            float* xo = (float*)(p.ws + WS_XRES) + (size_t)row * DM + col;
            const f32x4 x = *(const f32x4*)xo;
            *(f32x4*)xo = x + v;
          } else {
            *(f32x4*)((float*)(p.ws + WS_PART) + ((size_t)((l >> 8) - 1) * 1024 + (row - NPR)) * DM + col) = v;
          }
        }
    }
}

__device__ __forceinline__ void gemm_unit(const Params& p, const bfr* __restrict__ A, const bfr* __restrict__ Bt, const int K, const int kt0, const int nt,
                                          const int pm, const int pn, const int mode, const int l) {
  extern __shared__ __attribute__((aligned(16))) char smem[];
  bfr* shm = (bfr*)smem;
#define SA(b, h) (shm + ((b) * 2 + (h)) * HT)
#define SB(b, h) (shm + (4 + (b) * 2 + (h)) * HT)
#define STAGE(P, BASE, br, kt) do { const bfr* _g = (BASE) + (size_t)(br) * K + (kt0 + (kt)) * BK + goff; \
    __builtin_amdgcn_global_load_lds((const unsigned*)_g, (unsigned*)((char*)(P) + tid * 16), 16, 0, 0); \
    __builtin_amdgcn_global_load_lds((const unsigned*)(_g + (size_t)64 * K), (unsigned*)((char*)(P) + tid * 16 + 8192), 16, 0, 0); } while (0)
#define LDA(dst, b, h) for (int m = 0; m < 4; ++m) for (int k = 0; k < 2; ++k) \
    dst[m][k] = *reinterpret_cast<const bf16x8*>((char*)SA(b, h) + lds_byte(wr * 64 + m * 16 + fr, k * 32 + fq * 8))
#define LDB(dst, b, h) for (int n = 0; n < 2; ++n) for (int k = 0; k < 2; ++k) \
    dst[n][k] = *reinterpret_cast<const bf16x8*>((char*)SB(b, h) + lds_byte(wc * 32 + n * 16 + fr, k * 32 + fq * 8))
#define MMA(ai, bj, At, Bt_) do { __builtin_amdgcn_s_setprio(1); \
    for (int m = 0; m < 4; ++m) for (int n = 0; n < 2; ++n) for (int k = 0; k < 2; ++k) \
      acc[ai][bj][m][n] = __builtin_amdgcn_mfma_f32_16x16x32_bf16(Bt_[n][k], At[m][k], acc[ai][bj][m][n], 0, 0, 0); \
    __builtin_amdgcn_s_setprio(0); } while (0)
#define WAIT_V(n) asm volatile("s_waitcnt vmcnt(" #n ")" ::: "memory")
#define WAIT_L(n) asm volatile("s_waitcnt lgkmcnt(" #n ")" ::: "memory")
#define BAR __builtin_amdgcn_s_barrier()
#define SCHED __builtin_amdgcn_sched_barrier(0)
  const int tid = tidx();
  const int brow = pm * BM, bcol = pn * BM;
  const int wid = tid >> 6, lane = tid & 63, wr = wid >> 2, wc = wid & 3, fr = lane & 15, fq = lane >> 4;
  int R0, C0; stage_rc(tid * 16, R0, C0);
  const int goff = R0 * K + C0;
  f32x4 acc[2][2][4][2] = {};
  bf16x8 At[4][2], B0[2][2], B1[2][2];
  STAGE(SB(0, 0), Bt, bcol, 0); STAGE(SA(0, 0), A, brow, 0);
  STAGE(SB(0, 1), Bt, bcol + HALF, 0); STAGE(SA(0, 1), A, brow + HALF, 0);
  if (wr == 1) BAR;
  WAIT_V(4); BAR;
  STAGE(SB(1, 0), Bt, bcol, 1); STAGE(SA(1, 0), A, brow, 1); STAGE(SB(1, 1), Bt, bcol + HALF, 1);
  WAIT_V(6); BAR;
  for (int t = 0; t < nt - 2; t += 2) {
    LDB(B0, 0, 0); SCHED; LDA(At, 0, 0); STAGE(SA(1, 1), A, brow + HALF, t + 1);
    WAIT_L(8); BAR; WAIT_L(0); MMA(0, 0, At, B0); BAR; SCHED;
    LDB(B1, 0, 1); STAGE(SB(0, 0), Bt, bcol, t + 2);
    BAR; WAIT_L(0); MMA(0, 1, At, B1); BAR;
    LDA(At, 0, 1); STAGE(SA(0, 0), A, brow, t + 2);
    BAR; WAIT_L(0); MMA(1, 0, At, B0); BAR; SCHED;
    STAGE(SB(0, 1), Bt, bcol + HALF, t + 2);
    WAIT_V(6); BAR; MMA(1, 1, At, B1); BAR;
    LDB(B0, 1, 0); SCHED; LDA(At, 1, 0); STAGE(SA(0, 1), A, brow + HALF, t + 2);
    WAIT_L(8); BAR; WAIT_L(0); MMA(0, 0, At, B0); BAR; SCHED;
    LDB(B1, 1, 1); STAGE(SB(1, 0), Bt, bcol, t + 3);
    BAR; WAIT_L(0); MMA(0, 1, At, B1); BAR;
    LDA(At, 1, 1); STAGE(SA(1, 0), A, brow, t + 3);
    BAR; WAIT_L(0); MMA(1, 0, At, B0); BAR; SCHED;
    STAGE(SB(1, 1), Bt, bcol + HALF, t + 3);
    WAIT_V(6); BAR; MMA(1, 1, At, B1); BAR;
  }
  { LDB(B0, 0, 0); LDA(At, 0, 0); STAGE(SA(1, 1), A, brow + HALF, nt - 1);
    BAR; WAIT_L(0); MMA(0, 0, At, B0); BAR;
    LDB(B1, 0, 1); BAR; WAIT_L(0); MMA(0, 1, At, B1); BAR;
    LDA(At, 0, 1); WAIT_V(4); BAR; WAIT_L(0); MMA(1, 0, At, B0); MMA(1, 1, At, B1); BAR; }
  { LDB(B0, 1, 0); LDA(At, 1, 0); WAIT_V(2); BAR; WAIT_L(0); MMA(0, 0, At, B0); BAR;
    LDB(B1, 1, 1); WAIT_V(0); BAR; WAIT_L(0); MMA(0, 1, At, B1); BAR;
    LDA(At, 1, 1); BAR; WAIT_L(0); MMA(1, 0, At, B0); MMA(1, 1, At, B1); BAR; }
  if (wr == 0) BAR;
  epilogue(p, mode, l, acc, pm, pn, wr, wc, fr, fq);
  WAIT_V(0);
#undef SA
#undef SB
}

__device__ __forceinline__ bool unit_order(int i, int c, int G, int nM, int nN, int& pm, int& pn) {
  const int nwg = nM * nN;
  const long L = (long)i * G + c; if (L >= nwg) return false;
  int wgid = (int)L; { const int q = nwg / 8, r = nwg % 8, xcd = wgid % 8, off = wgid / 8; wgid = (xcd < r ? xcd * (q + 1) : r * (q + 1) + (xcd - r) * q) + off; }
  const int nig = 8 * nN, gid = wgid / nig, fm = gid * 8, gsz = (nM - fm) < 8 ? (nM - fm) : 8;
  pm = fm + ((wgid % nig) % gsz); pn = (wgid % nig) / gsz; return true;
}

__device__ __forceinline__ void gemm_phase(const Params& p, const int kind, const int l) {
  const int G = gridDim.x;
  const int j = l >> 1;
  const bool rw = l & 1;
  char* ws = p.ws;
  const bfr* hA = (const bfr*)(ws + WS_HA);
  int nM = NTOK / BM, nN, K, mode;
  const bfr* Bt;
  if (kind == 0) { nN = rw ? (l == 3 ? 23 : 22) : 20; K = 1024; mode = rw ? EM_G1R : EM_PROJ; Bt = (const bfr*)(ws + WS_WTIN) + l * WTIN_L; }
  else if (kind == 1) { nN = (l == 3) ? 12 : 8; K = 256; mode = EM_LUP; Bt = (const bfr*)(ws + WS_W2T) + (size_t)j * 3072 * 256; }
  else { nN = 4; K = 1536; mode = EM_OUT; Bt = (const bfr*)(ws + WS_WTOUT) + (size_t)l * DM * BRW; }
  int pm, pn;
  const int nwg1 = nM * nN;
  const bool withmem = (kind == 0 && l == 0);
  const int c2 = (bidx() + G - (nwg1 % G)) % G;
  int seg = 0, i = 0;
  for (;;) {
    const bfr* A; const bfr* B = Bt; int KK = K, md = mode, kt0 = 0, nt = K / BK, lk = l;
    if (kind == 2) {
      const int t = bidx() + G * i;
      if (t >= 256 + 96) break;
      ++i;
      A = (const bfr*)(ws + WS_BRANCH);
      if (t < 256) { pm = (t & 7) * 8 + (t >> 5); pn = (t >> 3) & 3; }
      else { const int v = t - 256, rem = v % 24, ks = rem % 6; pm = 64 + v / 24; pn = rem / 6; kt0 = ks * 4; nt = 4; if (ks) { md = EM_OUTA; lk = l | (ks << 8); } }
    } else {
      bool ok;
      if (seg == 0) ok = unit_order(i, bidx(), G, nM, nN, pm, pn);
      else ok = unit_order(i, c2, G, 32, 4, pm, pn);
      if (!ok) { if (seg == 0 && withmem) { seg = 1; i = 0; continue; } break; }
      ++i;
      if (seg == 1) { A = (const bfr*)(ws + WS_MEMN); B = (const bfr*)(ws + WS_WTMEM) + (size_t)(pm >> 3) * DM * DM; KK = 1024; nt = 16; md = EM_MEM; }
      else if (kind == 0) {
        int sel = 0;
        if (rw) sel = pn < 4 ? 1 : pn < 8 ? 3 : pn < 12 ? 4 : pn < 20 ? 0 : pn == 20 ? 2 : pn == 21 ? 5 : 4;
        A = hA + (size_t)sel * HA_SZ;
      } else A = (const bfr*)(ws + WS_ALORA);
    }
    gemm_unit(p, A, B, KK, kt0, nt, pm, pn, md, lk);
  }
}

__device__ __forceinline__ void xattn_unit(const Params& p, const float* __restrict__ kb, const float* __restrict__ vb, const int g0, const int ntok, const int head) {
  extern __shared__ __attribute__((aligned(16))) char smem[];
  bfr* Ks = (bfr*)smem;
  bfr* Vt = Ks + 256 * 136;
  const int tid = tidx(), wid = tid >> 6, lane = tid & 63, fr = lane & 15, fq = lane >> 4;
#pragma unroll 4
  for (int i = 0; i < 16; ++i) {
    const int idx = tid + i * 512, row = idx >> 5, c4 = (idx & 31) << 2;
    const float4 v = *(const float4*)(kb + (size_t)row * 512 + c4);
    u32x2 o; o.x = cvt_pk(v.x, v.y); o.y = cvt_pk(v.z, v.w);
    *(u32x2*)(Ks + row * 136 + c4) = o;
  }
  {
    const int pp = lane & 7, dd = lane >> 3;
#pragma unroll 4
    for (int it = 0; it < 8; ++it) {
      const int wq = it * 8 + wid, mb = wq & 15, db = wq >> 4;
      const int m0 = mb * 16 + 2 * pp, d0 = db * 32 + dd * 4;
      const float4 a = *(const float4*)(vb + (size_t)m0 * 512 + d0);
      const float4 b = *(const float4*)(vb + (size_t)(m0 + 1) * 512 + d0);
      *(unsigned*)(Vt + (d0 + 0) * 260 + m0) = cvt_pk(a.x, b.x);
      *(unsigned*)(Vt + (d0 + 1) * 260 + m0) = cvt_pk(a.y, b.y);
      *(unsigned*)(Vt + (d0 + 2) * 260 + m0) = cvt_pk(a.z, b.z);
      *(unsigned*)(Vt + (d0 + 3) * 260 + m0) = cvt_pk(a.w, b.w);
    }
  }
  __syncthreads();
  if (wid * 16 < ntok) {
    const bfr* proj = (const bfr*)(p.ws + WS_PROJ);
    int tl = wid * 16 + fr; if (tl > ntok - 1) tl = ntok - 1;
    const bfr* qrow = proj + (size_t)(g0 + tl) * INC + 3072 + head * 128;
    bf16x8 qf[4];
#pragma unroll
    for (int ks = 0; ks < 4; ++ks) qf[ks] = *(const bf16x8*)(qrow + ks * 32 + fq * 8);
    f32x4 sc[16];
#pragma unroll
    for (int mt = 0; mt < 16; ++mt) {
      f32x4 a = {0.f, 0.f, 0.f, 0.f};
#pragma unroll
      for (int ks = 0; ks < 4; ++ks) {
        const bf16x8 kf = *(const bf16x8*)(Ks + (mt * 16 + fr) * 136 + ks * 32 + fq * 8);
        a = __builtin_amdgcn_mfma_f32_16x16x32_bf16(kf, qf[ks], a, 0, 0, 0);
      }
      sc[mt] = a;
    }
    float mx = -3.0e38f;
#pragma unroll
    for (int mt = 0; mt < 16; ++mt) mx = fmaxf(mx, fmaxf(fmaxf(sc[mt][0], sc[mt][1]), fmaxf(sc[mt][2], sc[mt][3])));
    mx = fmaxf(mx, bperm(mx, lane ^ 16)); mx = fmaxf(mx, bperm(mx, lane ^ 32));
    const float cs = 0.08838834764831845f * 1.4426950408889634f;
    float sum = 0.f;
#pragma unroll
    for (int mt = 0; mt < 16; ++mt)
#pragma unroll
      for (int e = 0; e < 4; ++e) { const float pe = exp2f((sc[mt][e] - mx) * cs); sc[mt][e] = pe; sum += pe; }
    sum += bperm(sum, lane ^ 16); sum += bperm(sum, lane ^ 32);
    const float inv = frcp(sum);
    bf16x8 pf[8];
#pragma unroll
    for (int u = 0; u < 8; ++u) {
      u32x4 w; w.x = cvt_pk(sc[2 * u][0], sc[2 * u][1]); w.y = cvt_pk(sc[2 * u][2], sc[2 * u][3]);
      w.z = cvt_pk(sc[2 * u + 1][0], sc[2 * u + 1][1]); w.w = cvt_pk(sc[2 * u + 1][2], sc[2 * u + 1][3]);
      pf[u] = __builtin_bit_cast(bf16x8, w);
    }
    const bool tvalid = (wid * 16 + fr) < ntok;
    const int g = g0 + tl;
    const bfr* gate = proj + (size_t)g * INC + 3584 + 1024 + head * 128;
    bfr* br = (bfr*)(p.ws + WS_BRANCH) + (size_t)g * BRW + 1024 + head * 128;
#pragma unroll
    for (int dt = 0; dt < 8; ++dt) {
      f32x4 a = {0.f, 0.f, 0.f, 0.f};
#pragma unroll
      for (int u = 0; u < 8; ++u) {
        const bfr* vr = Vt + (dt * 16 + fr) * 260 + fq * 4;
        u32x4 w;
        const u32x2 lo = *(const u32x2*)(vr + (2 * u) * 16), hi = *(const u32x2*)(vr + (2 * u + 1) * 16);
        w.x = lo.x; w.y = lo.y; w.z = hi.x; w.w = hi.y;
        a = __builtin_amdgcn_mfma_f32_16x16x32_bf16(__builtin_bit_cast(bf16x8, w), pf[u], a, 0, 0, 0);
      }
      if (tvalid) {
        const u32x2 gw = *(const u32x2*)(gate + dt * 16 + fq * 4);
        const float g0f = bflo(gw.x), g1f = bfhi(gw.x), g2f = bflo(gw.y), g3f = bfhi(gw.y);
        u32x2 o;
        o.x = cvt_pk(a[0] * inv * g0f * sigmoidf_(g0f), a[1] * inv * g1f * sigmoidf_(g1f));
        o.y = cvt_pk(a[2] * inv * g2f * sigmoidf_(g2f), a[3] * inv * g3f * sigmoidf_(g3f));
        *(u32x2*)(br + dt * 16 + fq * 4) = o;
      }
    }
  }
  __syncthreads();
}

struct HgRaw { u32x2 q, f, v, g; };
__device__ __forceinline__ void hg_load(HgRaw& r, const bfr* __restrict__ proj, const int g0, const int T, const int sbi, const int h,
                                        const int wid, const int fr, const int fq, const int tid) {
  const int t0 = sbi * 16;
  if (t0 + fr < T) {
    const bfr* pr = proj + (size_t)(g0 + t0 + fr) * INC + h * 128 + wid * 16 + fq * 4;
    r.q = *(const u32x2*)pr; r.f = *(const u32x2*)(pr + 1024); r.g = *(const u32x2*)(pr + 3584);
  }
  const int vt = tid >> 5, dv4 = (tid & 31) << 2;
  if (t0 + vt < T) r.v = *(const u32x2*)(proj + (size_t)(g0 + t0 + vt) * INC + 2048 + h * 128 + dv4);
}
constexpr int KTS = 18;
constexpr int HG_SET = 16 * 136 * 2 + 128 * KTS * 2;

__device__ __forceinline__ void hgrn_unit(const Params& p, const int l, const bool smp, const int b, const int h) {
  extern __shared__ __attribute__((aligned(16))) char smem[];
  bfr* lds0 = (bfr*)smem;
  float* decb = (float*)(lds0 + 2 * HG_SET);
  float* redb = decb + 256;
  const int tid = tidx(), wid = tid >> 6, lane = tid & 63, fr = lane & 15, fq = lane >> 4;
  const int j = l >> 1;
  const bfr* proj = (const bfr*)(p.ws + WS_PROJ);
  bfr* branch = (bfr*)(p.ws + WS_BRANCH);
  const int g0 = smp ? NPR + b * 8 : b * 2048;
  const int T = smp ? 8 : 2048;
  const int nsub = (T + 15) >> 4;
  f32x4 S[8];
  if (smp) {
    const float* s0 = pin(p, I_SH) + (((size_t)j * 128 + b) * 8 + h) * 16384;
#pragma unroll
    for (int kt = 0; kt < 8; ++kt)
#pragma unroll
      for (int e = 0; e < 4; ++e) S[kt][e] = s0[(kt * 16 + fq * 4 + e) * 128 + wid * 16 + fr];
  } else {
#pragma unroll
    for (int kt = 0; kt < 8; ++kt) S[kt] = (f32x4){0.f, 0.f, 0.f, 0.f};
  }
  const int dkp = wid * 16 + fq * 4;
  float lb[4];
#pragma unroll
  for (int e = 0; e < 4; ++e) {
    if (j == 0) lb[e] = 0.f;
    else { const int c = h * 128 + dkp + e; lb[e] = sigmoidf_(pin(p, I_LB)[1024 + c] - pin(p, I_LB)[c]); }
  }
  float og[4];
#pragma unroll
  for (int e = 0; e < 4; ++e) og[e] = pin(p, I_ONG)[j * 128 + wid * 16 + fq * 4 + e];

  HgRaw raw[4];
#pragma unroll
  for (int u = 0; u < 4; ++u) { raw[u].q = raw[u].f = raw[u].v = raw[u].g = (u32x2){0u, 0u}; hg_load(raw[u], proj, g0, T, u, h, wid, fr, fq, tid); }
  u32x2 gsave[2] = {(u32x2){0u, 0u}, (u32x2){0u, 0u}};
  f32x4 oprev = {0.f, 0.f, 0.f, 0.f};

  for (int i4 = 0; i4 < nsub; i4 += 4) {
#pragma unroll
    for (int u = 0; u < 4; ++u) {
      const int i = i4 + u;
      if (i < nsub) {
        const int s = u & 1;
        bfr* Qs = lds0 + s * HG_SET; bfr* Kh = Qs + 16 * 136; bfr* Kt = Kh + 16 * 136; bfr* Vt = Kt + 128 * KTS;
        float* dec = decb + s * 128; float* red = redb + s * 128;
        {
          const int sb = i * 16;
          const bool valid = (sb + fr) < T;
          float q[4], P[4], kv[4];
          const float qz[4] = {bflo(raw[u].q.x), bfhi(raw[u].q.x), bflo(raw[u].q.y), bfhi(raw[u].q.y)};
          const float fz[4] = {bflo(raw[u].f.x), bfhi(raw[u].f.x), bflo(raw[u].f.y), bfhi(raw[u].f.y)};
#pragma unroll
          for (int e = 0; e < 4; ++e) {
            const float sg = sigmoidf_(fz[e]);
            const float f = fmaxf(lb[e] + (1.f - lb[e]) * sg, 1e-30f);
            P[e] = valid ? f : 1.f;
            kv[e] = valid ? (1.f - lb[e]) * (1.f - sg) : 0.f;
            q[e] = valid ? qz[e] * sigmoidf_(qz[e]) : 0.f;
          }
#pragma unroll
          for (int e = 0; e < 4; ++e) {
            P[e] *= __builtin_bit_cast(float, __builtin_amdgcn_update_dpp(0x3f800000, __builtin_bit_cast(int, P[e]), 0x111, 0xf, 0xf, false));
            P[e] *= __builtin_bit_cast(float, __builtin_amdgcn_update_dpp(0x3f800000, __builtin_bit_cast(int, P[e]), 0x112, 0xf, 0xf, false));
            P[e] *= __builtin_bit_cast(float, __builtin_amdgcn_update_dpp(0x3f800000, __builtin_bit_cast(int, P[e]), 0x114, 0xf, 0xf, false));
            P[e] *= __builtin_bit_cast(float, __builtin_amdgcn_update_dpp(0x3f800000, __builtin_bit_cast(int, P[e]), 0x118, 0xf, 0xf, false));
          }
          float qt[4], kh[4], kt[4];
#pragma unroll
          for (int e = 0; e < 4; ++e) {
            const float Pl = bperm(P[e], lane | 15);
            const float inv = frcp(fmaxf(P[e], 1e-30f));
            qt[e] = q[e] * P[e]; kh[e] = kv[e] * inv; kt[e] = kh[e] * Pl;
          }
          if (fr == 15) *(f32x4*)(dec + dkp) = (f32x4){P[0], P[1], P[2], P[3]};
          const int kpos = (wid >> 1) * 32 + fq * 8 + (wid & 1) * 4;
          u32x2 o; o.x = cvt_pk(qt[0], qt[1]); o.y = cvt_pk(qt[2], qt[3]);
          *(u32x2*)(Qs + fr * 136 + kpos) = o;
          o.x = cvt_pk(kh[0], kh[1]); o.y = cvt_pk(kh[2], kh[3]);
          *(u32x2*)(Kh + fr * 136 + kpos) = o;
          { const unsigned k01 = cvt_pk(kt[0], kt[1]), k23 = cvt_pk(kt[2], kt[3]);
            Kt[(dkp + 0) * KTS + fr] = (bfr)(k01 & 0xffff); Kt[(dkp + 1) * KTS + fr] = (bfr)(k01 >> 16);
            Kt[(dkp + 2) * KTS + fr] = (bfr)(k23 & 0xffff); Kt[(dkp + 3) * KTS + fr] = (bfr)(k23 >> 16); }
          const int vt = tid >> 5, dv4 = (tid & 31) << 2;
          const bool vv = (sb + vt) < T;
          const unsigned vx = vv ? raw[u].v.x : 0u, vy = vv ? raw[u].v.y : 0u;
          Vt[(dv4 + 0) * KTS + vt] = (bfr)(vx & 0xffff); Vt[(dv4 + 1) * KTS + vt] = (bfr)(vx >> 16);
          Vt[(dv4 + 2) * KTS + vt] = (bfr)(vy & 0xffff); Vt[(dv4 + 3) * KTS + vt] = (bfr)(vy >> 16);
          gsave[s] = raw[u].g;
          hg_load(raw[u], proj, g0, T, i + 4, h, wid, fr, fq, tid);
        }
        __syncthreads();
        if (i > 0) {
          const float* redp = redb + (s ^ 1) * 128;
          float tot = 0.f;
#pragma unroll
          for (int w = 0; w < 8; ++w) tot += redp[fr * 8 + w];
          const float rs = rsqrtf(tot * (1.f / 128.f) + 1e-6f);
          const int tk = (i - 1) * 16 + fr;
          if (tk < T) {
            const u32x2 gw = gsave[s ^ 1];
            const float gg[4] = {bflo(gw.x), bfhi(gw.x), bflo(gw.y), bfhi(gw.y)};
            float r[4];
#pragma unroll
            for (int e = 0; e < 4; ++e) r[e] = oprev[e] * rs * og[e] * gg[e] * sigmoidf_(gg[e]);
            u32x2 o; o.x = cvt_pk(r[0], r[1]); o.y = cvt_pk(r[2], r[3]);
            *(u32x2*)(branch + (size_t)(g0 + tk) * BRW + h * 128 + wid * 16 + fq * 4) = o;
          }
        }
        {
          bf16x8 qp[4], kp[4];
#pragma unroll
          for (int uu = 0; uu < 4; ++uu) {
            qp[uu] = *(const bf16x8*)(Qs + fr * 136 + uu * 32 + fq * 8);
            kp[uu] = *(const bf16x8*)(Kh + fr * 136 + uu * 32 + fq * 8);
          }
          f32x4 at = {0.f, 0.f, 0.f, 0.f};
#pragma unroll
          for (int uu = 0; uu < 4; ++uu) at = __builtin_amdgcn_mfma_f32_16x16x32_bf16(kp[uu], qp[uu], at, 0, 0, 0);
#pragma unroll
          for (int e = 0; e < 4; ++e) if (fq * 4 + e > fr) at[e] = 0.f;
          u32x2 aw; aw.x = cvt_pk(at[0], at[1]); aw.y = cvt_pk(at[2], at[3]);
          const bf16x4 a4 = __builtin_bit_cast(bf16x4, aw);
          u32x2 vfw; { const unsigned* q2 = (const unsigned*)(Vt + (wid * 16 + fr) * KTS + fq * 4); vfw.x = q2[0]; vfw.y = q2[1]; }
          const bf16x4 vf = __builtin_bit_cast(bf16x4, vfw);
          const bf16x8 vf8 = {vf[0], vf[1], vf[2], vf[3], 0, 0, 0, 0}, a8 = {a4[0], a4[1], a4[2], a4[3], 0, 0, 0, 0};
          f32x4 oacc = __builtin_amdgcn_mfma_f32_16x16x32_bf16(vf8, a8, (f32x4){0.f, 0.f, 0.f, 0.f}, 0, 0, 0);
#pragma unroll
          for (int uu = 0; uu < 4; ++uu) {
            u32x4 w; w.x = cvt_pk(S[2 * uu][0], S[2 * uu][1]); w.y = cvt_pk(S[2 * uu][2], S[2 * uu][3]);
            w.z = cvt_pk(S[2 * uu + 1][0], S[2 * uu + 1][1]); w.w = cvt_pk(S[2 * uu + 1][2], S[2 * uu + 1][3]);
            oacc = __builtin_amdgcn_mfma_f32_16x16x32_bf16(__builtin_bit_cast(bf16x8, w), qp[uu], oacc, 0, 0, 0);
          }
#pragma unroll
          for (int kt = 0; kt < 8; ++kt) {
            const f32x4 d = *(const f32x4*)(dec + kt * 16 + fq * 4);
            u32x2 kfw; { const unsigned* q2 = (const unsigned*)(Kt + (kt * 16 + fr) * KTS + fq * 4); kfw.x = q2[0]; kfw.y = q2[1]; }
            const bf16x4 kf = __builtin_bit_cast(bf16x4, kfw);
            const bf16x8 kf8 = {kf[0], kf[1], kf[2], kf[3], 0, 0, 0, 0};
            S[kt] = __builtin_amdgcn_mfma_f32_16x16x32_bf16(kf8, vf8, S[kt] * d, 0, 0, 0);
          }
          float ss = oacc[0] * oacc[0] + oacc[1] * oacc[1] + oacc[2] * oacc[2] + oacc[3] * oacc[3];
          ss += bperm(ss, lane ^ 16); ss += bperm(ss, lane ^ 32);
          if (fq == 0) red[fr * 8 + wid] = ss;
          oprev = oacc;
        }
      }
    }
  }
  __syncthreads();
  {
    const int i = nsub - 1, s = i & 1;
    const float* redp = redb + s * 128;
    float tot = 0.f;
#pragma unroll
    for (int w = 0; w < 8; ++w) tot += redp[fr * 8 + w];
    const float rs = rsqrtf(tot * (1.f / 128.f) + 1e-6f);
    const int tk = i * 16 + fr;
    if (tk < T) {
      const u32x2 gw = gsave[s];
      const float gg[4] = {bflo(gw.x), bfhi(gw.x), bflo(gw.y), bfhi(gw.y)};
      float r[4];
#pragma unroll
      for (int e = 0; e < 4; ++e) r[e] = oprev[e] * rs * og[e] * gg[e] * sigmoidf_(gg[e]);
      u32x2 o; o.x = cvt_pk(r[0], r[1]); o.y = cvt_pk(r[2], r[3]);
      *(u32x2*)(branch + (size_t)(g0 + tk) * BRW + h * 128 + wid * 16 + fq * 4) = o;
    }
  }
  float* so = p.out + (smp ? O_SHS + (((size_t)j * 128 + b) * 8 + h) * 16384 : O_SHP + (((size_t)j * 8 + b) * 8 + h) * 16384);
#pragma unroll
  for (int kt = 0; kt < 8; ++kt)
#pragma unroll
    for (int e = 0; e < 4; ++e) so[(kt * 16 + fq * 4 + e) * 128 + wid * 16 + fr] = S[kt][e];
  __syncthreads();
}

#define LDS_BARRIER() do { asm volatile("s_waitcnt lgkmcnt(0)" ::: "memory"); __builtin_amdgcn_s_barrier(); asm volatile("" ::: "memory"); } while (0)
typedef float f32x2 __attribute__((ext_vector_type(2)));
struct RwRaw { u32x2 r, k, v, gt, ew, a, vg, vf; };
constexpr int RW_SET = 7 * 1024;
struct RwCtx {
  const bfr* proj; const bfr* lup; const bfr* vfsrc; bfr* vdst; bfr* branch;
  int vgoff, vfld;
  int g0, T, tsl, cq4, C4;
  f32x4 kkw, kaw, rkw, lng, lnb;
};
__device__ __forceinline__ float sum16(float v) {
  v += dppf<0xB1>(v); v += dppf<0x4E>(v); v += dppf<0x141>(v); v += dppf<0x140>(v);
  return v;
}
__device__ __forceinline__ f32x4 unpk4(const u32x2 w) { return (f32x4){bflo(w.x), bfhi(w.x), bflo(w.y), bfhi(w.y)}; }
__device__ __forceinline__ void rw_load(RwRaw& raw, const RwCtx& c, const int tile) {
  int tok = tile * 16 + c.tsl; tok = tok < c.T ? tok : c.T - 1;
  const size_t g = (size_t)(c.g0 + tok);
  const bfr* pr = c.proj + g * INC + c.C4;
  raw.r = *(const u32x2*)pr; raw.k = *(const u32x2*)(pr + 1024); raw.v = *(const u32x2*)(pr + 2048); raw.gt = *(const u32x2*)(pr + 3584);
  const bfr* pl = c.lup + g * 3072 + c.C4;
  raw.ew = *(const u32x2*)pl; raw.a = *(const u32x2*)(pl + 1024); raw.vg = *(const u32x2*)(pl + c.vgoff);
  raw.vf = *(const u32x2*)(c.vfsrc + g * c.vfld + c.C4);
}
__device__ __forceinline__ void rw_prep(const RwRaw& raw, f32x4& bon, f32x4& gt, float* __restrict__ L, const RwCtx& c, const int tile) {
  int tok = tile * 16 + c.tsl; tok = tok < c.T ? tok : c.T - 1;
  const int tt = tok & 15;
  const size_t g = (size_t)(c.g0 + tok);
  const f32x4 r = unpk4(raw.r), k = unpk4(raw.k), ew = unpk4(raw.ew), a = unpk4(raw.a);
  f32x4 v = unpk4(raw.v);
  *(u32x2*)(c.vdst + g * DM + c.C4) = raw.v;
  v = v + (unpk4(raw.vf) - v) * unpk4(raw.vg);
  f32x4 dcy; dcy[0] = __expf(ew[0]); dcy[1] = __expf(ew[1]); dcy[2] = __expf(ew[2]); dcy[3] = __expf(ew[3]);
  f32x4 kk = k * c.kkw;
  const float n2 = sum16((kk[0] * kk[0] + kk[1] * kk[1]) + (kk[2] * kk[2] + kk[3] * kk[3]));
  const float inv = __builtin_amdgcn_rsqf(fmaxf(n2, 1e-24f));
  kk = kk * inv;
  const f32x4 k2 = k * (1.f + (a - 1.f) * c.kaw);
  const f32x4 rk = r * k2 * c.rkw;
  const float sb = sum16((rk[0] + rk[1]) + (rk[2] + rk[3]));
  bon = v * sb;
  gt = unpk4(raw.gt);
  const int o = tt * 64 + c.cq4;
  *(f32x4*)(L + 0 * 1024 + o) = r; *(f32x4*)(L + 1 * 1024 + o) = dcy; *(f32x4*)(L + 2 * 1024 + o) = k2; *(f32x4*)(L + 3 * 1024 + o) = v;
  *(f32x4*)(L + 4 * 1024 + o) = -kk; *(f32x4*)(L + 5 * 1024 + o) = kk * a;
}
__device__ __forceinline__ void rw_post(const f32x4 bon, const f32x4 gt, const float* __restrict__ L, const RwCtx& c, const int tile) {
  int tok = tile * 16 + c.tsl; tok = tok < c.T ? tok : c.T - 1;
  const int tt = tok & 15;
  const size_t g = (size_t)(c.g0 + tok);
  const f32x4 y = *(const f32x4*)(L + 6 * 1024 + tt * 64 + c.cq4);
  const float mean = sum16((y[0] + y[1]) + (y[2] + y[3])) * (1.f / 64.f);
  const f32x4 d = y - mean;
  const float var = sum16((d[0] * d[0] + d[1] * d[1]) + (d[2] * d[2] + d[3] * d[3])) * (1.f / 64.f);
  f32x4 o = d * rsqrtf(var + 64e-5f) * c.lng + c.lnb + bon;
  o[0] *= gt[0] * sigmoidf_(gt[0]); o[1] *= gt[1] * sigmoidf_(gt[1]); o[2] *= gt[2] * sigmoidf_(gt[2]); o[3] *= gt[3] * sigmoidf_(gt[3]);
  u32x2 w; w.x = cvt_pk(o[0], o[1]); w.y = cvt_pk(o[2], o[3]);
  *(u32x2*)(c.branch + g * BRW + c.C4) = w;
}
struct RwVec { f32x4 r0, r1, w0, w1, k0, k1, a0, a1, b0, b1; float v; };
__device__ __forceinline__ void rw_ldvec(RwVec& x, const float* __restrict__ L, const int t, const int row, const int c0) {
  x.r0 = *(const f32x4*)(L + 0 * 1024 + t * 64 + c0); x.r1 = *(const f32x4*)(L + 0 * 1024 + t * 64 + c0 + 4);
  x.w0 = *(const f32x4*)(L + 1 * 1024 + t * 64 + c0); x.w1 = *(const f32x4*)(L + 1 * 1024 + t * 64 + c0 + 4);
  x.k0 = *(const f32x4*)(L + 2 * 1024 + t * 64 + c0); x.k1 = *(const f32x4*)(L + 2 * 1024 + t * 64 + c0 + 4);
  x.v = L[3 * 1024 + t * 64 + row];
  x.a0 = *(const f32x4*)(L + 4 * 1024 + t * 64 + c0); x.a1 = *(const f32x4*)(L + 4 * 1024 + t * 64 + c0 + 4);
  x.b0 = *(const f32x4*)(L + 5 * 1024 + t * 64 + c0); x.b1 = *(const f32x4*)(L + 5 * 1024 + t * 64 + c0 + 4);
}
template <int NST>
__device__ __forceinline__ void rw_scan(f32x2 (&S)[4], float* __restrict__ L, const int row, const int c0, const int cg) {
  RwVec cur, nxt;
  rw_ldvec(cur, L, 0, row, c0);
  float yp[NST / 2], ra[NST / 2];
  const bool hi = (cg & 4) != 0, b1 = (cg & 2) != 0, b0 = (cg & 1) != 0;
#pragma unroll
  for (int t = 0; t < NST; ++t) {
    if (t + 1 < NST) rw_ldvec(nxt, L, t + 1, row, c0);
    const f32x2 av[4] = {{cur.a0[0], cur.a0[1]}, {cur.a0[2], cur.a0[3]}, {cur.a1[0], cur.a1[1]}, {cur.a1[2], cur.a1[3]}};
    const f32x2 wv[4] = {{cur.w0[0], cur.w0[1]}, {cur.w0[2], cur.w0[3]}, {cur.w1[0], cur.w1[1]}, {cur.w1[2], cur.w1[3]}};
    const f32x2 bv[4] = {{cur.b0[0], cur.b0[1]}, {cur.b0[2], cur.b0[3]}, {cur.b1[0], cur.b1[1]}, {cur.b1[2], cur.b1[3]}};
    const f32x2 kv[4] = {{cur.k0[0], cur.k0[1]}, {cur.k0[2], cur.k0[3]}, {cur.k1[0], cur.k1[1]}, {cur.k1[2], cur.k1[3]}};
    const f32x2 rv[4] = {{cur.r0[0], cur.r0[1]}, {cur.r0[2], cur.r0[3]}, {cur.r1[0], cur.r1[1]}, {cur.r1[2], cur.r1[3]}};
    const f32x2 vi2 = {cur.v, cur.v};
    f32x2 pa = S[0] * av[0] + S[1] * av[1];
    const f32x2 pb = S[2] * av[2] + S[3] * av[3];
    f32x2 n[4];
#pragma unroll
    for (int q = 0; q < 4; ++q) n[q] = S[q] * wv[q] + vi2 * kv[q];
    pa += pb;
    const float sa = sum8(pa[0] + pa[1]);
    const f32x2 sa2 = {sa, sa};
#pragma unroll
    for (int q = 0; q < 4; ++q) S[q] = sa2 * bv[q] + n[q];
    f32x2 ya = S[0] * rv[0] + S[1] * rv[1];
    const f32x2 yb = S[2] * rv[2] + S[3] * rv[3];
    ya += yb;
    if (t < NST / 2) yp[t] = ya[0] + ya[1];
    else { const float lo = yp[t - NST / 2], hv = ya[0] + ya[1]; const float mine = hi ? hv : lo, send = hi ? lo : hv; ra[t - NST / 2] = mine + dppf<0x141>(send); }
    cur = nxt;
  }
  float rb[NST / 4], rc[NST / 8];
#pragma unroll
  for (int k = 0; k < NST / 4; ++k) { const float mine = b1 ? ra[k + NST / 4] : ra[k], send = b1 ? ra[k] : ra[k + NST / 4]; rb[k] = mine + dppf<0x4E>(send); }
#pragma unroll
  for (int k = 0; k < NST / 8; ++k) { const float mine = b0 ? rb[k + NST / 8] : rb[k], send = b0 ? rb[k] : rb[k + NST / 8]; rc[k] = mine + dppf<0xB1>(send); }
  const int base = (hi ? NST / 2 : 0) + (b1 ? NST / 4 : 0) + (b0 ? NST / 8 : 0);
#pragma unroll
  for (int k = 0; k < NST / 8; ++k) L[6 * 1024 + (base + k) * 64 + row] = rc[k];
}

__device__ __forceinline__ void rwkv_unit(const Params& p, const int l, const bool smp, const int b, const int head) {
  extern __shared__ __attribute__((aligned(16))) char smem[];
  float* L0 = (float*)smem;
  float* L1 = L0 + RW_SET;
  RwCtx c;
  const int tid = tidx();
  const int wid = tid >> 6, lane = tid & 63;
  const int j = l >> 1;
  c.proj = (const bfr*)(p.ws + WS_PROJ);
  c.lup = (const bfr*)(p.ws + WS_LUP);
  c.vfsrc = (j == 0) ? c.proj + 2048 : (const bfr*)(p.ws + WS_VFIRST);
  c.vfld = (j == 0) ? INC : DM;
  c.vgoff = (j == 0) ? 1024 : 2048;
  c.vdst = (j == 0) ? (bfr*)(p.ws + WS_VFIRST) : (bfr*)(p.ws + WS_HA + 2 * HA_SZ * 2);
  c.branch = (bfr*)(p.ws + WS_BRANCH);
  c.g0 = smp ? NPR + b * 8 : b * 2048;
  c.T = smp ? 8 : 2048;
  c.tsl = 2 * wid + ((lane >> 4) & 1);
  c.cq4 = (lane & 15) * 4;
  c.C4 = head * 64 + c.cq4;
  const int cg = lane & 7, row = wid * 8 + (lane >> 3), c0 = cg * 8;
  f32x2 S[4];
  if (smp) {
    const float* s0 = pin(p, I_SR) + ((((size_t)j * 128 + b) * 16 + head) * 64 + row) * 64 + c0;
    const float4 a = *(const float4*)s0, bq = *(const float4*)(s0 + 4);
    S[0] = (f32x2){a.x, a.y}; S[1] = (f32x2){a.z, a.w}; S[2] = (f32x2){bq.x, bq.y}; S[3] = (f32x2){bq.z, bq.w};
  } else {
    S[0] = S[1] = S[2] = S[3] = (f32x2){0.f, 0.f};
  }
  c.kkw = *(const f32x4*)(pin(p, I_KK) + j * DM + c.C4); c.kaw = *(const f32x4*)(pin(p, I_KA) + j * DM + c.C4); c.rkw = *(const f32x4*)(pin(p, I_RK) + j * DM + c.C4);
  c.lng = *(const f32x4*)(pin(p, I_LG) + j * DM + c.C4); c.lnb = *(const f32x4*)(pin(p, I_LBI) + j * DM + c.C4);
  RwRaw rawA, rawB;
  f32x4 bonA, bonB, gtA, gtB;
  if (smp) {
    rw_load(rawA, c, 0);
    rw_prep(rawA, bonA, gtA, L0, c, 0);
    LDS_BARRIER();
    rw_scan<8>(S, L0, row, c0, cg);
    LDS_BARRIER();
    rw_post(bonA, gtA, L0, c, 0);
  } else {
    const int ntile = 128;
    rw_load(rawA, c, 0); rw_load(rawB, c, 1);
    rw_prep(rawA, bonA, gtA, L0, c, 0); rw_load(rawA, c, 2);
    LDS_BARRIER();
    rw_scan<16>(S, L0, row, c0, cg); rw_prep(rawB, bonB, gtB, L1, c, 1); rw_load(rawB, c, 3);
    LDS_BARRIER();
    for (int i = 1; i < ntile - 1; i += 2) {
      rw_post(bonA, gtA, L0, c, i - 1); rw_scan<16>(S, L1, row, c0, cg); rw_prep(rawA, bonA, gtA, L0, c, i + 1); rw_load(rawA, c, i + 3);
      LDS_BARRIER();
      rw_post(bonB, gtB, L1, c, i); rw_scan<16>(S, L0, row, c0, cg); rw_prep(rawB, bonB, gtB, L1, c, i + 2); rw_load(rawB, c, i + 4);
      LDS_BARRIER();
    }
    rw_post(bonA, gtA, L0, c, ntile - 2); rw_scan<16>(S, L1, row, c0, cg);
    LDS_BARRIER();
    rw_post(bonB, gtB, L1, c, ntile - 1);
  }
  float* so = p.out + (smp ? O_SRS + ((((size_t)j * 128 + b) * 16 + head) * 64 + row) * 64 + c0 : O_SRP + ((((size_t)j * 8 + b) * 16 + head) * 64 + row) * 64 + c0);
  *(float4*)so = make_float4(S[0][0], S[0][1], S[1][0], S[1][1]); *(float4*)(so + 4) = make_float4(S[2][0], S[2][1], S[3][0], S[3][1]);
  __syncthreads();
}

__device__ __forceinline__ void mix_phase(const Params& p, const int l, const int rep) {
  __shared__ int s_item;
  unsigned* ctr = (unsigned*)(p.ws + WS_CTRL) + l + 4 * rep;
  const bool rw = l & 1;
  const int nP = rw ? 128 : 64, nS = rw ? 2048 : 1024;
  const int nitems = nP + nS + 1024;
  for (;;) {
    __syncthreads();
    if (tidx() == 0) s_item = (int)atomicAdd(ctr, 1u);
    __syncthreads();
    int it = s_item;
    if (rep > 0 && PROBE_SUB == 1) { if (it >= nP) break; }
    if (rep > 0 && PROBE_SUB == 2) { it += nP; if (it >= nP + nS) break; }
    if (rep > 0 && PROBE_SUB == 3) { it += nP + nS; }
    if (it >= nitems) break;
    if (it < nP + nS) {
      const bool smp = it >= nP;
      if (smp) it -= nP;
      if (rw) rwkv_unit(p, l, smp, it >> 4, it & 15); else hgrn_unit(p, l, smp, it >> 3, it & 7);
    } else {
      it -= nP + nS;
      const float* kb; const float* vb; int g0, ntok, head;
      if (it < 512) {
        const int b = it >> 6, blk = it & 15; head = (it >> 4) & 3;
        const size_t off = ((size_t)(l * 8 + b) * 256) * 512 + head * 128;
        kb = p.out + O_MK + off; vb = p.out + O_MV + off; g0 = b * 2048 + blk * 128; ntok = 128;
      } else {
        it -= 512;
        const int b = it >> 2; head = it & 3;
        const size_t off = ((size_t)(l * 128 + b) * 256) * 512 + head * 128;
        kb = pin(p, I_CK) + off; vb = pin(p, I_CV) + off; g0 = NPR + b * 8; ntok = 8;
      }
      xattn_unit(p, kb, vb, g0, ntok, head);
    }
  }
}

#define XB_TMO      128
#define XB_XCNT(j)  (256  + 64 * (j))
#define XB_XSUB(j)  (1280 + 64 * (j))
#define XB_XGEN(j)  (2304 + 64 * (j))
#define XB_TOP      3328
#define XB_TOPGEN   3392
#define XB_SPIN_CAP (1u << 18)
#define XB_LAS __attribute__((address_space(3)))
__device__ __forceinline__ unsigned xb_ld(unsigned* p)              { return __hip_atomic_load(p, __ATOMIC_RELAXED, __HIP_MEMORY_SCOPE_AGENT); }
__device__ __forceinline__ unsigned xb_add(unsigned* p, unsigned v) { return __hip_atomic_fetch_add(p, v, __ATOMIC_RELAXED, __HIP_MEMORY_SCOPE_AGENT); }
__device__ __forceinline__ unsigned xb_xcc_id() { return (unsigned)__builtin_amdgcn_s_getreg((3 << 11) | 20) & 0xFu; }
#define XB_SPIN(cond, bar) do { unsigned _sp = 0; while (cond) { __builtin_amdgcn_s_sleep(1); \
    if ((++_sp & 255u) == 0u) { if (xb_ld(&(bar)[XB_TMO])) break; if (_sp > XB_SPIN_CAP) { atomicAdd(&(bar)[XB_TMO], 1u); break; } } } } while (0)
__device__ __forceinline__ void xcd_barrier_complete(unsigned* bar, unsigned x, unsigned& nloc, unsigned& nx) {
  const unsigned G = gridDim.x;
  unsigned sum, cnt, mine, sp = 0u;
  for (;;) {
    sum = 0u; cnt = 0u; mine = 0u;
#pragma unroll
    for (unsigned j = 0; j < 16; ++j) { const unsigned c = xb_ld(&bar[XB_XCNT(j)]); sum += c; cnt += (c > 0u) ? 1u : 0u; mine = (j == x) ? c : mine; }
    if (sum == G) break;
    __builtin_amdgcn_s_sleep(1);
    if ((++sp & 255u) == 0u) { if (xb_ld(&bar[XB_TMO])) break; if (sp > XB_SPIN_CAP) { atomicAdd(&bar[XB_TMO], 1u); break; } }
  }
  nloc = mine > 0u ? mine : 1u; nx = cnt > 0u ? cnt : 1u;
}
__device__ __forceinline__ void grid_barrier(unsigned* bar, volatile XB_LAS unsigned* st) {
  asm volatile("s_waitcnt vmcnt(0)" ::: "memory");
  __syncthreads();
  if (threadIdx.x == 0) {
    const unsigned x = xb_xcc_id();
    __builtin_amdgcn_s_waitcnt(0);
    unsigned nloc = st[0], nx = st[1];
    if (nloc == 0u) { xcd_barrier_complete(bar, x, nloc, nx); st[0] = nloc; st[1] = nx; }
    const unsigned old = xb_add(&bar[XB_XSUB(x)], 1u);
    const unsigned gen = old / nloc;
    if (old + 1u == (gen + 1u) * nloc) {
      __builtin_amdgcn_fence(__ATOMIC_RELEASE, "agent");
      asm volatile("s_waitcnt vmcnt(0)" ::: "memory");
      const unsigned og = xb_add(&bar[XB_TOP], 1u);
      const unsigned tg = og / nx;
      if (og + 1u == (tg + 1u) * nx) xb_add(&bar[XB_TOPGEN], 1u);
      else XB_SPIN(xb_ld(&bar[XB_TOPGEN]) == tg, bar);
      __builtin_amdgcn_fence(__ATOMIC_ACQUIRE, "agent");
      xb_add(&bar[XB_XGEN(x)], 1u);
      asm volatile("s_waitcnt vmcnt(0)" ::: "memory");
    } else {
      XB_SPIN(xb_ld(&bar[XB_XGEN(x)]) == gen, bar);
      __builtin_amdgcn_fence(__ATOMIC_ACQUIRE, "agent");
      asm volatile("s_waitcnt vmcnt(0)" ::: "memory");
    }
  }
  __syncthreads();
}
__device__ __forceinline__ void run_phase(const Params& p, const int ph, const int rep) {
  int code;
  switch (ph) {
    case 0: code = 0; break;
    case 1: code = 1 | (0 << 4) | (0 << 8); break;
    case 2: code = 2 | (0 << 8); break;
    case 3: code = 1 | (2 << 4) | (0 << 8); break;
    case 4: code = 3 | (1 << 8); break;
    case 5: code = 1 | (0 << 4) | (1 << 8); break;
    case 6: code = 1 | (1 << 4) | (1 << 8); break;
    case 7: code = 2 | (1 << 8); break;
    case 8: code = 1 | (2 << 4) | (1 << 8); break;
    case 9: code = 3 | (2 << 8); break;
    case 10: code = 1 | (0 << 4) | (2 << 8); break;
    case 11: code = 2 | (2 << 8); break;
    case 12: code = 1 | (2 << 4) | (2 << 8); break;
    case 13: code = 3 | (3 << 8); break;
    case 14: code = 1 | (0 << 4) | (3 << 8); break;
    case 15: code = 1 | (1 << 4) | (3 << 8); break;
    case 16: code = 2 | (3 << 8); break;
    case 17: code = 1 | (2 << 4) | (3 << 8); break;
    default: code = 4; break;
  }
  const int type = code & 15, kind = (code >> 4) & 15, l = code >> 8;
  if (type == 0) prologue(p);
  else if (type == 1) gemm_phase(p, kind, l);
  else if (type == 2) mix_phase(p, l, rep);
  else if (type == 3) prep_phase(p, l);
  else final_phase(p);
}
constexpr int NPHASE = 19;

__global__ void __launch_bounds__(512) mega(Params p) {
  __shared__ uint4 xb_words;
  if (threadIdx.x == 0) {
    xb_words = make_uint4(0u, 0u, 0u, 0u);
    (void)xb_add(&((unsigned*)(p.ws + WS_XBAR))[XB_XCNT(xb_xcc_id())], 1u);
  }
  __syncthreads();
  for (int ph = p.ph_lo; ph <= p.ph_hi; ++ph) {
    const int nrep = ((PROBE_MASK >> ph) & 1u) ? 2 : 1;
    for (int rep = 0; rep < nrep; ++rep) {
      run_phase(p, ph, rep);
      if (ph < p.ph_hi || rep + 1 < nrep) {
        if (p.ph_hi < 0) cg::this_grid().sync();
        grid_barrier((unsigned*)(p.ws + WS_XBAR), (volatile XB_LAS unsigned*)&xb_words);
      }
    }
  }
}

extern "C" void kernel_launch(void* const* d_in, const int* in_sizes, int n_in, void* d_out, int out_size, void* d_ws, size_t ws_size,
                              hipStream_t stream) {
  static int grid = 0;
  if (grid == 0) {
    if (n_in != 31 || ws_size < WS_END) { fprintf(stderr, "kernel_launch: unexpected n_in %d / ws %zu (need %zu)\n", n_in, ws_size, (size_t)WS_END); grid = -1; return; }
    int dev = 0, cus = 0, per_cu = 0;
    hipGetDevice(&dev);
    hipDeviceGetAttribute(&cus, hipDeviceAttributeMultiprocessorCount, dev);
    if (hipFuncSetAttribute((const void*)mega, hipFuncAttributeMaxDynamicSharedMemorySize, LDS_BYTES) != hipSuccess) { fprintf(stderr, "hipFuncSetAttribute failed\n"); grid = -1; return; }
    hipOccupancyMaxActiveBlocksPerMultiprocessor(&per_cu, (const void*)mega, 512, LDS_BYTES);
    if (per_cu < 1) { fprintf(stderr, "occupancy query says %d blocks/CU\n", per_cu); per_cu = 1; }
    (void)hipGetLastError();
    grid = cus * per_cu;
  }
  if (grid < 0) return;
  Params p{};
  for (int i = 0; i < 31; ++i) p.in[i] = (const float*)d_in[i];
  p.out = (float*)d_out; p.ws = (char*)d_ws;
  if (hipMemsetAsync((char*)d_ws + WS_CTRL, 0, 4096 + 16384, stream) != hipSuccess) { fprintf(stderr, "kernel_launch: control-word memset failed\n"); return; }
#if COOP
  p.ph_lo = 0; p.ph_hi = NPHASE - 1;
  void* args[] = {&p};
  hipError_t e = hipLaunchCooperativeKernel((const void*)mega, dim3(grid), dim3(512), args, LDS_BYTES, stream);
  if (e != hipSuccess) fprintf(stderr, "cooperative launch failed: %s (grid %d)\n", hipGetErrorString(e), grid);
#else
  for (int ph = 0; ph < NPHASE; ++ph) {
    p.ph_lo = ph; p.ph_hi = ph;
    hipLaunchKernelGGL(mega, dim3(grid), dim3(512), LDS_BYTES, stream, p);
  }
#endif
}
```

```cpp
#include <hip/hip_runtime.h>
#include <hip/hip_cooperative_groups.h>
#include <cstdio>
#include <cstdint>
namespace cg = cooperative_groups;

#ifndef COOP
#define COOP 1
#endif
#ifndef PROBE_SUB
#define PROBE_SUB 0
#endif
#ifndef PROBE_MASK
#define PROBE_MASK 0u
#endif

typedef unsigned short bfr;
typedef short bf16x8 __attribute__((ext_vector_type(8)));
typedef short bf16x4 __attribute__((ext_vector_type(4)));
typedef float f32x4 __attribute__((ext_vector_type(4)));
typedef unsigned u32x2 __attribute__((ext_vector_type(2)));
typedef unsigned u32x4 __attribute__((ext_vector_type(4)));

constexpr int NTOK = 17408, NPR = 16384, DM = 1024, INC = 5120, BRW = 1536;
constexpr int LDS_BYTES = 139264;
constexpr size_t O_YP = 0, O_SHP = 17825792, O_SRP = 19922944, O_SSP = 20971520, O_MK = 20987904, O_MV = 25182208,
                 O_SHS = 29376512, O_SRS = 62930944, O_SSS = 79708160;
constexpr size_t WS_CTRL = 0;
constexpr size_t WS_XBAR = 4096;
constexpr size_t WS_WTIN = 4096 + 16384;
constexpr size_t WTIN_L = (size_t)5888 * 1024;
constexpr size_t WS_WTOUT = WS_WTIN + 4 * WTIN_L * 2;
constexpr size_t WS_WTMEM = WS_WTOUT + (size_t)4 * 1024 * 1536 * 2;
constexpr size_t WS_W2T = WS_WTMEM + (size_t)4 * 1024 * 1024 * 2;
constexpr size_t WS_MEMN = WS_W2T + (size_t)2 * 3072 * 256 * 2;
constexpr size_t WS_XRES = WS_MEMN + (size_t)4 * 2048 * 1024 * 2;
constexpr size_t HA_SZ = (size_t)NTOK * 1024;
constexpr size_t WS_HA = WS_XRES + (size_t)NTOK * 1024 * 4;
constexpr size_t WS_PROJ = WS_HA + 6 * HA_SZ * 2;
constexpr size_t WS_ALORA = WS_PROJ + (size_t)NTOK * INC * 2;
constexpr size_t WS_LUP = WS_ALORA + (size_t)NTOK * 256 * 2;
constexpr size_t WS_VFIRST = WS_LUP + (size_t)NTOK * 3072 * 2;
constexpr size_t WS_BRANCH = WS_VFIRST + HA_SZ * 2;
constexpr size_t WS_PART = WS_BRANCH + (size_t)NTOK * BRW * 2;
constexpr size_t WS_END = WS_PART + (size_t)5 * 1024 * 1024 * 4;

struct Params {
  const float* in[31];
  float* out;
  char* ws;
  int ph_lo, ph_hi;
};
enum { I_XP = 0, I_XS, I_MEM, I_SH, I_SR, I_SS, I_CK, I_CV, I_NG, I_WIN, I_WOUT, I_MNG, I_WMEM, I_LB, I_ONG, I_MU, I_W0, I_W1, I_W2,
       I_A0, I_A1, I_A2, I_V0, I_V1, I_V2, I_KK, I_KA, I_RK, I_LG, I_LBI, I_FG };

__device__ __forceinline__ unsigned cvt_pk(float lo, float hi) { unsigned r; asm("v_cvt_pk_bf16_f32 %0, %1, %2" : "=v"(r) : "v"(lo), "v"(hi)); return r; }
__device__ __forceinline__ bfr f2bf(float f) { return (bfr)(cvt_pk(f, 0.f) & 0xffff); }
__device__ __forceinline__ float bf2f(unsigned h) { return __uint_as_float(h << 16); }
__device__ __forceinline__ float bflo(unsigned w) { return __uint_as_float(w << 16); }
__device__ __forceinline__ float bfhi(unsigned w) { return __uint_as_float(w & 0xffff0000u); }
__device__ __forceinline__ float frcp(float x) { return __builtin_amdgcn_rcpf(x); }
__device__ __forceinline__ float sigmoidf_(float x) { return frcp(1.f + __expf(-x)); }
template <int CTRL> __device__ __forceinline__ float dppf(float x) {
  return __builtin_bit_cast(float, __builtin_amdgcn_update_dpp(0, __builtin_bit_cast(int, x), CTRL, 0xf, 0xf, true));
}
__device__ __forceinline__ float wave_sum(float v) {
  v += dppf<0xB1>(v); v += dppf<0x4E>(v); v += dppf<0x141>(v); v += dppf<0x140>(v);
  const int iv = __builtin_bit_cast(int, v);
  float r = __builtin_bit_cast(float, __builtin_amdgcn_readlane(iv, 0));
  r += __builtin_bit_cast(float, __builtin_amdgcn_readlane(iv, 16));
  r += __builtin_bit_cast(float, __builtin_amdgcn_readlane(iv, 32));
  r += __builtin_bit_cast(float, __builtin_amdgcn_readlane(iv, 48));
  return r;
}
__device__ __forceinline__ float bperm(float v, int srclane) { return __builtin_bit_cast(float, __builtin_amdgcn_ds_bpermute(srclane << 2, __builtin_bit_cast(int, v))); }
__device__ __forceinline__ float sum8(float v) {
  v += dppf<0xB1>(v);
  v += dppf<0x4E>(v);
  v += dppf<0x141>(v);
  return v;
}
__device__ __forceinline__ const float* pin(const Params& p, int i) { asm volatile("" : "+s"(i)); return p.in[i]; }
__device__ __forceinline__ const float* xin_row(const Params& p, int g) {
  return g < NPR ? pin(p, I_XP) + (size_t)g * DM : pin(p, I_XS) + (size_t)(g - NPR) * DM;
}

__device__ __forceinline__ int tidx() { int t = threadIdx.x; asm volatile("" : "+v"(t)); return t; }
__device__ __forceinline__ int bidx() { int b = blockIdx.x; asm volatile("" : "+s"(b)); return b; }
__device__ __forceinline__ int wperm(int n) { const int c = n & 31; return (n & ~31) + ((c >> 2) & 1) * 16 + (c >> 3) * 4 + (c & 3); }

__device__ __forceinline__ void transpose_job(const float* __restrict__ src, int Ks, int Ns, bfr* __restrict__ dst, int ldd, int rot) {
  extern __shared__ __attribute__((aligned(16))) char smem[];
  bfr* T = (bfr*)smem;
  const int tid = tidx();
  const int tn = Ns >> 6, ntile = (Ks >> 6) * tn;
  const int G = gridDim.x;
  for (int tile = (bidx() + rot) % G; tile < ntile; tile += G) {
    const int k0 = (tile / tn) << 6, n0 = (tile % tn) << 6;
    const int kl = tid >> 3, nc = (tid & 7) << 3;
    const float* s = src + (size_t)(k0 + kl) * Ns + n0 + nc;
    const float4 a = *(const float4*)s, b = *(const float4*)(s + 4);
    __syncthreads();
    T[(nc + 0) * 72 + kl] = f2bf(a.x); T[(nc + 1) * 72 + kl] = f2bf(a.y); T[(nc + 2) * 72 + kl] = f2bf(a.z); T[(nc + 3) * 72 + kl] = f2bf(a.w);
    T[(nc + 4) * 72 + kl] = f2bf(b.x); T[(nc + 5) * 72 + kl] = f2bf(b.y); T[(nc + 6) * 72 + kl] = f2bf(b.z); T[(nc + 7) * 72 + kl] = f2bf(b.w);
    __syncthreads();
    const int nl = tid >> 3, kc = (tid & 7) << 3;
    const u32x4 v = *(const u32x4*)(T + nl * 72 + kc);
    *(u32x4*)(dst + (size_t)wperm(n0 + nl) * ldd + k0 + kc) = v;
  }
}

__device__ __forceinline__ void prologue(const Params& p) {
  const int tid = tidx(), wid = tid >> 6, lane = tid & 63;
  const int G = gridDim.x;
  char* ws = p.ws;
  int rot = 0;
  for (int l = 0; l < 4; ++l) {
    transpose_job(pin(p, I_WIN) + (size_t)l * DM * INC, DM, INC, (bfr*)(ws + WS_WTIN) + l * WTIN_L, DM, rot); rot = (rot + G - (1280 % G)) % G;
    transpose_job(pin(p, I_WOUT) + (size_t)l * BRW * DM, BRW, DM, (bfr*)(ws + WS_WTOUT) + (size_t)l * DM * BRW, BRW, rot); rot = (rot + G - (384 % G)) % G;
    transpose_job(pin(p, I_WMEM) + (size_t)l * DM * DM, DM, DM, (bfr*)(ws + WS_WTMEM) + (size_t)l * DM * DM, DM, rot); rot = (rot + G - (256 % G)) % G;
  }
  const int gt = bidx() * 512 + tid, nth = G * 512;
  for (int j = 0; j < 2; ++j) {
    bfr* dst = (bfr*)(ws + WS_WTIN) + (size_t)(2 * j + 1) * WTIN_L + (size_t)5120 * 1024;
    const float* w1 = pin(p, I_W1) + (size_t)j * 1024 * 64;
    const float* a1 = pin(p, I_A1) + (size_t)j * 1024 * 64;
    const float* v1 = pin(p, I_V1);
    for (int it = gt; it < 768 * 128; it += nth) {
      const int n = it % 768, kc = it / 768;
      const int seg = n >> 8, c = n & 255;
      float v[8];
#pragma unroll
      for (int e = 0; e < 8; ++e) {
        const int k = kc * 8 + e;
        float x = 0.f;
        if (seg == 0) { if (c < 64) x = w1[k * 64 + c]; }
        else if (seg == 1) { if (c < 64) x = a1[k * 64 + c]; }
        else { if (j == 1 && c < 32) x = v1[k * 32 + c]; }
        v[e] = x;
      }
      u32x4 o; o.x = cvt_pk(v[0], v[1]); o.y = cvt_pk(v[2], v[3]); o.z = cvt_pk(v[4], v[5]); o.w = cvt_pk(v[6], v[7]);
      *(u32x4*)(dst + (size_t)wperm(n) * 1024 + kc * 8) = o;
    }
    bfr* d2 = (bfr*)(ws + WS_W2T) + (size_t)j * 3072 * 256;
    const float* w2 = pin(p, I_W2) + (size_t)j * 64 * 1024;
    const float* a2 = pin(p, I_A2) + (size_t)j * 64 * 1024;
    const float* v2 = pin(p, I_V2);
    for (int it = gt; it < 3072 * 32; it += nth) {
      const int n = it % 3072, kc = it / 3072;
      const int seg = n >> 10, c = n & 1023;
      float v[8];
#pragma unroll
      for (int e = 0; e < 8; ++e) {
        const int k = kc * 8 + e;
        float x = 0.f;
        if (seg == 0) { if (k < 64) x = w2[k * 1024 + c]; }
        else if (seg == 1) { if (k >= 64 && k < 128) x = a2[(k - 64) * 1024 + c]; }
        else { if (j == 1 && k >= 128 && k < 160) x = v2[(k - 128) * 1024 + c]; }
        v[e] = x;
      }
      u32x4 o; o.x = cvt_pk(v[0], v[1]); o.y = cvt_pk(v[2], v[3]); o.z = cvt_pk(v[4], v[5]); o.w = cvt_pk(v[6], v[7]);
      *(u32x4*)(d2 + (size_t)wperm(n) * 256 + kc * 8) = o;
    }
  }
  const int gw = bidx() * 8 + wid, nw = G * 8;
  for (int row = gw; row < 2048 + NTOK; row += nw) {
    const bool ismem = row < 2048;
    const float* src = ismem ? pin(p, I_MEM) + (size_t)row * DM : xin_row(p, row - 2048);
    float4 x[4]; float ss = 0.f;
#pragma unroll
    for (int i = 0; i < 4; ++i) { x[i] = *(const float4*)(src + lane * 4 + i * 256); ss += x[i].x * x[i].x + x[i].y * x[i].y + x[i].z * x[i].z + x[i].w * x[i].w; }
    ss = wave_sum(ss);
    const float rs = rsqrtf(ss * (1.f / 1024.f) + 1e-6f);
    if (ismem) {
      for (int l = 0; l < 4; ++l) {
        bfr* dst = (bfr*)(ws + WS_MEMN) + ((size_t)l * 2048 + row) * DM;
#pragma unroll
        for (int i = 0; i < 4; ++i) {
          const float4 g = *(const float4*)(pin(p, I_MNG) + l * DM + lane * 4 + i * 256);
          u32x2 o; o.x = cvt_pk(x[i].x * rs * g.x, x[i].y * rs * g.y); o.y = cvt_pk(x[i].z * rs * g.z, x[i].w * rs * g.w);
          *(u32x2*)(dst + lane * 4 + i * 256) = o;
        }
      }
    } else {
      float* xr = (float*)(ws + WS_XRES) + (size_t)(row - 2048) * DM;
#pragma unroll
      for (int i = 0; i < 4; ++i) *(float4*)(xr + lane * 4 + i * 256) = x[i];
      bfr* dst = (bfr*)(ws + WS_HA) + (size_t)(row - 2048) * DM;
#pragma unroll
      for (int i = 0; i < 4; ++i) {
        const float4 g = *(const float4*)(pin(p, I_NG) + lane * 4 + i * 256);
        u32x2 o; o.x = cvt_pk(x[i].x * rs * g.x, x[i].y * rs * g.y); o.y = cvt_pk(x[i].z * rs * g.z, x[i].w * rs * g.w);
        *(u32x2*)(dst + lane * 4 + i * 256) = o;
      }
    }
  }
}

__device__ __forceinline__ void load_xrow(const Params& p, const int g, const int lane, float4 (&x)[4]) {
  const float* s = (const float*)(p.ws + WS_XRES) + (size_t)g * DM;
#pragma unroll
  for (int i = 0; i < 4; ++i) x[i] = *(const float4*)(s + lane * 4 + i * 256);
  if (g >= NPR) {
#pragma unroll
    for (int k = 0; k < 5; ++k) {
      const float* q = (const float*)(p.ws + WS_PART) + ((size_t)k * 1024 + (g - NPR)) * DM;
#pragma unroll
      for (int i = 0; i < 4; ++i) { const float4 t = *(const float4*)(q + lane * 4 + i * 256); x[i].x += t.x; x[i].y += t.y; x[i].z += t.z; x[i].w += t.w; }
    }
  }
}
__device__ __forceinline__ void prep_phase(const Params& p, int l) {
  const int tid = tidx(), wid = tid >> 6, lane = tid & 63;
  const bool rw = (l & 1);
  const int j = l >> 1;
  const float* xres = (const float*)(p.ws + WS_XRES);
  bfr* hA = (bfr*)(p.ws + WS_HA);
  const float* ng = pin(p, I_NG) + l * DM;
  const float* mu = pin(p, I_MU) + (size_t)j * 5 * DM;
  const int gw = bidx() * 8 + wid, nw = gridDim.x * 8;
  constexpr int NCH = 1920;
  for (int task = gw; task < NCH + 128; task += nw) {
    const int g0 = task < NCH ? (int)(((long)task * NPR) / NCH) : NPR + (task - NCH) * 8;
    const int nrows = task < NCH ? (int)(((long)(task + 1) * NPR) / NCH) - g0 : 8;
    float hp[16];
    if (rw) {
      const bool smp = g0 >= NPR;
      const int t0 = smp ? ((g0 - NPR) & 7) : (g0 & 2047);
      if (t0 == 0) {
        if (smp) {
          const float* s = pin(p, I_SS) + ((size_t)j * 128 + ((g0 - NPR) >> 3)) * DM;
#pragma unroll
          for (int i = 0; i < 4; ++i) { const float4 v = *(const float4*)(s + lane * 4 + i * 256); hp[i * 4] = v.x; hp[i * 4 + 1] = v.y; hp[i * 4 + 2] = v.z; hp[i * 4 + 3] = v.w; }
        } else {
#pragma unroll
          for (int i = 0; i < 16; ++i) hp[i] = 0.f;
        }
      } else {
        float4 x[4]; float ss = 0.f;
        load_xrow(p, g0 - 1, lane, x);
#pragma unroll
        for (int i = 0; i < 4; ++i) ss += x[i].x * x[i].x + x[i].y * x[i].y + x[i].z * x[i].z + x[i].w * x[i].w;
        ss = wave_sum(ss);
        const float rs = rsqrtf(ss * (1.f / 1024.f) + 1e-6f);
#pragma unroll
        for (int i = 0; i < 4; ++i) {
          const float4 g = *(const float4*)(ng + lane * 4 + i * 256);
          hp[i * 4] = x[i].x * rs * g.x; hp[i * 4 + 1] = x[i].y * rs * g.y; hp[i * 4 + 2] = x[i].z * rs * g.z; hp[i * 4 + 3] = x[i].w * rs * g.w;
        }
      }
    }
    for (int r = 0; r < nrows; ++r) {
      const int g = g0 + r;
      if (rw && r > 0 && g < NPR && (g & 2047) == 0) {
#pragma unroll
        for (int i = 0; i < 16; ++i) hp[i] = 0.f;
      }
      float4 x[4]; float ss = 0.f;
      load_xrow(p, g, lane, x);
      if (g >= NPR) {
        float* xw = (float*)(p.ws + WS_XRES) + (size_t)g * DM;
#pragma unroll
        for (int i = 0; i < 4; ++i) *(float4*)(xw + lane * 4 + i * 256) = x[i];
      }
#pragma unroll
      for (int i = 0; i < 4; ++i) ss += x[i].x * x[i].x + x[i].y * x[i].y + x[i].z * x[i].z + x[i].w * x[i].w;
      ss = wave_sum(ss);
      const float rs = rsqrtf(ss * (1.f / 1024.f) + 1e-6f);
      float h[16];
#pragma unroll
      for (int i = 0; i < 4; ++i) {
        const float4 gg = *(const float4*)(ng + lane * 4 + i * 256);
        h[i * 4] = x[i].x * rs * gg.x; h[i * 4 + 1] = x[i].y * rs * gg.y; h[i * 4 + 2] = x[i].z * rs * gg.z; h[i * 4 + 3] = x[i].w * rs * gg.w;
        u32x2 o; o.x = cvt_pk(h[i * 4], h[i * 4 + 1]); o.y = cvt_pk(h[i * 4 + 2], h[i * 4 + 3]);
        *(u32x2*)(hA + (size_t)g * DM + lane * 4 + i * 256) = o;
      }
      if (rw) {
#pragma unroll
        for (int m = 0; m < 5; ++m) {
          bfr* dst = hA + (size_t)(1 + m) * HA_SZ + (size_t)g * DM;
#pragma unroll
          for (int i = 0; i < 4; ++i) {
            const float4 mm = *(const float4*)(mu + m * DM + lane * 4 + i * 256);
            const float a0 = h[i * 4] + (hp[i * 4] - h[i * 4]) * mm.x, a1 = h[i * 4 + 1] + (hp[i * 4 + 1] - h[i * 4 + 1]) * mm.y;
            const float a2 = h[i * 4 + 2] + (hp[i * 4 + 2] - h[i * 4 + 2]) * mm.z, a3 = h[i * 4 + 3] + (hp[i * 4 + 3] - h[i * 4 + 3]) * mm.w;
            u32x2 o; o.x = cvt_pk(a0, a1); o.y = cvt_pk(a2, a3);
            *(u32x2*)(dst + lane * 4 + i * 256) = o;
          }
        }
        const bool smp = g >= NPR;
        const int t = smp ? ((g - NPR) & 7) : (g & 2047);
        if (t == (smp ? 7 : 2047)) {
          float* o = p.out + (smp ? O_SSS + ((size_t)j * 128 + ((g - NPR) >> 3)) * DM : O_SSP + ((size_t)j * 8 + (g >> 11)) * DM);
#pragma unroll
          for (int i = 0; i < 4; ++i) *(float4*)(o + lane * 4 + i * 256) = make_float4(h[i * 4], h[i * 4 + 1], h[i * 4 + 2], h[i * 4 + 3]);
        }
#pragma unroll
        for (int i = 0; i < 16; ++i) hp[i] = h[i];
      }
    }
  }
}

__device__ __forceinline__ void final_phase(const Params& p) {
  const int tid = tidx(), wid = tid >> 6, lane = tid & 63;
  const float* xres = (const float*)(p.ws + WS_XRES);
  const float* fg = pin(p, I_FG);
  const int gw = bidx() * 8 + wid, nw = gridDim.x * 8;
  for (int g = gw; g < NTOK; g += nw) {
    float4 x[4]; float ss = 0.f;
    load_xrow(p, g, lane, x);
#pragma unroll
    for (int i = 0; i < 4; ++i) ss += x[i].x * x[i].x + x[i].y * x[i].y + x[i].z * x[i].z + x[i].w * x[i].w;
    ss = wave_sum(ss);
    const float rs = rsqrtf(ss * (1.f / 1024.f) + 1e-6f);
    float* o = p.out + O_YP + (size_t)g * DM;
#pragma unroll
    for (int i = 0; i < 4; ++i) {
      const float4 gg = *(const float4*)(fg + lane * 4 + i * 256);
      *(float4*)(o + lane * 4 + i * 256) = make_float4(x[i].x * rs * gg.x, x[i].y * rs * gg.y, x[i].z * rs * gg.z, x[i].w * rs * gg.w);
    }
  }
}

constexpr int BM = 256, BK = 64, HALF = 128, HT = HALF * BK;
__device__ __forceinline__ int lds_byte(int r, int c) {
  int st = (r >> 4) * 2 + (c >> 5), rr = r & 15, cc = c & 31, ob = rr * 64 + cc * 2;
  return st * 1024 + (ob ^ (((ob >> 9) & 1) << 5));
}
__device__ __forceinline__ void stage_rc(int b, int& R, int& C) {
  int st = b / 1024, sb = b % 1024, swz = sb ^ (((sb >> 9) & 1) << 5);
  R = (st >> 1) * 16 + swz / 64; C = (st & 1) * 32 + (swz % 64) / 2;
}

enum { EM_PROJ = 0, EM_G1R, EM_MEM, EM_LUP, EM_OUT, EM_OUTA };

__device__ __forceinline__ void epilogue(const Params& p, const int mode, const int l, const f32x4 (&acc)[2][2][4][2],
                                         const int pm, const int pn, const int wr, const int wc, const int fr, const int fq) {
  const int j = (l & 255) >> 1;
#pragma unroll
  for (int ai = 0; ai < 2; ++ai)
#pragma unroll
    for (int m = 0; m < 4; ++m) {
      const int row = pm * BM + ai * HALF + wr * 64 + m * 16 + fr;
#pragma unroll
      for (int bj = 0; bj < 2; ++bj)
#pragma unroll
        for (int n = 0; n < 2; ++n) {
          const int col = pn * BM + bj * HALF + wc * 32 + fq * 8 + n * 4;
          const f32x4 v = acc[ai][bj][m][n];
          if (mode == EM_PROJ || (mode == EM_G1R && pn < 20)) {
            if (n == 0) {
              const f32x4 v1 = acc[ai][bj][m][1];
              u32x4 o; o.x = cvt_pk(v[0], v[1]); o.y = cvt_pk(v[2], v[3]); o.z = cvt_pk(v1[0], v1[1]); o.w = cvt_pk(v1[2], v1[3]);
              *(u32x4*)((bfr*)(p.ws + WS_PROJ) + (size_t)row * INC + col) = o;
            }
          } else if (mode == EM_G1R) {
            bfr* al = (bfr*)(p.ws + WS_ALORA) + (size_t)row * 256;
            const int c = col & 255;
            if (pn == 20) {
              if (c < 64) {
                float t[4];
#pragma unroll
                for (int e = 0; e < 4; ++e) { const float ex = __expf(2.f * v[e]); t[e] = 1.f - 2.f * frcp(ex + 1.f); }
                u32x2 o; o.x = cvt_pk(t[0], t[1]); o.y = cvt_pk(t[2], t[3]);
                *(u32x2*)(al + c) = o;
              }
            } else if (pn == 21) {
              const int lim = (l == 3) ? 128 : 256;
              if (64 + c < lim) {
                u32x2 o; o.x = 0u; o.y = 0u;
                if (c < 64) { o.x = cvt_pk(v[0], v[1]); o.y = cvt_pk(v[2], v[3]); }
                *(u32x2*)(al + 64 + c) = o;
              }
            } else {
              if (128 + c < 256) {
                u32x2 o; o.x = 0u; o.y = 0u;
                if (c < 32) { o.x = cvt_pk(v[0], v[1]); o.y = cvt_pk(v[2], v[3]); }
                *(u32x2*)(al + 128 + c) = o;
              }
            }
          } else if (mode == EM_MEM) {
            const int lm = pm >> 3, r2 = row & 2047;
            float* o = p.out + (col < 512 ? O_MK : O_MV) + ((size_t)lm * 2048 + r2) * 512 + (col & 511);
            *(f32x4*)o = v;
          } else if (mode == EM_LUP) {
            const int seg = col >> 10, c = col & 1023;
            float t[4];
            if (seg == 0) {
              const float4 b = *(const float4*)(pin(p, I_W0) + j * DM + c);
              const float bb[4] = {b.x, b.y, b.z, b.w};
#pragma unroll
              for (int e = 0; e < 4; ++e) {
                const float x = bb[e] + v[e];
                t[e] = -0.6065306597126334f * sigmoidf_(x);
              }
            } else if (seg == 1) {
              const float4 b = *(const float4*)(pin(p, I_A0) + j * DM + c);
              t[0] = sigmoidf_(b.x + v[0]); t[1] = sigmoidf_(b.y + v[1]); t[2] = sigmoidf_(b.z + v[2]); t[3] = sigmoidf_(b.w + v[3]);
            } else {
              const float4 b = *(const float4*)(pin(p, I_V0) + c);
              t[0] = sigmoidf_(b.x + v[0]); t[1] = sigmoidf_(b.y + v[1]); t[2] = sigmoidf_(b.z + v[2]); t[3] = sigmoidf_(b.w + v[3]);
            }
            u32x2 o; o.x = cvt_pk(t[0], t[1]); o.y = cvt_pk(t[2], t[3]);
            *(u32x2*)((bfr*)(p.ws + WS_LUP) + (size_t)row * 3072 + col) = o;
          } else if (mode == EM_OUT) {
            float* xo = (float*)(p.ws + WS_XRES) + (size_t)row * DM + col;
            const f32x4 x = *(const f32x4*)xo;
            *(f32x4*)xo = x + v;
          } else {
            *(f32x4*)((float*)(p.ws + WS_PART) + ((size_t)((l >> 8) - 1) * 1024 + (row - NPR)) * DM + col) = v;
          }
        }
    }
}

__device__ __forceinline__ void gemm_unit(const Params& p, const bfr* __restrict__ A, const bfr* __restrict__ Bt, const int K, const int kt0, const int nt,
                                          const int pm, const int pn, const int mode, const int l) {
  extern __shared__ __attribute__((aligned(16))) char smem[];
  bfr* shm = (bfr*)smem;
#define SA(b, h) (shm + ((b) * 2 + (h)) * HT)
#define SB(b, h) (shm + (4 + (b) * 2 + (h)) * HT)
#define STAGE(P, BASE, br, kt) do { const bfr* _g = (BASE) + (size_t)(br) * K + (kt0 + (kt)) * BK + goff; \
    __builtin_amdgcn_global_load_lds((const unsigned*)_g, (unsigned*)((char*)(P) + tid * 16), 16, 0, 0); \
    __builtin_amdgcn_global_load_lds((const unsigned*)(_g + (size_t)64 * K), (unsigned*)((char*)(P) + tid * 16 + 8192), 16, 0, 0); } while (0)
#define LDA(dst, b, h) for (int m = 0; m < 4; ++m) for (int k = 0; k < 2; ++k) \
    dst[m][k] = *reinterpret_cast<const bf16x8*>((char*)SA(b, h) + lds_byte(wr * 64 + m * 16 + fr, k * 32 + fq * 8))
#define LDB(dst, b, h) for (int n = 0; n < 2; ++n) for (int k = 0; k < 2; ++k) \
    dst[n][k] = *reinterpret_cast<const bf16x8*>((char*)SB(b, h) + lds_byte(wc * 32 + n * 16 + fr, k * 32 + fq * 8))
#define MMA(ai, bj, At, Bt_) do { __builtin_amdgcn_s_setprio(1); \
    for (int m = 0; m < 4; ++m) for (int n = 0; n < 2; ++n) for (int k = 0; k < 2; ++k) \
      acc[ai][bj][m][n] = __builtin_amdgcn_mfma_f32_16x16x32_bf16(Bt_[n][k], At[m][k], acc[ai][bj][m][n], 0, 0, 0); \
    __builtin_amdgcn_s_setprio(0); } while (0)
#define WAIT_V(n) asm volatile("s_waitcnt vmcnt(" #n ")" ::: "memory")
#define WAIT_L(n) asm volatile("s_waitcnt lgkmcnt(" #n ")" ::: "memory")
#define BAR __builtin_amdgcn_s_barrier()
#define SCHED __builtin_amdgcn_sched_barrier(0)
  const int tid = tidx();
  const int brow = pm * BM, bcol = pn * BM;
  const int wid = tid >> 6, lane = tid & 63, wr = wid >> 2, wc = wid & 3, fr = lane & 15, fq = lane >> 4;
  int R0, C0; stage_rc(tid * 16, R0, C0);
  const int goff = R0 * K + C0;
  f32x4 acc[2][2][4][2] = {};
  bf16x8 At[4][2], B0[2][2], B1[2][2];
  STAGE(SB(0, 0), Bt, bcol, 0); STAGE(SA(0, 0), A, brow, 0);
  STAGE(SB(0, 1), Bt, bcol + HALF, 0); STAGE(SA(0, 1), A, brow + HALF, 0);
  if (wr == 1) BAR;
  WAIT_V(4); BAR;
  STAGE(SB(1, 0), Bt, bcol, 1); STAGE(SA(1, 0), A, brow, 1); STAGE(SB(1, 1), Bt, bcol + HALF, 1);
  WAIT_V(6); BAR;
  for (int t = 0; t < nt - 2; t += 2) {
    LDB(B0, 0, 0); SCHED; LDA(At, 0, 0); STAGE(SA(1, 1), A, brow + HALF, t + 1);
    WAIT_L(8); BAR; WAIT_L(0); MMA(0, 0, At, B0); BAR; SCHED;
    LDB(B1, 0, 1); STAGE(SB(0, 0), Bt, bcol, t + 2);
    BAR; WAIT_L(0); MMA(0, 1, At, B1); BAR;
    LDA(At, 0, 1); STAGE(SA(0, 0), A, brow, t + 2);
    BAR; WAIT_L(0); MMA(1, 0, At, B0); BAR; SCHED;
    STAGE(SB(0, 1), Bt, bcol + HALF, t + 2);
    WAIT_V(6); BAR; MMA(1, 1, At, B1); BAR;
    LDB(B0, 1, 0); SCHED; LDA(At, 1, 0); STAGE(SA(0, 1), A, brow + HALF, t + 2);
    WAIT_L(8); BAR; WAIT_L(0); MMA(0, 0, At, B0); BAR; SCHED;
    LDB(B1, 1, 1); STAGE(SB(1, 0), Bt, bcol, t + 3);
    BAR; WAIT_L(0); MMA(0, 1, At, B1); BAR;
    LDA(At, 1, 1); STAGE(SA(1, 0), A, brow, t + 3);
    BAR; WAIT_L(0); MMA(1, 0, At, B0); BAR; SCHED;
    STAGE(SB(1, 1), Bt, bcol + HALF, t + 3);
    WAIT_V(6); BAR; MMA(1, 1, At, B1); BAR;
  }
  { LDB(B0, 0, 0); LDA(At, 0, 0); STAGE(SA(1, 1), A, brow + HALF, nt - 1);
    BAR; WAIT_L(0); MMA(0, 0, At, B0); BAR;
    LDB(B1, 0, 1); BAR; WAIT_L(0); MMA(0, 1, At, B1); BAR;
    LDA(At, 0, 1); WAIT_V(4); BAR; WAIT_L(0); MMA(1, 0, At, B0); MMA(1, 1, At, B1); BAR; }
  { LDB(B0, 1, 0); LDA(At, 1, 0); WAIT_V(2); BAR; WAIT_L(0); MMA(0, 0, At, B0); BAR;
    LDB(B1, 1, 1); WAIT_V(0); BAR; WAIT_L(0); MMA(0, 1, At, B1); BAR;
    LDA(At, 1, 1); BAR; WAIT_L(0); MMA(1, 0, At, B0); MMA(1, 1, At, B1); BAR; }
  if (wr == 0) BAR;
  epilogue(p, mode, l, acc, pm, pn, wr, wc, fr, fq);
  WAIT_V(0);
#undef SA
#undef SB
}

__device__ __forceinline__ bool unit_order(int i, int c, int G, int nM, int nN, int& pm, int& pn) {
  const int nwg = nM * nN;
  const long L = (long)i * G + c; if (L >= nwg) return false;
  int wgid = (int)L; { const int q = nwg / 8, r = nwg % 8, xcd = wgid % 8, off = wgid / 8; wgid = (xcd < r ? xcd * (q + 1) : r * (q + 1) + (xcd - r) * q) + off; }
  const int nig = 8 * nN, gid = wgid / nig, fm = gid * 8, gsz = (nM - fm) < 8 ? (nM - fm) : 8;
  pm = fm + ((wgid % nig) % gsz); pn = (wgid % nig) / gsz; return true;
}

__device__ __forceinline__ void gemm_phase(const Params& p, const int kind, const int l) {
  const int G = gridDim.x;
  const int j = l >> 1;
  const bool rw = l & 1;
  char* ws = p.ws;
  const bfr* hA = (const bfr*)(ws + WS_HA);
  int nM = NTOK / BM, nN, K, mode;
  const bfr* Bt;
  if (kind == 0) { nN = rw ? (l == 3 ? 23 : 22) : 20; K = 1024; mode = rw ? EM_G1R : EM_PROJ; Bt = (const bfr*)(ws + WS_WTIN) + l * WTIN_L; }
  else if (kind == 1) { nN = (l == 3) ? 12 : 8; K = 256; mode = EM_LUP; Bt = (const bfr*)(ws + WS_W2T) + (size_t)j * 3072 * 256; }
  else { nN = 4; K = 1536; mode = EM_OUT; Bt = (const bfr*)(ws + WS_WTOUT) + (size_t)l * DM * BRW; }
  int pm, pn;
  const int nwg1 = nM * nN;
  const bool withmem = (kind == 0 && l == 0);
  const int c2 = (bidx() + G - (nwg1 % G)) % G;
  int seg = 0, i = 0;
  for (;;) {
    const bfr* A; const bfr* B = Bt; int KK = K, md = mode, kt0 = 0, nt = K / BK, lk = l;
    if (kind == 2) {
      const int t = bidx() + G * i;
      if (t >= 256 + 96) break;
      ++i;
      A = (const bfr*)(ws + WS_BRANCH);
      if (t < 256) { pm = (t & 7) * 8 + (t >> 5); pn = (t >> 3) & 3; }
      else { const int v = t - 256, rem = v % 24, ks = rem % 6; pm = 64 + v / 24; pn = rem / 6; kt0 = ks * 4; nt = 4; if (ks) { md = EM_OUTA; lk = l | (ks << 8); } }
    } else {
      bool ok;
      if (seg == 0) ok = unit_order(i, bidx(), G, nM, nN, pm, pn);
      else ok = unit_order(i, c2, G, 32, 4, pm, pn);
      if (!ok) { if (seg == 0 && withmem) { seg = 1; i = 0; continue; } break; }
      ++i;
      if (seg == 1) { A = (const bfr*)(ws + WS_MEMN); B = (const bfr*)(ws + WS_WTMEM) + (size_t)(pm >> 3) * DM * DM; KK = 1024; nt = 16; md = EM_MEM; }
      else if (kind == 0) {
        int sel = 0;
        if (rw) sel = pn < 4 ? 1 : pn < 8 ? 3 : pn < 12 ? 4 : pn < 20 ? 0 : pn == 20 ? 2 : pn == 21 ? 5 : 4;
        A = hA + (size_t)sel * HA_SZ;
      } else A = (const bfr*)(ws + WS_ALORA);
    }
    gemm_unit(p, A, B, KK, kt0, nt, pm, pn, md, lk);
  }
}

__device__ __forceinline__ void xattn_unit(const Params& p, const float* __restrict__ kb, const float* __restrict__ vb, const int g0, const int ntok, const int head) {
  extern __shared__ __attribute__((aligned(16))) char smem[];
  bfr* Ks = (bfr*)smem;
  bfr* Vt = Ks + 256 * 136;
  const int tid = tidx(), wid = tid >> 6, lane = tid & 63, fr = lane & 15, fq = lane >> 4;
#pragma unroll 4
  for (int i = 0; i < 16; ++i) {
    const int idx = tid + i * 512, row = idx >> 5, c4 = (idx & 31) << 2;
    const float4 v = *(const float4*)(kb + (size_t)row * 512 + c4);
    u32x2 o; o.x = cvt_pk(v.x, v.y); o.y = cvt_pk(v.z, v.w);
    *(u32x2*)(Ks + row * 136 + c4) = o;
  }
  {
    const int pp = lane & 7, dd = lane >> 3;
#pragma unroll 4
    for (int it = 0; it < 8; ++it) {
      const int wq = it * 8 + wid, mb = wq & 15, db = wq >> 4;
      const int m0 = mb * 16 + 2 * pp, d0 = db * 32 + dd * 4;
      const float4 a = *(const float4*)(vb + (size_t)m0 * 512 + d0);
      const float4 b = *(const float4*)(vb + (size_t)(m0 + 1) * 512 + d0);
      *(unsigned*)(Vt + (d0 + 0) * 260 + m0) = cvt_pk(a.x, b.x);
      *(unsigned*)(Vt + (d0 + 1) * 260 + m0) = cvt_pk(a.y, b.y);
      *(unsigned*)(Vt + (d0 + 2) * 260 + m0) = cvt_pk(a.z, b.z);
      *(unsigned*)(Vt + (d0 + 3) * 260 + m0) = cvt_pk(a.w, b.w);
    }
  }
  __syncthreads();
  if (wid * 16 < ntok) {
    const bfr* proj = (const bfr*)(p.ws + WS_PROJ);
    int tl = wid * 16 + fr; if (tl > ntok - 1) tl = ntok - 1;
    const bfr* qrow = proj + (size_t)(g0 + tl) * INC + 3072 + head * 128;
    bf16x8 qf[4];
#pragma unroll
    for (int ks = 0; ks < 4; ++ks) qf[ks] = *(const bf16x8*)(qrow + ks * 32 + fq * 8);
    f32x4 sc[16];
#pragma unroll
    for (int mt = 0; mt < 16; ++mt) {
      f32x4 a = {0.f, 0.f, 0.f, 0.f};
#pragma unroll
      for (int ks = 0; ks < 4; ++ks) {
        const bf16x8 kf = *(const bf16x8*)(Ks + (mt * 16 + fr) * 136 + ks * 32 + fq * 8);
        a = __builtin_amdgcn_mfma_f32_16x16x32_bf16(kf, qf[ks], a, 0, 0, 0);
      }
      sc[mt] = a;
    }
    float mx = -3.0e38f;
#pragma unroll
    for (int mt = 0; mt < 16; ++mt) mx = fmaxf(mx, fmaxf(fmaxf(sc[mt][0], sc[mt][1]), fmaxf(sc[mt][2], sc[mt][3])));
    mx = fmaxf(mx, bperm(mx, lane ^ 16)); mx = fmaxf(mx, bperm(mx, lane ^ 32));
    const float cs = 0.08838834764831845f * 1.4426950408889634f;
    float sum = 0.f;
#pragma unroll
    for (int mt = 0; mt < 16; ++mt)
#pragma unroll
      for (int e = 0; e < 4; ++e) { const float pe = exp2f((sc[mt][e] - mx) * cs); sc[mt][e] = pe; sum += pe; }
    sum += bperm(sum, lane ^ 16); sum += bperm(sum, lane ^ 32);
    const float inv = frcp(sum);
    bf16x8 pf[8];
#pragma unroll
    for (int u = 0; u < 8; ++u) {
      u32x4 w; w.x = cvt_pk(sc[2 * u][0], sc[2 * u][1]); w.y = cvt_pk(sc[2 * u][2], sc[2 * u][3]);
      w.z = cvt_pk(sc[2 * u + 1][0], sc[2 * u + 1][1]); w.w = cvt_pk(sc[2 * u + 1][2], sc[2 * u + 1][3]);
      pf[u] = __builtin_bit_cast(bf16x8, w);
    }
    const bool tvalid = (wid * 16 + fr) < ntok;
    const int g = g0 + tl;
    const bfr* gate = proj + (size_t)g * INC + 3584 + 1024 + head * 128;
    bfr* br = (bfr*)(p.ws + WS_BRANCH) + (size_t)g * BRW + 1024 + head * 128;
#pragma unroll
    for (int dt = 0; dt < 8; ++dt) {
      f32x4 a = {0.f, 0.f, 0.f, 0.f};
#pragma unroll
      for (int u = 0; u < 8; ++u) {
        const bfr* vr = Vt + (dt * 16 + fr) * 260 + fq * 4;
        u32x4 w;
        const u32x2 lo = *(const u32x2*)(vr + (2 * u) * 16), hi = *(const u32x2*)(vr + (2 * u + 1) * 16);
        w.x = lo.x; w.y = lo.y; w.z = hi.x; w.w = hi.y;
        a = __builtin_amdgcn_mfma_f32_16x16x32_bf16(__builtin_bit_cast(bf16x8, w), pf[u], a, 0, 0, 0);
      }
      if (tvalid) {
        const u32x2 gw = *(const u32x2*)(gate + dt * 16 + fq * 4);
        const float g0f = bflo(gw.x), g1f = bfhi(gw.x), g2f = bflo(gw.y), g3f = bfhi(gw.y);
        u32x2 o;
        o.x = cvt_pk(a[0] * inv * g0f * sigmoidf_(g0f), a[1] * inv * g1f * sigmoidf_(g1f));
        o.y = cvt_pk(a[2] * inv * g2f * sigmoidf_(g2f), a[3] * inv * g3f * sigmoidf_(g3f));
        *(u32x2*)(br + dt * 16 + fq * 4) = o;
      }
    }
  }
  __syncthreads();
}

struct HgRaw { u32x2 q, f, v, g; };
__device__ __forceinline__ void hg_load(HgRaw& r, const bfr* __restrict__ proj, const int g0, const int T, const int sbi, const int h,
                                        const int wid, const int fr, const int fq, const int tid) {
  const int t0 = sbi * 16;
  if (t0 + fr < T) {
    const bfr* pr = proj + (size_t)(g0 + t0 + fr) * INC + h * 128 + wid * 16 + fq * 4;
    r.q = *(const u32x2*)pr; r.f = *(const u32x2*)(pr + 1024); r.g = *(const u32x2*)(pr + 3584);
  }
  const int vt = tid >> 5, dv4 = (tid & 31) << 2;
  if (t0 + vt < T) r.v = *(const u32x2*)(proj + (size_t)(g0 + t0 + vt) * INC + 2048 + h * 128 + dv4);
}
constexpr int KTS = 18;
constexpr int HG_SET = 16 * 136 * 2 + 128 * KTS * 2;

__device__ __forceinline__ void hgrn_unit(const Params& p, const int l, const bool smp, const int b, const int h) {
  extern __shared__ __attribute__((aligned(16))) char smem[];
  bfr* lds0 = (bfr*)smem;
  float* decb = (float*)(lds0 + 2 * HG_SET);
  float* redb = decb + 256;
  const int tid = tidx(), wid = tid >> 6, lane = tid & 63, fr = lane & 15, fq = lane >> 4;
  const int j = l >> 1;
  const bfr* proj = (const bfr*)(p.ws + WS_PROJ);
  bfr* branch = (bfr*)(p.ws + WS_BRANCH);
  const int g0 = smp ? NPR + b * 8 : b * 2048;
  const int T = smp ? 8 : 2048;
  const int nsub = (T + 15) >> 4;
  f32x4 S[8];
  if (smp) {
    const float* s0 = pin(p, I_SH) + (((size_t)j * 128 + b) * 8 + h) * 16384;
#pragma unroll
    for (int kt = 0; kt < 8; ++kt)
#pragma unroll
      for (int e = 0; e < 4; ++e) S[kt][e] = s0[(kt * 16 + fq * 4 + e) * 128 + wid * 16 + fr];
  } else {
#pragma unroll
    for (int kt = 0; kt < 8; ++kt) S[kt] = (f32x4){0.f, 0.f, 0.f, 0.f};
  }
  const int dkp = wid * 16 + fq * 4;
  float lb[4];
#pragma unroll
  for (int e = 0; e < 4; ++e) {
    if (j == 0) lb[e] = 0.f;
    else { const int c = h * 128 + dkp + e; lb[e] = sigmoidf_(pin(p, I_LB)[1024 + c] - pin(p, I_LB)[c]); }
  }
  float og[4];
#pragma unroll
  for (int e = 0; e < 4; ++e) og[e] = pin(p, I_ONG)[j * 128 + wid * 16 + fq * 4 + e];

  HgRaw raw[4];
#pragma unroll
  for (int u = 0; u < 4; ++u) { raw[u].q = raw[u].f = raw[u].v = raw[u].g = (u32x2){0u, 0u}; hg_load(raw[u], proj, g0, T, u, h, wid, fr, fq, tid); }
  u32x2 gsave[2] = {(u32x2){0u, 0u}, (u32x2){0u, 0u}};
  f32x4 oprev = {0.f, 0.f, 0.f, 0.f};

  for (int i4 = 0; i4 < nsub; i4 += 4) {
#pragma unroll
    for (int u = 0; u < 4; ++u) {
      const int i = i4 + u;
      if (i < nsub) {
        const int s = u & 1;
        bfr* Qs = lds0 + s * HG_SET; bfr* Kh = Qs + 16 * 136; bfr* Kt = Kh + 16 * 136; bfr* Vt = Kt + 128 * KTS;
        float* dec = decb + s * 128; float* red = redb + s * 128;
        {
          const int sb = i * 16;
          const bool valid = (sb + fr) < T;
          float q[4], P[4], kv[4];
          const float qz[4] = {bflo(raw[u].q.x), bfhi(raw[u].q.x), bflo(raw[u].q.y), bfhi(raw[u].q.y)};
          const float fz[4] = {bflo(raw[u].f.x), bfhi(raw[u].f.x), bflo(raw[u].f.y), bfhi(raw[u].f.y)};
#pragma unroll
          for (int e = 0; e < 4; ++e) {
            const float sg = sigmoidf_(fz[e]);
            const float f = fmaxf(lb[e] + (1.f - lb[e]) * sg, 1e-30f);
            P[e] = valid ? f : 1.f;
            kv[e] = valid ? (1.f - lb[e]) * (1.f - sg) : 0.f;
            q[e] = valid ? qz[e] * sigmoidf_(qz[e]) : 0.f;
          }
#pragma unroll
          for (int e = 0; e < 4; ++e) {
            P[e] *= __builtin_bit_cast(float, __builtin_amdgcn_update_dpp(0x3f800000, __builtin_bit_cast(int, P[e]), 0x111, 0xf, 0xf, false));
            P[e] *= __builtin_bit_cast(float, __builtin_amdgcn_update_dpp(0x3f800000, __builtin_bit_cast(int, P[e]), 0x112, 0xf, 0xf, false));
            P[e] *= __builtin_bit_cast(float, __builtin_amdgcn_update_dpp(0x3f800000, __builtin_bit_cast(int, P[e]), 0x114, 0xf, 0xf, false));
            P[e] *= __builtin_bit_cast(float, __builtin_amdgcn_update_dpp(0x3f800000, __builtin_bit_cast(int, P[e]), 0x118, 0xf, 0xf, false));
          }
          float qt[4], kh[4], kt[4];
#pragma unroll
          for (int e = 0; e < 4; ++e) {
            const float Pl = bperm(P[e], lane | 15);
            const float inv = frcp(fmaxf(P[e], 1e-30f));
            qt[e] = q[e] * P[e]; kh[e] = kv[e] * inv; kt[e] = kh[e] * Pl;
          }
          if (fr == 15) *(f32x4*)(dec + dkp) = (f32x4){P[0], P[1], P[2], P[3]};
          const int kpos = (wid >> 1) * 32 + fq * 8 + (wid & 1) * 4;
          u32x2 o; o.x = cvt_pk(qt[0], qt[1]); o.y = cvt_pk(qt[2], qt[3]);
          *(u32x2*)(Qs + fr * 136 + kpos) = o;
          o.x = cvt_pk(kh[0], kh[1]); o.y = cvt_pk(kh[2], kh[3]);
          *(u32x2*)(Kh + fr * 136 + kpos) = o;
          { const unsigned k01 = cvt_pk(kt[0], kt[1]), k23 = cvt_pk(kt[2], kt[3]);
            Kt[(dkp + 0) * KTS + fr] = (bfr)(k01 & 0xffff); Kt[(dkp + 1) * KTS + fr] = (bfr)(k01 >> 16);
            Kt[(dkp + 2) * KTS + fr] = (bfr)(k23 & 0xffff); Kt[(dkp + 3) * KTS + fr] = (bfr)(k23 >> 16); }
          const int vt = tid >> 5, dv4 = (tid & 31) << 2;
          const bool vv = (sb + vt) < T;
          const unsigned vx = vv ? raw[u].v.x : 0u, vy = vv ? raw[u].v.y : 0u;
          Vt[(dv4 + 0) * KTS + vt] = (bfr)(vx & 0xffff); Vt[(dv4 + 1) * KTS + vt] = (bfr)(vx >> 16);
          Vt[(dv4 + 2) * KTS + vt] = (bfr)(vy & 0xffff); Vt[(dv4 + 3) * KTS + vt] = (bfr)(vy >> 16);
          gsave[s] = raw[u].g;
          hg_load(raw[u], proj, g0, T, i + 4, h, wid, fr, fq, tid);
        }
        __syncthreads();
        if (i > 0) {
          const float* redp = redb + (s ^ 1) * 128;
          float tot = 0.f;
#pragma unroll
          for (int w = 0; w < 8; ++w) tot += redp[fr * 8 + w];
          const float rs = rsqrtf(tot * (1.f / 128.f) + 1e-6f);
          const int tk = (i - 1) * 16 + fr;
          if (tk < T) {
            const u32x2 gw = gsave[s ^ 1];
            const float gg[4] = {bflo(gw.x), bfhi(gw.x), bflo(gw.y), bfhi(gw.y)};
            float r[4];
#pragma unroll
            for (int e = 0; e < 4; ++e) r[e] = oprev[e] * rs * og[e] * gg[e] * sigmoidf_(gg[e]);
            u32x2 o; o.x = cvt_pk(r[0], r[1]); o.y = cvt_pk(r[2], r[3]);
            *(u32x2*)(branch + (size_t)(g0 + tk) * BRW + h * 128 + wid * 16 + fq * 4) = o;
          }
        }
        {
          bf16x8 qp[4], kp[4];
#pragma unroll
          for (int uu = 0; uu < 4; ++uu) {
            qp[uu] = *(const bf16x8*)(Qs + fr * 136 + uu * 32 + fq * 8);
            kp[uu] = *(const bf16x8*)(Kh + fr * 136 + uu * 32 + fq * 8);
          }
          f32x4 at = {0.f, 0.f, 0.f, 0.f};
#pragma unroll
          for (int uu = 0; uu < 4; ++uu) at = __builtin_amdgcn_mfma_f32_16x16x32_bf16(kp[uu], qp[uu], at, 0, 0, 0);
#pragma unroll
          for (int e = 0; e < 4; ++e) if (fq * 4 + e > fr) at[e] = 0.f;
          u32x2 aw; aw.x = cvt_pk(at[0], at[1]); aw.y = cvt_pk(at[2], at[3]);
          const bf16x4 a4 = __builtin_bit_cast(bf16x4, aw);
          u32x2 vfw; { const unsigned* q2 = (const unsigned*)(Vt + (wid * 16 + fr) * KTS + fq * 4); vfw.x = q2[0]; vfw.y = q2[1]; }
          const bf16x4 vf = __builtin_bit_cast(bf16x4, vfw);
          const bf16x8 vf8 = {vf[0], vf[1], vf[2], vf[3], 0, 0, 0, 0}, a8 = {a4[0], a4[1], a4[2], a4[3], 0, 0, 0, 0};
          f32x4 oacc = __builtin_amdgcn_mfma_f32_16x16x32_bf16(vf8, a8, (f32x4){0.f, 0.f, 0.f, 0.f}, 0, 0, 0);
#pragma unroll
          for (int uu = 0; uu < 4; ++uu) {
            u32x4 w; w.x = cvt_pk(S[2 * uu][0], S[2 * uu][1]); w.y = cvt_pk(S[2 * uu][2], S[2 * uu][3]);
            w.z = cvt_pk(S[2 * uu + 1][0], S[2 * uu + 1][1]); w.w = cvt_pk(S[2 * uu + 1][2], S[2 * uu + 1][3]);
            oacc = __builtin_amdgcn_mfma_f32_16x16x32_bf16(__builtin_bit_cast(bf16x8, w), qp[uu], oacc, 0, 0, 0);
          }
#pragma unroll
          for (int kt = 0; kt < 8; ++kt) {
            const f32x4 d = *(const f32x4*)(dec + kt * 16 + fq * 4);
            u32x2 kfw; { const unsigned* q2 = (const unsigned*)(Kt + (kt * 16 + fr) * KTS + fq * 4); kfw.x = q2[0]; kfw.y = q2[1]; }
            const bf16x4 kf = __builtin_bit_cast(bf16x4, kfw);
            const bf16x8 kf8 = {kf[0], kf[1], kf[2], kf[3], 0, 0, 0, 0};
            S[kt] = __builtin_amdgcn_mfma_f32_16x16x32_bf16(kf8, vf8, S[kt] * d, 0, 0, 0);
          }
          float ss = oacc[0] * oacc[0] + oacc[1] * oacc[1] + oacc[2] * oacc[2] + oacc[3] * oacc[3];
          ss += bperm(ss, lane ^ 16); ss += bperm(ss, lane ^ 32);
          if (fq == 0) red[fr * 8 + wid] = ss;
          oprev = oacc;
        }
      }
    }
  }
  __syncthreads();
  {
    const int i = nsub - 1, s = i & 1;
    const float* redp = redb + s * 128;
    float tot = 0.f;
#pragma unroll
    for (int w = 0; w < 8; ++w) tot += redp[fr * 8 + w];
    const float rs = rsqrtf(tot * (1.f / 128.f) + 1e-6f);
    const int tk = i * 16 + fr;
    if (tk < T) {
      const u32x2 gw = gsave[s];
      const float gg[4] = {bflo(gw.x), bfhi(gw.x), bflo(gw.y), bfhi(gw.y)};
      float r[4];
#pragma unroll
      for (int e = 0; e < 4; ++e) r[e] = oprev[e] * rs * og[e] * gg[e] * sigmoidf_(gg[e]);
      u32x2 o; o.x = cvt_pk(r[0], r[1]); o.y = cvt_pk(r[2], r[3]);
      *(u32x2*)(branch + (size_t)(g0 + tk) * BRW + h * 128 + wid * 16 + fq * 4) = o;
    }
  }
  float* so = p.out + (smp ? O_SHS + (((size_t)j * 128 + b) * 8 + h) * 16384 : O_SHP + (((size_t)j * 8 + b) * 8 + h) * 16384);
#pragma unroll
  for (int kt = 0; kt < 8; ++kt)
#pragma unroll
    for (int e = 0; e < 4; ++e) so[(kt * 16 + fq * 4 + e) * 128 + wid * 16 + fr] = S[kt][e];
  __syncthreads();
}

#define LDS_BARRIER() do { asm volatile("s_waitcnt lgkmcnt(0)" ::: "memory"); __builtin_amdgcn_s_barrier(); asm volatile("" ::: "memory"); } while (0)
typedef float f32x2 __attribute__((ext_vector_type(2)));
struct RwRaw { u32x2 r, k, v, gt, ew, a, vg, vf; };
constexpr int RW_SET = 7 * 1024;
struct RwCtx {
  const bfr* proj; const bfr* lup; const bfr* vfsrc; bfr* vdst; bfr* branch;
  int vgoff, vfld;
  int g0, T, tsl, cq4, C4;
  f32x4 kkw, kaw, rkw, lng, lnb;
};
__device__ __forceinline__ float sum16(float v) {
  v += dppf<0xB1>(v); v += dppf<0x4E>(v); v += dppf<0x141>(v); v += dppf<0x140>(v);
  return v;
}
__device__ __forceinline__ f32x4 unpk4(const u32x2 w) { return (f32x4){bflo(w.x), bfhi(w.x), bflo(w.y), bfhi(w.y)}; }
__device__ __forceinline__ void rw_load(RwRaw& raw, const RwCtx& c, const int tile) {
  int tok = tile * 16 + c.tsl; tok = tok < c.T ? tok : c.T - 1;
  const size_t g = (size_t)(c.g0 + tok);
  const bfr* pr = c.proj + g * INC + c.C4;
  raw.r = *(const u32x2*)pr; raw.k = *(const u32x2*)(pr + 1024); raw.v = *(const u32x2*)(pr + 2048); raw.gt = *(const u32x2*)(pr + 3584);
  const bfr* pl = c.lup + g * 3072 + c.C4;
  raw.ew = *(const u32x2*)pl; raw.a = *(const u32x2*)(pl + 1024); raw.vg = *(const u32x2*)(pl + c.vgoff);
  raw.vf = *(const u32x2*)(c.vfsrc + g * c.vfld + c.C4);
}
__device__ __forceinline__ void rw_prep(const RwRaw& raw, f32x4& bon, f32x4& gt, float* __restrict__ L, const RwCtx& c, const int tile) {
  int tok = tile * 16 + c.tsl; tok = tok < c.T ? tok : c.T - 1;
  const int tt = tok & 15;
  const size_t g = (size_t)(c.g0 + tok);
  const f32x4 r = unpk4(raw.r), k = unpk4(raw.k), ew = unpk4(raw.ew), a = unpk4(raw.a);
  f32x4 v = unpk4(raw.v);
  *(u32x2*)(c.vdst + g * DM + c.C4) = raw.v;
  v = v + (unpk4(raw.vf) - v) * unpk4(raw.vg);
  f32x4 dcy; dcy[0] = __expf(ew[0]); dcy[1] = __expf(ew[1]); dcy[2] = __expf(ew[2]); dcy[3] = __expf(ew[3]);
  f32x4 kk = k * c.kkw;
  const float n2 = sum16((kk[0] * kk[0] + kk[1] * kk[1]) + (kk[2] * kk[2] + kk[3] * kk[3]));
  const float inv = __builtin_amdgcn_rsqf(fmaxf(n2, 1e-24f));
  kk = kk * inv;
  const f32x4 k2 = k * (1.f + (a - 1.f) * c.kaw);
  const f32x4 rk = r * k2 * c.rkw;
  const float sb = sum16((rk[0] + rk[1]) + (rk[2] + rk[3]));
  bon = v * sb;
  gt = unpk4(raw.gt);
  const int o = tt * 64 + c.cq4;
  *(f32x4*)(L + 0 * 1024 + o) = r; *(f32x4*)(L + 1 * 1024 + o) = dcy; *(f32x4*)(L + 2 * 1024 + o) = k2; *(f32x4*)(L + 3 * 1024 + o) = v;
  *(f32x4*)(L + 4 * 1024 + o) = -kk; *(f32x4*)(L + 5 * 1024 + o) = kk * a;
}
__device__ __forceinline__ void rw_post(const f32x4 bon, const f32x4 gt, const float* __restrict__ L, const RwCtx& c, const int tile) {
  int tok = tile * 16 + c.tsl; tok = tok < c.T ? tok : c.T - 1;
  const int tt = tok & 15;
  const size_t g = (size_t)(c.g0 + tok);
  const f32x4 y = *(const f32x4*)(L + 6 * 1024 + tt * 64 + c.cq4);
  const float mean = sum16((y[0] + y[1]) + (y[2] + y[3])) * (1.f / 64.f);
  const f32x4 d = y - mean;
  const float var = sum16((d[0] * d[0] + d[1] * d[1]) + (d[2] * d[2] + d[3] * d[3])) * (1.f / 64.f);
  f32x4 o = d * rsqrtf(var + 64e-5f) * c.lng + c.lnb + bon;
  o[0] *= gt[0] * sigmoidf_(gt[0]); o[1] *= gt[1] * sigmoidf_(gt[1]); o[2] *= gt[2] * sigmoidf_(gt[2]); o[3] *= gt[3] * sigmoidf_(gt[3]);
  u32x2 w; w.x = cvt_pk(o[0], o[1]); w.y = cvt_pk(o[2], o[3]);
  *(u32x2*)(c.branch + g * BRW + c.C4) = w;
}
struct RwVec { f32x4 r0, r1, w0, w1, k0, k1, a0, a1, b0, b1; float v; };
__device__ __forceinline__ void rw_ldvec(RwVec& x, const float* __restrict__ L, const int t, const int row, const int c0) {
  x.r0 = *(const f32x4*)(L + 0 * 1024 + t * 64 + c0); x.r1 = *(const f32x4*)(L + 0 * 1024 + t * 64 + c0 + 4);
  x.w0 = *(const f32x4*)(L + 1 * 1024 + t * 64 + c0); x.w1 = *(const f32x4*)(L + 1 * 1024 + t * 64 + c0 + 4);
  x.k0 = *(const f32x4*)(L + 2 * 1024 + t * 64 + c0); x.k1 = *(const f32x4*)(L + 2 * 1024 + t * 64 + c0 + 4);
  x.v = L[3 * 1024 + t * 64 + row];
  x.a0 = *(const f32x4*)(L + 4 * 1024 + t * 64 + c0); x.a1 = *(const f32x4*)(L + 4 * 1024 + t * 64 + c0 + 4);
  x.b0 = *(const f32x4*)(L + 5 * 1024 + t * 64 + c0); x.b1 = *(const f32x4*)(L + 5 * 1024 + t * 64 + c0 + 4);
}
template <int NST>
__device__ __forceinline__ void rw_scan(f32x2 (&S)[4], float* __restrict__ L, const int row, const int c0, const int cg) {
  RwVec cur, nxt;
  rw_ldvec(cur, L, 0, row, c0);
  float yp[NST / 2], ra[NST / 2];
  const bool hi = (cg & 4) != 0, b1 = (cg & 2) != 0, b0 = (cg & 1) != 0;
#pragma unroll
  for (int t = 0; t < NST; ++t) {
    if (t + 1 < NST) rw_ldvec(nxt, L, t + 1, row, c0);
    const f32x2 av[4] = {{cur.a0[0], cur.a0[1]}, {cur.a0[2], cur.a0[3]}, {cur.a1[0], cur.a1[1]}, {cur.a1[2], cur.a1[3]}};
    const f32x2 wv[4] = {{cur.w0[0], cur.w0[1]}, {cur.w0[2], cur.w0[3]}, {cur.w1[0], cur.w1[1]}, {cur.w1[2], cur.w1[3]}};
    const f32x2 bv[4] = {{cur.b0[0], cur.b0[1]}, {cur.b0[2], cur.b0[3]}, {cur.b1[0], cur.b1[1]}, {cur.b1[2], cur.b1[3]}};
    const f32x2 kv[4] = {{cur.k0[0], cur.k0[1]}, {cur.k0[2], cur.k0[3]}, {cur.k1[0], cur.k1[1]}, {cur.k1[2], cur.k1[3]}};
    const f32x2 rv[4] = {{cur.r0[0], cur.r0[1]}, {cur.r0[2], cur.r0[3]}, {cur.r1[0], cur.r1[1]}, {cur.r1[2], cur.r1[3]}};
    const f32x2 vi2 = {cur.v, cur.v};
    f32x2 pa = S[0] * av[0] + S[1] * av[1];
    const f32x2 pb = S[2] * av[2] + S[3] * av[3];
    f32x2 n[4];
#pragma unroll
    for (int q = 0; q < 4; ++q) n[q] = S[q] * wv[q] + vi2 * kv[q];
    pa += pb;
    const float sa = sum8(pa[0] + pa[1]);
    const f32x2 sa2 = {sa, sa};
#pragma unroll
    for (int q = 0; q < 4; ++q) S[q] = sa2 * bv[q] + n[q];
    f32x2 ya = S[0] * rv[0] + S[1] * rv[1];
    const f32x2 yb = S[2] * rv[2] + S[3] * rv[3];
    ya += yb;
    if (t < NST / 2) yp[t] = ya[0] + ya[1];
    else { const float lo = yp[t - NST / 2], hv = ya[0] + ya[1]; const float mine = hi ? hv : lo, send = hi ? lo : hv; ra[t - NST / 2] = mine + dppf<0x141>(send); }
    cur = nxt;
  }
  float rb[NST / 4], rc[NST / 8];
#pragma unroll
  for (int k = 0; k < NST / 4; ++k) { const float mine = b1 ? ra[k + NST / 4] : ra[k], send = b1 ? ra[k] : ra[k + NST / 4]; rb[k] = mine + dppf<0x4E>(send); }
#pragma unroll
  for (int k = 0; k < NST / 8; ++k) { const float mine = b0 ? rb[k + NST / 8] : rb[k], send = b0 ? rb[k] : rb[k + NST / 8]; rc[k] = mine + dppf<0xB1>(send); }
  const int base = (hi ? NST / 2 : 0) + (b1 ? NST / 4 : 0) + (b0 ? NST / 8 : 0);
#pragma unroll
  for (int k = 0; k < NST / 8; ++k) L[6 * 1024 + (base + k) * 64 + row] = rc[k];
}

__device__ __forceinline__ void rwkv_unit(const Params& p, const int l, const bool smp, const int b, const int head) {
  extern __shared__ __attribute__((aligned(16))) char smem[];
  float* L0 = (float*)smem;
  float* L1 = L0 + RW_SET;
  RwCtx c;
  const int tid = tidx();
  const int wid = tid >> 6, lane = tid & 63;
  const int j = l >> 1;
  c.proj = (const bfr*)(p.ws + WS_PROJ);
  c.lup = (const bfr*)(p.ws + WS_LUP);
  c.vfsrc = (j == 0) ? c.proj + 2048 : (const bfr*)(p.ws + WS_VFIRST);
  c.vfld = (j == 0) ? INC : DM;
  c.vgoff = (j == 0) ? 1024 : 2048;
  c.vdst = (j == 0) ? (bfr*)(p.ws + WS_VFIRST) : (bfr*)(p.ws + WS_HA + 2 * HA_SZ * 2);
  c.branch = (bfr*)(p.ws + WS_BRANCH);
  c.g0 = smp ? NPR + b * 8 : b * 2048;
  c.T = smp ? 8 : 2048;
  c.tsl = 2 * wid + ((lane >> 4) & 1);
  c.cq4 = (lane & 15) * 4;
  c.C4 = head * 64 + c.cq4;
  const int cg = lane & 7, row = wid * 8 + (lane >> 3), c0 = cg * 8;
  f32x2 S[4];
  if (smp) {
    const float* s0 = pin(p, I_SR) + ((((size_t)j * 128 + b) * 16 + head) * 64 + row) * 64 + c0;
    const float4 a = *(const float4*)s0, bq = *(const float4*)(s0 + 4);
    S[0] = (f32x2){a.x, a.y}; S[1] = (f32x2){a.z, a.w}; S[2] = (f32x2){bq.x, bq.y}; S[3] = (f32x2){bq.z, bq.w};
  } else {
    S[0] = S[1] = S[2] = S[3] = (f32x2){0.f, 0.f};
  }
  c.kkw = *(const f32x4*)(pin(p, I_KK) + j * DM + c.C4); c.kaw = *(const f32x4*)(pin(p, I_KA) + j * DM + c.C4); c.rkw = *(const f32x4*)(pin(p, I_RK) + j * DM + c.C4);
  c.lng = *(const f32x4*)(pin(p, I_LG) + j * DM + c.C4); c.lnb = *(const f32x4*)(pin(p, I_LBI) + j * DM + c.C4);
  RwRaw rawA, rawB;
  f32x4 bonA, bonB, gtA, gtB;
  if (smp) {
    rw_load(rawA, c, 0);
    rw_prep(rawA, bonA, gtA, L0, c, 0);
    LDS_BARRIER();
    rw_scan<8>(S, L0, row, c0, cg);
    LDS_BARRIER();
    rw_post(bonA, gtA, L0, c, 0);
  } else {
    const int ntile = 128;
    rw_load(rawA, c, 0); rw_load(rawB, c, 1);
    rw_prep(rawA, bonA, gtA, L0, c, 0); rw_load(rawA, c, 2);
    LDS_BARRIER();
    rw_scan<16>(S, L0, row, c0, cg); rw_prep(rawB, bonB, gtB, L1, c, 1); rw_load(rawB, c, 3);
    LDS_BARRIER();
    for (int i = 1; i < ntile - 1; i += 2) {
      rw_post(bonA, gtA, L0, c, i - 1); rw_scan<16>(S, L1, row, c0, cg); rw_prep(rawA, bonA, gtA, L0, c, i + 1); rw_load(rawA, c, i + 3);
      LDS_BARRIER();
      rw_post(bonB, gtB, L1, c, i); rw_scan<16>(S, L0, row, c0, cg); rw_prep(rawB, bonB, gtB, L1, c, i + 2); rw_load(rawB, c, i + 4);
      LDS_BARRIER();
    }
    rw_post(bonA, gtA, L0, c, ntile - 2); rw_scan<16>(S, L1, row, c0, cg);
    LDS_BARRIER();
    rw_post(bonB, gtB, L1, c, ntile - 1);
  }
  float* so = p.out + (smp ? O_SRS + ((((size_t)j * 128 + b) * 16 + head) * 64 + row) * 64 + c0 : O_SRP + ((((size_t)j * 8 + b) * 16 + head) * 64 + row) * 64 + c0);
  *(float4*)so = make_float4(S[0][0], S[0][1], S[1][0], S[1][1]); *(float4*)(so + 4) = make_float4(S[2][0], S[2][1], S[3][0], S[3][1]);
  __syncthreads();
}

__device__ __forceinline__ void mix_phase(const Params& p, const int l, const int rep) {
  __shared__ int s_item;
  unsigned* ctr = (unsigned*)(p.ws + WS_CTRL) + l + 4 * rep;
  const bool rw = l & 1;
  const int nP = rw ? 128 : 64, nS = rw ? 2048 : 1024;
  const int nitems = nP + nS + 1024;
  for (;;) {
    __syncthreads();
    if (tidx() == 0) s_item = (int)atomicAdd(ctr, 1u);
    __syncthreads();
    int it = s_item;
    if (rep > 0 && PROBE_SUB == 1) { if (it >= nP) break; }
    if (rep > 0 && PROBE_SUB == 2) { it += nP; if (it >= nP + nS) break; }
    if (rep > 0 && PROBE_SUB == 3) { it += nP + nS; }
    if (it >= nitems) break;
    if (it < nP + nS) {
      const bool smp = it >= nP;
      if (smp) it -= nP;
      if (rw) rwkv_unit(p, l, smp, it >> 4, it & 15); else hgrn_unit(p, l, smp, it >> 3, it & 7);
    } else {
      it -= nP + nS;
      const float* kb; const float* vb; int g0, ntok, head;
      if (it < 512) {
        const int b = it >> 6, blk = it & 15; head = (it >> 4) & 3;
        const size_t off = ((size_t)(l * 8 + b) * 256) * 512 + head * 128;
        kb = p.out + O_MK + off; vb = p.out + O_MV + off; g0 = b * 2048 + blk * 128; ntok = 128;
      } else {
        it -= 512;
        const int b = it >> 2; head = it & 3;
        const size_t off = ((size_t)(l * 128 + b) * 256) * 512 + head * 128;
        kb = pin(p, I_CK) + off; vb = pin(p, I_CV) + off; g0 = NPR + b * 8; ntok = 8;
      }
      xattn_unit(p, kb, vb, g0, ntok, head);
    }
  }
}

#define XB_TMO      128
#define XB_XCNT(j)  (256  + 64 * (j))
#define XB_XSUB(j)  (1280 + 64 * (j))
#define XB_XGEN(j)  (2304 + 64 * (j))
#define XB_TOP      3328
#define XB_TOPGEN   3392
#define XB_SPIN_CAP (1u << 18)
#define XB_LAS __attribute__((address_space(3)))
__device__ __forceinline__ unsigned xb_ld(unsigned* p)              { return __hip_atomic_load(p, __ATOMIC_RELAXED, __HIP_MEMORY_SCOPE_AGENT); }
__device__ __forceinline__ unsigned xb_add(unsigned* p, unsigned v) { return __hip_atomic_fetch_add(p, v, __ATOMIC_RELAXED, __HIP_MEMORY_SCOPE_AGENT); }
__device__ __forceinline__ unsigned xb_xcc_id() { return (unsigned)__builtin_amdgcn_s_getreg((3 << 11) | 20) & 0xFu; }
#define XB_SPIN(cond, bar) do { unsigned _sp = 0; while (cond) { __builtin_amdgcn_s_sleep(1); \
    if ((++_sp & 255u) == 0u) { if (xb_ld(&(bar)[XB_TMO])) break; if (_sp > XB_SPIN_CAP) { atomicAdd(&(bar)[XB_TMO], 1u); break; } } } } while (0)
__device__ __forceinline__ void xcd_barrier_complete(unsigned* bar, unsigned x, unsigned& nloc, unsigned& nx) {
  const unsigned G = gridDim.x;
  unsigned sum, cnt, mine, sp = 0u;
  for (;;) {
    sum = 0u; cnt = 0u; mine = 0u;
#pragma unroll
    for (unsigned j = 0; j < 16; ++j) { const unsigned c = xb_ld(&bar[XB_XCNT(j)]); sum += c; cnt += (c > 0u) ? 1u : 0u; mine = (j == x) ? c : mine; }
    if (sum == G) break;
    __builtin_amdgcn_s_sleep(1);
    if ((++sp & 255u) == 0u) { if (xb_ld(&bar[XB_TMO])) break; if (sp > XB_SPIN_CAP) { atomicAdd(&bar[XB_TMO], 1u); break; } }
  }
  nloc = mine > 0u ? mine : 1u; nx = cnt > 0u ? cnt : 1u;
}
__device__ __forceinline__ void grid_barrier(unsigned* bar, volatile XB_LAS unsigned* st) {
  asm volatile("s_waitcnt vmcnt(0)" ::: "memory");
  __syncthreads();
  if (threadIdx.x == 0) {
    const unsigned x = xb_xcc_id();
    __builtin_amdgcn_s_waitcnt(0);
    unsigned nloc = st[0], nx = st[1];
    if (nloc == 0u) { xcd_barrier_complete(bar, x, nloc, nx); st[0] = nloc; st[1] = nx; }
    const unsigned old = xb_add(&bar[XB_XSUB(x)], 1u);
    const unsigned gen = old / nloc;
    if (old + 1u == (gen + 1u) * nloc) {
      __builtin_amdgcn_fence(__ATOMIC_RELEASE, "agent");
      asm volatile("s_waitcnt vmcnt(0)" ::: "memory");
      const unsigned og = xb_add(&bar[XB_TOP], 1u);
      const unsigned tg = og / nx;
      if (og + 1u == (tg + 1u) * nx) xb_add(&bar[XB_TOPGEN], 1u);
      else XB_SPIN(xb_ld(&bar[XB_TOPGEN]) == tg, bar);
      __builtin_amdgcn_fence(__ATOMIC_ACQUIRE, "agent");
      xb_add(&bar[XB_XGEN(x)], 1u);
      asm volatile("s_waitcnt vmcnt(0)" ::: "memory");
    } else {
      XB_SPIN(xb_ld(&bar[XB_XGEN(x)]) == gen, bar);
      __builtin_amdgcn_fence(__ATOMIC_ACQUIRE, "agent");
      asm volatile("s_waitcnt vmcnt(0)" ::: "memory");
    }
  }
  __syncthreads();
}
__device__ __forceinline__ void run_phase(const Params& p, const int ph, const int rep) {
  int code;
  switch (ph) {
    case 0: code = 0; break;
    case 1: code = 1 | (0 << 4) | (0 << 8); break;
    case 2: code = 2 | (0 << 8); break;
    case 3: code = 1 | (2 << 4) | (0 << 8); break;
    case 4: code = 3 | (1 << 8); break;
    case 5: code = 1 | (0 << 4) | (1 << 8); break;
    case 6: code = 1 | (1 << 4) | (1 << 8); break;
    case 7: code = 2 | (1 << 8); break;
    case 8: code = 1 | (2 << 4) | (1 << 8); break;
    case 9: code = 3 | (2 << 8); break;
    case 10: code = 1 | (0 << 4) | (2 << 8); break;
    case 11: code = 2 | (2 << 8); break;
    case 12: code = 1 | (2 << 4) | (2 << 8); break;
    case 13: code = 3 | (3 << 8); break;
    case 14: code = 1 | (0 << 4) | (3 << 8); break;
    case 15: code = 1 | (1 << 4) | (3 << 8); break;
    case 16: code = 2 | (3 << 8); break;
    case 17: code = 1 | (2 << 4) | (3 << 8); break;
    default: code = 4; break;
  }
  const int type = code & 15, kind = (code >> 4) & 15, l = code >> 8;
  if (type == 0) prologue(p);
  else if (type == 1) gemm_phase(p, kind, l);
  else if (type == 2) mix_phase(p, l, rep);
  else if (type == 3) prep_phase(p, l);
  else final_phase(p);
}
constexpr int NPHASE = 19;

__global__ void __launch_bounds__(512) mega(Params p) {
  __shared__ uint4 xb_words;
  if (threadIdx.x == 0) {
    xb_words = make_uint4(0u, 0u, 0u, 0u);
    (void)xb_add(&((unsigned*)(p.ws + WS_XBAR))[XB_XCNT(xb_xcc_id())], 1u);
  }
  __syncthreads();
  for (int ph = p.ph_lo; ph <= p.ph_hi; ++ph) {
    const int nrep = ((PROBE_MASK >> ph) & 1u) ? 2 : 1;
    for (int rep = 0; rep < nrep; ++rep) {
      run_phase(p, ph, rep);
      if (ph < p.ph_hi || rep + 1 < nrep) {
        if (p.ph_hi < 0) cg::this_grid().sync();
        grid_barrier((unsigned*)(p.ws + WS_XBAR), (volatile XB_LAS unsigned*)&xb_words);
      }
    }
  }
}

extern "C" void kernel_launch(void* const* d_in, const int* in_sizes, int n_in, void* d_out, int out_size, void* d_ws, size_t ws_size,
                              hipStream_t stream) {
  static int grid = 0;
  if (grid == 0) {
    if (n_in != 31 || ws_size < WS_END) { fprintf(stderr, "kernel_launch: unexpected n_in %d / ws %zu (need %zu)\n", n_in, ws_size, (size_t)WS_END); grid = -1; return; }
    int dev = 0, cus = 0, per_cu = 0;
    hipGetDevice(&dev);
    hipDeviceGetAttribute(&cus, hipDeviceAttributeMultiprocessorCount, dev);
    if (hipFuncSetAttribute((const void*)mega, hipFuncAttributeMaxDynamicSharedMemorySize, LDS_BYTES) != hipSuccess) { fprintf(stderr, "hipFuncSetAttribute failed\n"); grid = -1; return; }
    hipOccupancyMaxActiveBlocksPerMultiprocessor(&per_cu, (const void*)mega, 512, LDS_BYTES);
    if (per_cu < 1) { fprintf(stderr, "occupancy query says %d blocks/CU\n", per_cu); per_cu = 1; }
    (void)hipGetLastError();
    grid = cus * per_cu;
  }
  if (grid < 0) return;
  Params p{};
  for (int i = 0; i < 31; ++i) p.in[i] = (const float*)d_in[i];
  p.out = (float*)d_out; p.ws = (char*)d_ws;
  if (hipMemsetAsync((char*)d_ws + WS_CTRL, 0, 4096 + 16384, stream) != hipSuccess) { fprintf(stderr, "kernel_launch: control-word memset failed\n"); return; }
#if COOP
  p.ph_lo = 0; p.ph_hi = NPHASE - 1;
  void* args[] = {&p};
  hipError_t e = hipLaunchCooperativeKernel((const void*)mega, dim3(grid), dim3(512), args, LDS_BYTES, stream);
  if (e != hipSuccess) fprintf(stderr, "cooperative launch failed: %s (grid %d)\n", hipGetErrorString(e), grid);
#else
  for (int ph = 0; ph < NPHASE; ++ph) {
    p.ph_lo = ph; p.ph_hi = ph;
    hipLaunchKernelGGL(mega, dim3(grid), dim3(512), LDS_BYTES, stream, p);
  }
#endif
}
```

```cpp
#include <hip/hip_runtime.h>
#include <hip/hip_cooperative_groups.h>
#include <cstdio>
#include <cstdint>
namespace cg = cooperative_groups;

#ifndef COOP
#define COOP 1
#endif
#ifndef PROBE_SUB
#define PROBE_SUB 0
#endif
#ifndef PROBE_MASK
#define PROBE_MASK 0u
#endif

typedef unsigned short bfr;
typedef short bf16x8 __attribute__((ext_vector_type(8)));
typedef short bf16x4 __attribute__((ext_vector_type(4)));
typedef float f32x4 __attribute__((ext_vector_type(4)));
typedef unsigned u32x2 __attribute__((ext_vector_type(2)));
typedef unsigned u32x4 __attribute__((ext_vector_type(4)));

constexpr int NTOK = 17408, NPR = 16384, DM = 1024, INC = 5120, BRW = 1536;
constexpr int LDS_BYTES = 139264;
constexpr size_t O_YP = 0, O_SHP = 17825792, O_SRP = 19922944, O_SSP = 20971520, O_MK = 20987904, O_MV = 25182208,
                 O_SHS = 29376512, O_SRS = 62930944, O_SSS = 79708160;
constexpr size_t WS_CTRL = 0;
constexpr size_t WS_XBAR = 4096;
constexpr size_t WS_WTIN = 4096 + 16384;
constexpr size_t WTIN_L = (size_t)5888 * 1024;
constexpr size_t WS_WTOUT = WS_WTIN + 4 * WTIN_L * 2;
constexpr size_t WS_WTMEM = WS_WTOUT + (size_t)4 * 1024 * 1536 * 2;
constexpr size_t WS_W2T = WS_WTMEM + (size_t)4 * 1024 * 1024 * 2;
constexpr size_t WS_MEMN = WS_W2T + (size_t)2 * 3072 * 256 * 2;
constexpr size_t WS_XRES = WS_MEMN + (size_t)4 * 2048 * 1024 * 2;
constexpr size_t HA_SZ = (size_t)NTOK * 1024;
constexpr size_t WS_HA = WS_XRES + (size_t)NTOK * 1024 * 4;
constexpr size_t WS_PROJ = WS_HA + 6 * HA_SZ * 2;
constexpr size_t WS_ALORA = WS_PROJ + (size_t)NTOK * INC * 2;
constexpr size_t WS_LUP = WS_ALORA + (size_t)NTOK * 256 * 2;
constexpr size_t WS_VFIRST = WS_LUP + (size_t)NTOK * 3072 * 2;
constexpr size_t WS_BRANCH = WS_VFIRST + HA_SZ * 2;
constexpr size_t WS_PART = WS_BRANCH + (size_t)NTOK * BRW * 2;
constexpr size_t WS_END = WS_PART + (size_t)5 * 1024 * 1024 * 4;

struct Params {
  const float* in[31];
  float* out;
  char* ws;
  int ph_lo, ph_hi;
};
enum { I_XP = 0, I_XS, I_MEM, I_SH, I_SR, I_SS, I_CK, I_CV, I_NG, I_WIN, I_WOUT, I_MNG, I_WMEM, I_LB, I_ONG, I_MU, I_W0, I_W1, I_W2,
       I_A0, I_A1, I_A2, I_V0, I_V1, I_V2, I_KK, I_KA, I_RK, I_LG, I_LBI, I_FG };

__device__ __forceinline__ unsigned cvt_pk(float lo, float hi) { unsigned r; asm("v_cvt_pk_bf16_f32 %0, %1, %2" : "=v"(r) : "v"(lo), "v"(hi)); return r; }
__device__ __forceinline__ bfr f2bf(float f) { return (bfr)(cvt_pk(f, 0.f) & 0xffff); }
__device__ __forceinline__ float bf2f(unsigned h) { return __uint_as_float(h << 16); }
__device__ __forceinline__ float bflo(unsigned w) { return __uint_as_float(w << 16); }
__device__ __forceinline__ float bfhi(unsigned w) { return __uint_as_float(w & 0xffff0000u); }
__device__ __forceinline__ float frcp(float x) { return __builtin_amdgcn_rcpf(x); }
__device__ __forceinline__ float sigmoidf_(float x) { return frcp(1.f + __expf(-x)); }
template <int CTRL> __device__ __forceinline__ float dppf(float x) {
  return __builtin_bit_cast(float, __builtin_amdgcn_update_dpp(0, __builtin_bit_cast(int, x), CTRL, 0xf, 0xf, true));
}
__device__ __forceinline__ float wave_sum(float v) {
  v += dppf<0xB1>(v); v += dppf<0x4E>(v); v += dppf<0x141>(v); v += dppf<0x140>(v);
  const int iv = __builtin_bit_cast(int, v);
  float r = __builtin_bit_cast(float, __builtin_amdgcn_readlane(iv, 0));
  r += __builtin_bit_cast(float, __builtin_amdgcn_readlane(iv, 16));
  r += __builtin_bit_cast(float, __builtin_amdgcn_readlane(iv, 32));
  r += __builtin_bit_cast(float, __builtin_amdgcn_readlane(iv, 48));
  return r;
}
__device__ __forceinline__ float bperm(float v, int srclane) { return __builtin_bit_cast(float, __builtin_amdgcn_ds_bpermute(srclane << 2, __builtin_bit_cast(int, v))); }
__device__ __forceinline__ float sum8(float v) {
  v += dppf<0xB1>(v);
  v += dppf<0x4E>(v);
  v += dppf<0x141>(v);
  return v;
}
__device__ __forceinline__ const float* pin(const Params& p, int i) { asm volatile("" : "+s"(i)); return p.in[i]; }
__device__ __forceinline__ const float* xin_row(const Params& p, int g) {
  return g < NPR ? pin(p, I_XP) + (size_t)g * DM : pin(p, I_XS) + (size_t)(g - NPR) * DM;
}

__device__ __forceinline__ int tidx() { int t = threadIdx.x; asm volatile("" : "+v"(t)); return t; }
__device__ __forceinline__ int bidx() { int b = blockIdx.x; asm volatile("" : "+s"(b)); return b; }
__device__ __forceinline__ int wperm(int n) { const int c = n & 31; return (n & ~31) + ((c >> 2) & 1) * 16 + (c >> 3) * 4 + (c & 3); }

__device__ __forceinline__ void transpose_job(const float* __restrict__ src, int Ks, int Ns, bfr* __restrict__ dst, int ldd, int rot) {
  extern __shared__ __attribute__((aligned(16))) char smem[];
  bfr* T = (bfr*)smem;
  const int tid = tidx();
  const int tn = Ns >> 6, ntile = (Ks >> 6) * tn;
  const int G = gridDim.x;
  for (int tile = (bidx() + rot) % G; tile < ntile; tile += G) {
    const int k0 = (tile / tn) << 6, n0 = (tile % tn) << 6;
    const int kl = tid >> 3, nc = (tid & 7) << 3;
    const float* s = src + (size_t)(k0 + kl) * Ns + n0 + nc;
    const float4 a = *(const float4*)s, b = *(const float4*)(s + 4);
    __syncthreads();
    T[(nc + 0) * 72 + kl] = f2bf(a.x); T[(nc + 1) * 72 + kl] = f2bf(a.y); T[(nc + 2) * 72 + kl] = f2bf(a.z); T[(nc + 3) * 72 + kl] = f2bf(a.w);
    T[(nc + 4) * 72 + kl] = f2bf(b.x); T[(nc + 5) * 72 + kl] = f2bf(b.y); T[(nc + 6) * 72 + kl] = f2bf(b.z); T[(nc + 7) * 72 + kl] = f2bf(b.w);
    __syncthreads();
    const int nl = tid >> 3, kc = (tid & 7) << 3;
    const u32x4 v = *(const u32x4*)(T + nl * 72 + kc);
    *(u32x4*)(dst + (size_t)wperm(n0 + nl) * ldd + k0 + kc) = v;
  }
}

__device__ __forceinline__ void prologue(const Params& p) {
  const int tid = tidx(), wid = tid >> 6, lane = tid & 63;
  const int G = gridDim.x;
  char* ws = p.ws;
  int rot = 0;
  for (int l = 0; l < 4; ++l) {
    transpose_job(pin(p, I_WIN) + (size_t)l * DM * INC, DM, INC, (bfr*)(ws + WS_WTIN) + l * WTIN_L, DM, rot); rot = (rot + G - (1280 % G)) % G;
    transpose_job(pin(p, I_WOUT) + (size_t)l * BRW * DM, BRW, DM, (bfr*)(ws + WS_WTOUT) + (size_t)l * DM * BRW, BRW, rot); rot = (rot + G - (384 % G)) % G;
    transpose_job(pin(p, I_WMEM) + (size_t)l * DM * DM, DM, DM, (bfr*)(ws + WS_WTMEM) + (size_t)l * DM * DM, DM, rot); rot = (rot + G - (256 % G)) % G;
  }
  const int gt = bidx() * 512 + tid, nth = G * 512;
  for (int j = 0; j < 2; ++j) {
    bfr* dst = (bfr*)(ws + WS_WTIN) + (size_t)(2 * j + 1) * WTIN_L + (size_t)5120 * 1024;
    const float* w1 = pin(p, I_W1) + (size_t)j * 1024 * 64;
    const float* a1 = pin(p, I_A1) + (size_t)j * 1024 * 64;
    const float* v1 = pin(p, I_V1);
    for (int it = gt; it < 768 * 128; it += nth) {
      const int n = it % 768, kc = it / 768;
      const int seg = n >> 8, c = n & 255;
      float v[8];
#pragma unroll
      for (int e = 0; e < 8; ++e) {
        const int k = kc * 8 + e;
        float x = 0.f;
        if (seg == 0) { if (c < 64) x = w1[k * 64 + c]; }
        else if (seg == 1) { if (c < 64) x = a1[k * 64 + c]; }
        else { if (j == 1 && c < 32) x = v1[k * 32 + c]; }
        v[e] = x;
      }
      u32x4 o; o.x = cvt_pk(v[0], v[1]); o.y = cvt_pk(v[2], v[3]); o.z = cvt_pk(v[4], v[5]); o.w = cvt_pk(v[6], v[7]);
      *(u32x4*)(dst + (size_t)wperm(n) * 1024 + kc * 8) = o;
    }
    bfr* d2 = (bfr*)(ws + WS_W2T) + (size_t)j * 3072 * 256;
    const float* w2 = pin(p, I_W2) + (size_t)j * 64 * 1024;
    const float* a2 = pin(p, I_A2) + (size_t)j * 64 * 1024;
    const float* v2 = pin(p, I_V2);
    for (int it = gt; it < 3072 * 32; it += nth) {
      const int n = it % 3072, kc = it / 3072;
      const int seg = n >> 10, c = n & 1023;
      float v[8];
#pragma unroll
      for (int e = 0; e < 8; ++e) {
        const int k = kc * 8 + e;
        float x = 0.f;
        if (seg == 0) { if (k < 64) x = w2[k * 1024 + c]; }
        else if (seg == 1) { if (k >= 64 && k < 128) x = a2[(k - 64) * 1024 + c]; }
        else { if (j == 1 && k >= 128 && k < 160) x = v2[(k - 128) * 1024 + c]; }
        v[e] = x;
      }
      u32x4 o; o.x = cvt_pk(v[0], v[1]); o.y = cvt_pk(v[2], v[3]); o.z = cvt_pk(v[4], v[5]); o.w = cvt_pk(v[6], v[7]);
      *(u32x4*)(d2 + (size_t)wperm(n) * 256 + kc * 8) = o;
    }
  }
  const int gw = bidx() * 8 + wid, nw = G * 8;
  for (int row = gw; row < 2048 + NTOK; row += nw) {
    const bool ismem = row < 2048;
    const float* src = ismem ? pin(p, I_MEM) + (size_t)row * DM : xin_row(p, row - 2048);
    float4 x[4]; float ss = 0.f;
#pragma unroll
    for (int i = 0; i < 4; ++i) { x[i] = *(const float4*)(src + lane * 4 + i * 256); ss += x[i].x * x[i].x + x[i].y * x[i].y + x[i].z * x[i].z + x[i].w * x[i].w; }
    ss = wave_sum(ss);
    const float rs = rsqrtf(ss * (1.f / 1024.f) + 1e-6f);
    if (ismem) {
      for (int l = 0; l < 4; ++l) {
        bfr* dst = (bfr*)(ws + WS_MEMN) + ((size_t)l * 2048 + row) * DM;
#pragma unroll
        for (int i = 0; i < 4; ++i) {
          const float4 g = *(const float4*)(pin(p, I_MNG) + l * DM + lane * 4 + i * 256);
          u32x2 o; o.x = cvt_pk(x[i].x * rs * g.x, x[i].y * rs * g.y); o.y = cvt_pk(x[i].z * rs * g.z, x[i].w * rs * g.w);
          *(u32x2*)(dst + lane * 4 + i * 256) = o;
        }
      }
    } else {
      float* xr = (float*)(ws + WS_XRES) + (size_t)(row - 2048) * DM;
#pragma unroll
      for (int i = 0; i < 4; ++i) *(float4*)(xr + lane * 4 + i * 256) = x[i];
      bfr* dst = (bfr*)(ws + WS_HA) + (size_t)(row - 2048) * DM;
#pragma unroll
      for (int i = 0; i < 4; ++i) {
        const float4 g = *(const float4*)(pin(p, I_NG) + lane * 4 + i * 256);
        u32x2 o; o.x = cvt_pk(x[i].x * rs * g.x, x[i].y * rs * g.y); o.y = cvt_pk(x[i].z * rs * g.z, x[i].w * rs * g.w);
        *(u32x2*)(dst + lane * 4 + i * 256) = o;
      }
    }
  }
}

__device__ __forceinline__ void load_xrow(const Params& p, const int g, const int lane, float4 (&x)[4]) {
  const float* s = (const float*)(p.ws + WS_XRES) + (size_t)g * DM;
#pragma unroll
  for (int i = 0; i < 4; ++i) x[i] = *(const float4*)(s + lane * 4 + i * 256);
  if (g >= NPR) {
#pragma unroll
    for (int k = 0; k < 5; ++k) {
      const float* q = (const float*)(p.ws + WS_PART) + ((size_t)k * 1024 + (g - NPR)) * DM;
#pragma unroll
      for (int i = 0; i < 4; ++i) { const float4 t = *(const float4*)(q + lane * 4 + i * 256); x[i].x += t.x; x[i].y += t.y; x[i].z += t.z; x[i].w += t.w; }
    }
  }
}
__device__ __forceinline__ void prep_phase(const Params& p, int l) {
  const int tid = tidx(), wid = tid >> 6, lane = tid & 63;
  const bool rw = (l & 1);
  const int j = l >> 1;
  const float* xres = (const float*)(p.ws + WS_XRES);
  bfr* hA = (bfr*)(p.ws + WS_HA);
  const float* ng = pin(p, I_NG) + l * DM;
  const float* mu = pin(p, I_MU) + (size_t)j * 5 * DM;
  const int gw = bidx() * 8 + wid, nw = gridDim.x * 8;
  constexpr int NCH = 1920;
  for (int task = gw; task < NCH + 128; task += nw) {
    const bool smpt = (task & 15) == 15;
    const int ch = task - ((task + 1) >> 4);
    const int g0 = smpt ? NPR + (task >> 4) * 8 : (int)(((long)ch * NPR) / NCH);
    const int nrows = smpt ? 8 : (int)(((long)(ch + 1) * NPR) / NCH) - g0;
    float hp[16];
    if (rw) {
      const bool smp = g0 >= NPR;
      const int t0 = smp ? ((g0 - NPR) & 7) : (g0 & 2047);
      if (t0 == 0) {
        if (smp) {
          const float* s = pin(p, I_SS) + ((size_t)j * 128 + ((g0 - NPR) >> 3)) * DM;
#pragma unroll
          for (int i = 0; i < 4; ++i) { const float4 v = *(const float4*)(s + lane * 4 + i * 256); hp[i * 4] = v.x; hp[i * 4 + 1] = v.y; hp[i * 4 + 2] = v.z; hp[i * 4 + 3] = v.w; }
        } else {
#pragma unroll
          for (int i = 0; i < 16; ++i) hp[i] = 0.f;
        }
      } else {
        float4 x[4]; float ss = 0.f;
        load_xrow(p, g0 - 1, lane, x);
#pragma unroll
        for (int i = 0; i < 4; ++i) ss += x[i].x * x[i].x + x[i].y * x[i].y + x[i].z * x[i].z + x[i].w * x[i].w;
        ss = wave_sum(ss);
        const float rs = rsqrtf(ss * (1.f / 1024.f) + 1e-6f);
#pragma unroll
        for (int i = 0; i < 4; ++i) {
          const float4 g = *(const float4*)(ng + lane * 4 + i * 256);
          hp[i * 4] = x[i].x * rs * g.x; hp[i * 4 + 1] = x[i].y * rs * g.y; hp[i * 4 + 2] = x[i].z * rs * g.z; hp[i * 4 + 3] = x[i].w * rs * g.w;
        }
      }
    }
    for (int r = 0; r < nrows; ++r) {
      const int g = g0 + r;
      if (rw && r > 0 && g < NPR && (g & 2047) == 0) {
#pragma unroll
        for (int i = 0; i < 16; ++i) hp[i] = 0.f;
      }
      float4 x[4]; float ss = 0.f;
      load_xrow(p, g, lane, x);
      if (g >= NPR) {
        float* xw = (float*)(p.ws + WS_XRES) + (size_t)g * DM;
#pragma unroll
        for (int i = 0; i < 4; ++i) *(float4*)(xw + lane * 4 + i * 256) = x[i];
      }
#pragma unroll
      for (int i = 0; i < 4; ++i) ss += x[i].x * x[i].x + x[i].y * x[i].y + x[i].z * x[i].z + x[i].w * x[i].w;
      ss = wave_sum(ss);
      const float rs = rsqrtf(ss * (1.f / 1024.f) + 1e-6f);
      float h[16];
#pragma unroll
      for (int i = 0; i < 4; ++i) {
        const float4 gg = *(const float4*)(ng + lane * 4 + i * 256);
        h[i * 4] = x[i].x * rs * gg.x; h[i * 4 + 1] = x[i].y * rs * gg.y; h[i * 4 + 2] = x[i].z * rs * gg.z; h[i * 4 + 3] = x[i].w * rs * gg.w;
        u32x2 o; o.x = cvt_pk(h[i * 4], h[i * 4 + 1]); o.y = cvt_pk(h[i * 4 + 2], h[i * 4 + 3]);
        *(u32x2*)(hA + (size_t)g * DM + lane * 4 + i * 256) = o;
      }
      if (rw) {
#pragma unroll
        for (int m = 0; m < 5; ++m) {
          bfr* dst = hA + (size_t)(1 + m) * HA_SZ + (size_t)g * DM;
#pragma unroll
          for (int i = 0; i < 4; ++i) {
            const float4 mm = *(const float4*)(mu + m * DM + lane * 4 + i * 256);
            const float a0 = h[i * 4] + (hp[i * 4] - h[i * 4]) * mm.x, a1 = h[i * 4 + 1] + (hp[i * 4 + 1] - h[i * 4 + 1]) * mm.y;
            const float a2 = h[i * 4 + 2] + (hp[i * 4 + 2] - h[i * 4 + 2]) * mm.z, a3 = h[i * 4 + 3] + (hp[i * 4 + 3] - h[i * 4 + 3]) * mm.w;
            u32x2 o; o.x = cvt_pk(a0, a1); o.y = cvt_pk(a2, a3);
            *(u32x2*)(dst + lane * 4 + i * 256) = o;
          }
        }
        const bool smp = g >= NPR;
        const int t = smp ? ((g - NPR) & 7) : (g & 2047);
        if (t == (smp ? 7 : 2047)) {
          float* o = p.out + (smp ? O_SSS + ((size_t)j * 128 + ((g - NPR) >> 3)) * DM : O_SSP + ((size_t)j * 8 + (g >> 11)) * DM);
#pragma unroll
          for (int i = 0; i < 4; ++i) *(float4*)(o + lane * 4 + i * 256) = make_float4(h[i * 4], h[i * 4 + 1], h[i * 4 + 2], h[i * 4 + 3]);
        }
#pragma unroll
        for (int i = 0; i < 16; ++i) hp[i] = h[i];
      }
    }
  }
}

__device__ __forceinline__ void final_phase(const Params& p) {
  const int tid = tidx(), wid = tid >> 6, lane = tid & 63;
  const float* xres = (const float*)(p.ws + WS_XRES);
  const float* fg = pin(p, I_FG);
  const int gw = bidx() * 8 + wid, nw = gridDim.x * 8;
  for (int g = gw; g < NTOK; g += nw) {
    float4 x[4]; float ss = 0.f;
    load_xrow(p, g, lane, x);
#pragma unroll
    for (int i = 0; i < 4; ++i) ss += x[i].x * x[i].x + x[i].y * x[i].y + x[i].z * x[i].z + x[i].w * x[i].w;
    ss = wave_sum(ss);
    const float rs = rsqrtf(ss * (1.f / 1024.f) + 1e-6f);
    float* o = p.out + O_YP + (size_t)g * DM;
#pragma unroll
    for (int i = 0; i < 4; ++i) {
      const float4 gg = *(const float4*)(fg + lane * 4 + i * 256);
      *(float4*)(o + lane * 4 + i * 256) = make_float4(x[i].x * rs * gg.x, x[i].y * rs * gg.y, x[i].z * rs * gg.z, x[i].w * rs * gg.w);
    }
  }
}

constexpr int BM = 256, BK = 64, HALF = 128, HT = HALF * BK;
__device__ __forceinline__ int lds_byte(int r, int c) {
  int st = (r >> 4) * 2 + (c >> 5), rr = r & 15, cc = c & 31, ob = rr * 64 + cc * 2;
  return st * 1024 + (ob ^ (((ob >> 9) & 1) << 5));
}
__device__ __forceinline__ void stage_rc(int b, int& R, int& C) {
  int st = b / 1024, sb = b % 1024, swz = sb ^ (((sb >> 9) & 1) << 5);
  R = (st >> 1) * 16 + swz / 64; C = (st & 1) * 32 + (swz % 64) / 2;
}

enum { EM_PROJ = 0, EM_G1R, EM_MEM, EM_LUP, EM_OUT, EM_OUTA };

__device__ __forceinline__ void epilogue(const Params& p, const int mode, const int l, const f32x4 (&acc)[2][2][4][2],
                                         const int pm, const int pn, const int wr, const int wc, const int fr, const int fq) {
  const int j = (l & 255) >> 1;
#pragma unroll
  for (int ai = 0; ai < 2; ++ai)
#pragma unroll
    for (int m = 0; m < 4; ++m) {
      const int row = pm * BM + ai * HALF + wr * 64 + m * 16 + fr;
#pragma unroll
      for (int bj = 0; bj < 2; ++bj)
#pragma unroll
        for (int n = 0; n < 2; ++n) {
          const int col = pn * BM + bj * HALF + wc * 32 + fq * 8 + n * 4;
          const f32x4 v = acc[ai][bj][m][n];
          if (mode == EM_PROJ || (mode == EM_G1R && pn < 20)) {
            if (n == 0) {
              const f32x4 v1 = acc[ai][bj][m][1];
              u32x4 o; o.x = cvt_pk(v[0], v[1]); o.y = cvt_pk(v[2], v[3]); o.z = cvt_pk(v1[0], v1[1]); o.w = cvt_pk(v1[2], v1[3]);
              *(u32x4*)((bfr*)(p.ws + WS_PROJ) + (size_t)row * INC + col) = o;
            }
          } else if (mode == EM_G1R) {
            bfr* al = (bfr*)(p.ws + WS_ALORA) + (size_t)row * 256;
            const int c = col & 255;
            if (pn == 20) {
              if (c < 64) {
                float t[4];
#pragma unroll
                for (int e = 0; e < 4; ++e) { const float ex = __expf(2.f * v[e]); t[e] = 1.f - 2.f * frcp(ex + 1.f); }
                u32x2 o; o.x = cvt_pk(t[0], t[1]); o.y = cvt_pk(t[2], t[3]);
                *(u32x2*)(al + c) = o;
              }
            } else if (pn == 21) {
              const int lim = (l == 3) ? 128 : 256;
              if (64 + c < lim) {
                u32x2 o; o.x = 0u; o.y = 0u;
                if (c < 64) { o.x = cvt_pk(v[0], v[1]); o.y = cvt_pk(v[2], v[3]); }
                *(u32x2*)(al + 64 + c) = o;
              }
            } else {
              if (128 + c < 256) {
                u32x2 o; o.x = 0u; o.y = 0u;
                if (c < 32) { o.x = cvt_pk(v[0], v[1]); o.y = cvt_pk(v[2], v[3]); }
                *(u32x2*)(al + 128 + c) = o;
              }
            }
          } else if (mode == EM_MEM) {
            const int lm = pm >> 3, r2 = row & 2047;
            float* o = p.out + (col < 512 ? O_MK : O_MV) + ((size_t)lm * 2048 + r2) * 512 + (col & 511);
            *(f32x4*)o = v;
          } else if (mode == EM_LUP) {
            const int seg = col >> 10, c = col & 1023;
            float t[4];
            if (seg == 0) {
              const float4 b = *(const float4*)(pin(p, I_W0) + j * DM + c);
              const float bb[4] = {b.x, b.y, b.z, b.w};
#pragma unroll
              for (int e = 0; e < 4; ++e) {
                const float x = bb[e] + v[e];
                t[e] = -0.6065306597126334f * sigmoidf_(x);
              }
            } else if (seg == 1) {
              const float4 b = *(const float4*)(pin(p, I_A0) + j * DM + c);
              t[0] = sigmoidf_(b.x + v[0]); t[1] = sigmoidf_(b.y + v[1]); t[2] = sigmoidf_(b.z + v[2]); t[3] = sigmoidf_(b.w + v[3]);
            } else {
              const float4 b = *(const float4*)(pin(p, I_V0) + c);
              t[0] = sigmoidf_(b.x + v[0]); t[1] = sigmoidf_(b.y + v[1]); t[2] = sigmoidf_(b.z + v[2]); t[3] = sigmoidf_(b.w + v[3]);
            }
            u32x2 o; o.x = cvt_pk(t[0], t[1]); o.y = cvt_pk(t[2], t[3]);
            *(u32x2*)((bfr*)(p.ws + WS_LUP) + (size_t)row * 3072 + col) = o;
          } else if (mode == EM_OUT) {
            float* xo = (float*)(p.ws + WS_XRES) + (size_t)row * DM + col;
            const f32x4 x = *(const f32x4*)xo;
            *(f32x4*)xo = x + v;
          } else {
            *(f32x4*)((float*)(p.ws + WS_PART) + ((size_t)((l >> 8) - 1) * 1024 + (row - NPR)) * DM + col) = v;
          }
        }
    }
}

__device__ __forceinline__ void gemm_unit(const Params& p, const bfr* __restrict__ A, const bfr* __restrict__ Bt, const int K, const int kt0, const int nt,
                                          const int pm, const int pn, const int mode, const int l) {
  extern __shared__ __attribute__((aligned(16))) char smem[];
  bfr* shm = (bfr*)smem;
#define SA(b, h) (shm + ((b) * 2 + (h)) * HT)
#define SB(b, h) (shm + (4 + (b) * 2 + (h)) * HT)
#define STAGE(P, BASE, br, kt) do { const bfr* _g = (BASE) + (size_t)(br) * K + (kt0 + (kt)) * BK + goff; \
    __builtin_amdgcn_global_load_lds((const unsigned*)_g, (unsigned*)((char*)(P) + tid * 16), 16, 0, 0); \
    __builtin_amdgcn_global_load_lds((const unsigned*)(_g + (size_t)64 * K), (unsigned*)((char*)(P) + tid * 16 + 8192), 16, 0, 0); } while (0)
#define LDA(dst, b, h) for (int m = 0; m < 4; ++m) for (int k = 0; k < 2; ++k) \
    dst[m][k] = *reinterpret_cast<const bf16x8*>((char*)SA(b, h) + lds_byte(wr * 64 + m * 16 + fr, k * 32 + fq * 8))
#define LDB(dst, b, h) for (int n = 0; n < 2; ++n) for (int k = 0; k < 2; ++k) \
    dst[n][k] = *reinterpret_cast<const bf16x8*>((char*)SB(b, h) + lds_byte(wc * 32 + n * 16 + fr, k * 32 + fq * 8))
#define MMA(ai, bj, At, Bt_) do { __builtin_amdgcn_s_setprio(1); \
    for (int m = 0; m < 4; ++m) for (int n = 0; n < 2; ++n) for (int k = 0; k < 2; ++k) \
      acc[ai][bj][m][n] = __builtin_amdgcn_mfma_f32_16x16x32_bf16(Bt_[n][k], At[m][k], acc[ai][bj][m][n], 0, 0, 0); \
    __builtin_amdgcn_s_setprio(0); } while (0)
#define WAIT_V(n) asm volatile("s_waitcnt vmcnt(" #n ")" ::: "memory")
#define WAIT_L(n) asm volatile("s_waitcnt lgkmcnt(" #n ")" ::: "memory")
#define BAR __builtin_amdgcn_s_barrier()
#define SCHED __builtin_amdgcn_sched_barrier(0)
  const int tid = tidx();
  const int brow = pm * BM, bcol = pn * BM;
  const int wid = tid >> 6, lane = tid & 63, wr = wid >> 2, wc = wid & 3, fr = lane & 15, fq = lane >> 4;
  int R0, C0; stage_rc(tid * 16, R0, C0);
  const int goff = R0 * K + C0;
  f32x4 acc[2][2][4][2] = {};
  bf16x8 At[4][2], B0[2][2], B1[2][2];
  STAGE(SB(0, 0), Bt, bcol, 0); STAGE(SA(0, 0), A, brow, 0);
  STAGE(SB(0, 1), Bt, bcol + HALF, 0); STAGE(SA(0, 1), A, brow + HALF, 0);
  if (wr == 1) BAR;
  WAIT_V(4); BAR;
  STAGE(SB(1, 0), Bt, bcol, 1); STAGE(SA(1, 0), A, brow, 1); STAGE(SB(1, 1), Bt, bcol + HALF, 1);
  WAIT_V(6); BAR;
  for (int t = 0; t < nt - 2; t += 2) {
    LDB(B0, 0, 0); SCHED; LDA(At, 0, 0); STAGE(SA(1, 1), A, brow + HALF, t + 1);
    WAIT_L(8); BAR; WAIT_L(0); MMA(0, 0, At, B0); BAR; SCHED;
    LDB(B1, 0, 1); STAGE(SB(0, 0), Bt, bcol, t + 2);
    BAR; WAIT_L(0); MMA(0, 1, At, B1); BAR;
    LDA(At, 0, 1); STAGE(SA(0, 0), A, brow, t + 2);
    BAR; WAIT_L(0); MMA(1, 0, At, B0); BAR; SCHED;
    STAGE(SB(0, 1), Bt, bcol + HALF, t + 2);
    WAIT_V(6); BAR; MMA(1, 1, At, B1); BAR;
    LDB(B0, 1, 0); SCHED; LDA(At, 1, 0); STAGE(SA(0, 1), A, brow + HALF, t + 2);
    WAIT_L(8); BAR; WAIT_L(0); MMA(0, 0, At, B0); BAR; SCHED;
    LDB(B1, 1, 1); STAGE(SB(1, 0), Bt, bcol, t + 3);
    BAR; WAIT_L(0); MMA(0, 1, At, B1); BAR;
    LDA(At, 1, 1); STAGE(SA(1, 0), A, brow, t + 3);
    BAR; WAIT_L(0); MMA(1, 0, At, B0); BAR; SCHED;
    STAGE(SB(1, 1), Bt, bcol + HALF, t + 3);
    WAIT_V(6); BAR; MMA(1, 1, At, B1); BAR;
  }
  { LDB(B0, 0, 0); LDA(At, 0, 0); STAGE(SA(1, 1), A, brow + HALF, nt - 1);
    BAR; WAIT_L(0); MMA(0, 0, At, B0); BAR;
    LDB(B1, 0, 1); BAR; WAIT_L(0); MMA(0, 1, At, B1); BAR;
    LDA(At, 0, 1); WAIT_V(4); BAR; WAIT_L(0); MMA(1, 0, At, B0); MMA(1, 1, At, B1); BAR; }
  { LDB(B0, 1, 0); LDA(At, 1, 0); WAIT_V(2); BAR; WAIT_L(0); MMA(0, 0, At, B0); BAR;
    LDB(B1, 1, 1); WAIT_V(0); BAR; WAIT_L(0); MMA(0, 1, At, B1); BAR;
    LDA(At, 1, 1); BAR; WAIT_L(0); MMA(1, 0, At, B0); MMA(1, 1, At, B1); BAR; }
  if (wr == 0) BAR;
  epilogue(p, mode, l, acc, pm, pn, wr, wc, fr, fq);
  WAIT_V(0);
#undef SA
#undef SB
}

__device__ __forceinline__ bool unit_order(int i, int c, int G, int nM, int nN, int& pm, int& pn) {
  const int nwg = nM * nN;
  const long L = (long)i * G + c; if (L >= nwg) return false;
  int wgid = (int)L; { const int q = nwg / 8, r = nwg % 8, xcd = wgid % 8, off = wgid / 8; wgid = (xcd < r ? xcd * (q + 1) : r * (q + 1) + (xcd - r) * q) + off; }
  const int nig = 8 * nN, gid = wgid / nig, fm = gid * 8, gsz = (nM - fm) < 8 ? (nM - fm) : 8;
  pm = fm + ((wgid % nig) % gsz); pn = (wgid % nig) / gsz; return true;
}

__device__ __forceinline__ void gemm_phase(const Params& p, const int kind, const int l) {
  const int G = gridDim.x;
  const int j = l >> 1;
  const bool rw = l & 1;
  char* ws = p.ws;
  const bfr* hA = (const bfr*)(ws + WS_HA);
  int nM = NTOK / BM, nN, K, mode;
  const bfr* Bt;
  if (kind == 0) { nN = rw ? (l == 3 ? 23 : 22) : 20; K = 1024; mode = rw ? EM_G1R : EM_PROJ; Bt = (const bfr*)(ws + WS_WTIN) + l * WTIN_L; }
  else if (kind == 1) { nN = (l == 3) ? 12 : 8; K = 256; mode = EM_LUP; Bt = (const bfr*)(ws + WS_W2T) + (size_t)j * 3072 * 256; }
  else { nN = 4; K = 1536; mode = EM_OUT; Bt = (const bfr*)(ws + WS_WTOUT) + (size_t)l * DM * BRW; }
  int pm, pn;
  const int nwg1 = nM * nN;
  const bool withmem = (kind == 0 && l == 0);
  const int c2 = (bidx() + G - (nwg1 % G)) % G;
  int seg = 0, i = 0;
  for (;;) {
    const bfr* A; const bfr* B = Bt; int KK = K, md = mode, kt0 = 0, nt = K / BK, lk = l;
    if (kind == 2) {
      const int t = bidx() + G * i;
      if (t >= 256 + 96) break;
      ++i;
      A = (const bfr*)(ws + WS_BRANCH);
      if (t < 256) { pm = (t & 7) * 8 + (t >> 5); pn = (t >> 3) & 3; }
      else { const int v = t - 256, rem = v % 24, ks = rem % 6; pm = 64 + v / 24; pn = rem / 6; kt0 = ks * 4; nt = 4; if (ks) { md = EM_OUTA; lk = l | (ks << 8); } }
    } else {
      bool ok;
      if (seg == 0) ok = unit_order(i, bidx(), G, nM, nN, pm, pn);
      else ok = unit_order(i, c2, G, 32, 4, pm, pn);
      if (!ok) { if (seg == 0 && withmem) { seg = 1; i = 0; continue; } break; }
      ++i;
      if (seg == 1) { A = (const bfr*)(ws + WS_MEMN); B = (const bfr*)(ws + WS_WTMEM) + (size_t)(pm >> 3) * DM * DM; KK = 1024; nt = 16; md = EM_MEM; }
      else if (kind == 0) {
        int sel = 0;
        if (rw) sel = pn < 4 ? 1 : pn < 8 ? 3 : pn < 12 ? 4 : pn < 20 ? 0 : pn == 20 ? 2 : pn == 21 ? 5 : 4;
        A = hA + (size_t)sel * HA_SZ;
      } else A = (const bfr*)(ws + WS_ALORA);
    }
    gemm_unit(p, A, B, KK, kt0, nt, pm, pn, md, lk);
  }
}

__device__ __forceinline__ void xattn_unit(const Params& p, const float* __restrict__ kb, const float* __restrict__ vb, const int g0, const int ntok, const int head) {
  extern __shared__ __attribute__((aligned(16))) char smem[];
  bfr* Ks = (bfr*)smem;
  bfr* Vt = Ks + 256 * 136;
  const int tid = tidx(), wid = tid >> 6, lane = tid & 63, fr = lane & 15, fq = lane >> 4;
#pragma unroll 4
  for (int i = 0; i < 16; ++i) {
    const int idx = tid + i * 512, row = idx >> 5, c4 = (idx & 31) << 2;
    const float4 v = *(const float4*)(kb + (size_t)row * 512 + c4);
    u32x2 o; o.x = cvt_pk(v.x, v.y); o.y = cvt_pk(v.z, v.w);
    *(u32x2*)(Ks + row * 136 + c4) = o;
  }
  {
    const int pp = lane & 7, dd = lane >> 3;
#pragma unroll 4
    for (int it = 0; it < 8; ++it) {
      const int wq = it * 8 + wid, mb = wq & 15, db = wq >> 4;
      const int m0 = mb * 16 + 2 * pp, d0 = db * 32 + dd * 4;
      const float4 a = *(const float4*)(vb + (size_t)m0 * 512 + d0);
      const float4 b = *(const float4*)(vb + (size_t)(m0 + 1) * 512 + d0);
      *(unsigned*)(Vt + (d0 + 0) * 260 + m0) = cvt_pk(a.x, b.x);
      *(unsigned*)(Vt + (d0 + 1) * 260 + m0) = cvt_pk(a.y, b.y);
      *(unsigned*)(Vt + (d0 + 2) * 260 + m0) = cvt_pk(a.z, b.z);
      *(unsigned*)(Vt + (d0 + 3) * 260 + m0) = cvt_pk(a.w, b.w);
    }
  }
  __syncthreads();
  if (wid * 16 < ntok) {
    const bfr* proj = (const bfr*)(p.ws + WS_PROJ);
    int tl = wid * 16 + fr; if (tl > ntok - 1) tl = ntok - 1;
    const bfr* qrow = proj + (size_t)(g0 + tl) * INC + 3072 + head * 128;
    bf16x8 qf[4];
#pragma unroll
    for (int ks = 0; ks < 4; ++ks) qf[ks] = *(const bf16x8*)(qrow + ks * 32 + fq * 8);
    f32x4 sc[16];
#pragma unroll
    for (int mt = 0; mt < 16; ++mt) {
      f32x4 a = {0.f, 0.f, 0.f, 0.f};
#pragma unroll
      for (int ks = 0; ks < 4; ++ks) {
        const bf16x8 kf = *(const bf16x8*)(Ks + (mt * 16 + fr) * 136 + ks * 32 + fq * 8);
        a = __builtin_amdgcn_mfma_f32_16x16x32_bf16(kf, qf[ks], a, 0, 0, 0);
      }
      sc[mt] = a;
    }
    float mx = -3.0e38f;
#pragma unroll
    for (int mt = 0; mt < 16; ++mt) mx = fmaxf(mx, fmaxf(fmaxf(sc[mt][0], sc[mt][1]), fmaxf(sc[mt][2], sc[mt][3])));
    mx = fmaxf(mx, bperm(mx, lane ^ 16)); mx = fmaxf(mx, bperm(mx, lane ^ 32));
    const float cs = 0.08838834764831845f * 1.4426950408889634f;
    float sum = 0.f;
#pragma unroll
    for (int mt = 0; mt < 16; ++mt)
#pragma unroll
      for (int e = 0; e < 4; ++e) { const float pe = exp2f((sc[mt][e] - mx) * cs); sc[mt][e] = pe; sum += pe; }
    sum += bperm(sum, lane ^ 16); sum += bperm(sum, lane ^ 32);
    const float inv = frcp(sum);
    bf16x8 pf[8];
#pragma unroll
    for (int u = 0; u < 8; ++u) {
      u32x4 w; w.x = cvt_pk(sc[2 * u][0], sc[2 * u][1]); w.y = cvt_pk(sc[2 * u][2], sc[2 * u][3]);
      w.z = cvt_pk(sc[2 * u + 1][0], sc[2 * u + 1][1]); w.w = cvt_pk(sc[2 * u + 1][2], sc[2 * u + 1][3]);
      pf[u] = __builtin_bit_cast(bf16x8, w);
    }
    const bool tvalid = (wid * 16 + fr) < ntok;
    const int g = g0 + tl;
    const bfr* gate = proj + (size_t)g * INC + 3584 + 1024 + head * 128;
    bfr* br = (bfr*)(p.ws + WS_BRANCH) + (size_t)g * BRW + 1024 + head * 128;
#pragma unroll
    for (int dt = 0; dt < 8; ++dt) {
      f32x4 a = {0.f, 0.f, 0.f, 0.f};
#pragma unroll
      for (int u = 0; u < 8; ++u) {
        const bfr* vr = Vt + (dt * 16 + fr) * 260 + fq * 4;
        u32x4 w;
        const u32x2 lo = *(const u32x2*)(vr + (2 * u) * 16), hi = *(const u32x2*)(vr + (2 * u + 1) * 16);
        w.x = lo.x; w.y = lo.y; w.z = hi.x; w.w = hi.y;
        a = __builtin_amdgcn_mfma_f32_16x16x32_bf16(__builtin_bit_cast(bf16x8, w), pf[u], a, 0, 0, 0);
      }
      if (tvalid) {
        const u32x2 gw = *(const u32x2*)(gate + dt * 16 + fq * 4);
        const float g0f = bflo(gw.x), g1f = bfhi(gw.x), g2f = bflo(gw.y), g3f = bfhi(gw.y);
        u32x2 o;
        o.x = cvt_pk(a[0] * inv * g0f * sigmoidf_(g0f), a[1] * inv * g1f * sigmoidf_(g1f));
        o.y = cvt_pk(a[2] * inv * g2f * sigmoidf_(g2f), a[3] * inv * g3f * sigmoidf_(g3f));
        *(u32x2*)(br + dt * 16 + fq * 4) = o;
      }
    }
  }
  __syncthreads();
}

struct HgRaw { u32x2 q, f, v, g; };
__device__ __forceinline__ void hg_load(HgRaw& r, const bfr* __restrict__ proj, const int g0, const int T, const int sbi, const int h,
                                        const int wid, const int fr, const int fq, const int tid) {
  const int t0 = sbi * 16;
  if (t0 + fr < T) {
    const bfr* pr = proj + (size_t)(g0 + t0 + fr) * INC + h * 128 + wid * 16 + fq * 4;
    r.q = *(const u32x2*)pr; r.f = *(const u32x2*)(pr + 1024); r.g = *(const u32x2*)(pr + 3584);
  }
  const int vt = tid >> 5, dv4 = (tid & 31) << 2;
  if (t0 + vt < T) r.v = *(const u32x2*)(proj + (size_t)(g0 + t0 + vt) * INC + 2048 + h * 128 + dv4);
}
constexpr int KTS = 18;
constexpr int HG_SET = 16 * 136 * 2 + 128 * KTS * 2;

__device__ __forceinline__ void hgrn_unit(const Params& p, const int l, const bool smp, const int b, const int h) {
  extern __shared__ __attribute__((aligned(16))) char smem[];
  bfr* lds0 = (bfr*)smem;
  float* decb = (float*)(lds0 + 2 * HG_SET);
  float* redb = decb + 256;
  const int tid = tidx(), wid = tid >> 6, lane = tid & 63, fr = lane & 15, fq = lane >> 4;
  const int j = l >> 1;
  const bfr* proj = (const bfr*)(p.ws + WS_PROJ);
  bfr* branch = (bfr*)(p.ws + WS_BRANCH);
  const int g0 = smp ? NPR + b * 8 : b * 2048;
  const int T = smp ? 8 : 2048;
  const int nsub = (T + 15) >> 4;
  f32x4 S[8];
  if (smp) {
    const float* s0 = pin(p, I_SH) + (((size_t)j * 128 + b) * 8 + h) * 16384;
#pragma unroll
    for (int kt = 0; kt < 8; ++kt)
#pragma unroll
      for (int e = 0; e < 4; ++e) S[kt][e] = s0[(kt * 16 + fq * 4 + e) * 128 + wid * 16 + fr];
  } else {
#pragma unroll
    for (int kt = 0; kt < 8; ++kt) S[kt] = (f32x4){0.f, 0.f, 0.f, 0.f};
  }
  const int dkp = wid * 16 + fq * 4;
  float lb[4];
#pragma unroll
  for (int e = 0; e < 4; ++e) {
    if (j == 0) lb[e] = 0.f;
    else { const int c = h * 128 + dkp + e; lb[e] = sigmoidf_(pin(p, I_LB)[1024 + c] - pin(p, I_LB)[c]); }
  }
  float og[4];
#pragma unroll
  for (int e = 0; e < 4; ++e) og[e] = pin(p, I_ONG)[j * 128 + wid * 16 + fq * 4 + e];

  HgRaw raw[4];
#pragma unroll
  for (int u = 0; u < 4; ++u) { raw[u].q = raw[u].f = raw[u].v = raw[u].g = (u32x2){0u, 0u}; hg_load(raw[u], proj, g0, T, u, h, wid, fr, fq, tid); }
  u32x2 gsave[2] = {(u32x2){0u, 0u}, (u32x2){0u, 0u}};
  f32x4 oprev = {0.f, 0.f, 0.f, 0.f};

  for (int i4 = 0; i4 < nsub; i4 += 4) {
#pragma unroll
    for (int u = 0; u < 4; ++u) {
      const int i = i4 + u;
      if (i < nsub) {
        const int s = u & 1;
        bfr* Qs = lds0 + s * HG_SET; bfr* Kh = Qs + 16 * 136; bfr* Kt = Kh + 16 * 136; bfr* Vt = Kt + 128 * KTS;
        float* dec = decb + s * 128; float* red = redb + s * 128;
        {
          const int sb = i * 16;
          const bool valid = (sb + fr) < T;
          float q[4], P[4], kv[4];
          const float qz[4] = {bflo(raw[u].q.x), bfhi(raw[u].q.x), bflo(raw[u].q.y), bfhi(raw[u].q.y)};
          const float fz[4] = {bflo(raw[u].f.x), bfhi(raw[u].f.x), bflo(raw[u].f.y), bfhi(raw[u].f.y)};
#pragma unroll
          for (int e = 0; e < 4; ++e) {
            const float sg = sigmoidf_(fz[e]);
            const float f = fmaxf(lb[e] + (1.f - lb[e]) * sg, 1e-30f);
            P[e] = valid ? f : 1.f;
            kv[e] = valid ? (1.f - lb[e]) * (1.f - sg) : 0.f;
            q[e] = valid ? qz[e] * sigmoidf_(qz[e]) : 0.f;
          }
#pragma unroll
          for (int e = 0; e < 4; ++e) {
            P[e] *= __builtin_bit_cast(float, __builtin_amdgcn_update_dpp(0x3f800000, __builtin_bit_cast(int, P[e]), 0x111, 0xf, 0xf, false));
            P[e] *= __builtin_bit_cast(float, __builtin_amdgcn_update_dpp(0x3f800000, __builtin_bit_cast(int, P[e]), 0x112, 0xf, 0xf, false));
            P[e] *= __builtin_bit_cast(float, __builtin_amdgcn_update_dpp(0x3f800000, __builtin_bit_cast(int, P[e]), 0x114, 0xf, 0xf, false));
            P[e] *= __builtin_bit_cast(float, __builtin_amdgcn_update_dpp(0x3f800000, __builtin_bit_cast(int, P[e]), 0x118, 0xf, 0xf, false));
          }
          float qt[4], kh[4], kt[4];
#pragma unroll
          for (int e = 0; e < 4; ++e) {
            const float Pl = bperm(P[e], lane | 15);
            const float inv = frcp(fmaxf(P[e], 1e-30f));
            qt[e] = q[e] * P[e]; kh[e] = kv[e] * inv; kt[e] = kh[e] * Pl;
          }
          if (fr == 15) *(f32x4*)(dec + dkp) = (f32x4){P[0], P[1], P[2], P[3]};
          const int kpos = (wid >> 1) * 32 + fq * 8 + (wid & 1) * 4;
          u32x2 o; o.x = cvt_pk(qt[0], qt[1]); o.y = cvt_pk(qt[2], qt[3]);
          *(u32x2*)(Qs + fr * 136 + kpos) = o;
          o.x = cvt_pk(kh[0], kh[1]); o.y = cvt_pk(kh[2], kh[3]);
          *(u32x2*)(Kh + fr * 136 + kpos) = o;
          { const unsigned k01 = cvt_pk(kt[0], kt[1]), k23 = cvt_pk(kt[2], kt[3]);
            Kt[(dkp + 0) * KTS + fr] = (bfr)(k01 & 0xffff); Kt[(dkp + 1) * KTS + fr] = (bfr)(k01 >> 16);
            Kt[(dkp + 2) * KTS + fr] = (bfr)(k23 & 0xffff); Kt[(dkp + 3) * KTS + fr] = (bfr)(k23 >> 16); }
          const int vt = tid >> 5, dv4 = (tid & 31) << 2;
          const bool vv = (sb + vt) < T;
          const unsigned vx = vv ? raw[u].v.x : 0u, vy = vv ? raw[u].v.y : 0u;
          Vt[(dv4 + 0) * KTS + vt] = (bfr)(vx & 0xffff); Vt[(dv4 + 1) * KTS + vt] = (bfr)(vx >> 16);
          Vt[(dv4 + 2) * KTS + vt] = (bfr)(vy & 0xffff); Vt[(dv4 + 3) * KTS + vt] = (bfr)(vy >> 16);
          gsave[s] = raw[u].g;
          hg_load(raw[u], proj, g0, T, i + 4, h, wid, fr, fq, tid);
        }
        __syncthreads();
        if (i > 0) {
          const float* redp = redb + (s ^ 1) * 128;
          float tot = 0.f;
#pragma unroll
          for (int w = 0; w < 8; ++w) tot += redp[fr * 8 + w];
          const float rs = rsqrtf(tot * (1.f / 128.f) + 1e-6f);
          const int tk = (i - 1) * 16 + fr;
          if (tk < T) {
            const u32x2 gw = gsave[s ^ 1];
            const float gg[4] = {bflo(gw.x), bfhi(gw.x), bflo(gw.y), bfhi(gw.y)};
            float r[4];
#pragma unroll
            for (int e = 0; e < 4; ++e) r[e] = oprev[e] * rs * og[e] * gg[e] * sigmoidf_(gg[e]);
            u32x2 o; o.x = cvt_pk(r[0], r[1]); o.y = cvt_pk(r[2], r[3]);
            *(u32x2*)(branch + (size_t)(g0 + tk) * BRW + h * 128 + wid * 16 + fq * 4) = o;
          }
        }
        {
          bf16x8 qp[4], kp[4];
#pragma unroll
          for (int uu = 0; uu < 4; ++uu) {
            qp[uu] = *(const bf16x8*)(Qs + fr * 136 + uu * 32 + fq * 8);
            kp[uu] = *(const bf16x8*)(Kh + fr * 136 + uu * 32 + fq * 8);
          }
          f32x4 at = {0.f, 0.f, 0.f, 0.f};
#pragma unroll
          for (int uu = 0; uu < 4; ++uu) at = __builtin_amdgcn_mfma_f32_16x16x32_bf16(kp[uu], qp[uu], at, 0, 0, 0);
#pragma unroll
          for (int e = 0; e < 4; ++e) if (fq * 4 + e > fr) at[e] = 0.f;
          u32x2 aw; aw.x = cvt_pk(at[0], at[1]); aw.y = cvt_pk(at[2], at[3]);
          const bf16x4 a4 = __builtin_bit_cast(bf16x4, aw);
          u32x2 vfw; { const unsigned* q2 = (const unsigned*)(Vt + (wid * 16 + fr) * KTS + fq * 4); vfw.x = q2[0]; vfw.y = q2[1]; }
          const bf16x4 vf = __builtin_bit_cast(bf16x4, vfw);
          const bf16x8 vf8 = {vf[0], vf[1], vf[2], vf[3], 0, 0, 0, 0}, a8 = {a4[0], a4[1], a4[2], a4[3], 0, 0, 0, 0};
          f32x4 oacc = __builtin_amdgcn_mfma_f32_16x16x32_bf16(vf8, a8, (f32x4){0.f, 0.f, 0.f, 0.f}, 0, 0, 0);
#pragma unroll
          for (int uu = 0; uu < 4; ++uu) {
            u32x4 w; w.x = cvt_pk(S[2 * uu][0], S[2 * uu][1]); w.y = cvt_pk(S[2 * uu][2], S[2 * uu][3]);
            w.z = cvt_pk(S[2 * uu + 1][0], S[2 * uu + 1][1]); w.w = cvt_pk(S[2 * uu + 1][2], S[2 * uu + 1][3]);
            oacc = __builtin_amdgcn_mfma_f32_16x16x32_bf16(__builtin_bit_cast(bf16x8, w), qp[uu], oacc, 0, 0, 0);
          }
#pragma unroll
          for (int kt = 0; kt < 8; ++kt) {
            const f32x4 d = *(const f32x4*)(dec + kt * 16 + fq * 4);
            u32x2 kfw; { const unsigned* q2 = (const unsigned*)(Kt + (kt * 16 + fr) * KTS + fq * 4); kfw.x = q2[0]; kfw.y = q2[1]; }
            const bf16x4 kf = __builtin_bit_cast(bf16x4, kfw);
            const bf16x8 kf8 = {kf[0], kf[1], kf[2], kf[3], 0, 0, 0, 0};
            S[kt] = __builtin_amdgcn_mfma_f32_16x16x32_bf16(kf8, vf8, S[kt] * d, 0, 0, 0);
          }
          float ss = oacc[0] * oacc[0] + oacc[1] * oacc[1] + oacc[2] * oacc[2] + oacc[3] * oacc[3];
          ss += bperm(ss, lane ^ 16); ss += bperm(ss, lane ^ 32);
          if (fq == 0) red[fr * 8 + wid] = ss;
          oprev = oacc;
        }
      }
    }
  }
  __syncthreads();
  {
    const int i = nsub - 1, s = i & 1;
    const float* redp = redb + s * 128;
    float tot = 0.f;
#pragma unroll
    for (int w = 0; w < 8; ++w) tot += redp[fr * 8 + w];
    const float rs = rsqrtf(tot * (1.f / 128.f) + 1e-6f);
    const int tk = i * 16 + fr;
    if (tk < T) {
      const u32x2 gw = gsave[s];
      const float gg[4] = {bflo(gw.x), bfhi(gw.x), bflo(gw.y), bfhi(gw.y)};
      float r[4];
#pragma unroll
      for (int e = 0; e < 4; ++e) r[e] = oprev[e] * rs * og[e] * gg[e] * sigmoidf_(gg[e]);
      u32x2 o; o.x = cvt_pk(r[0], r[1]); o.y = cvt_pk(r[2], r[3]);
      *(u32x2*)(branch + (size_t)(g0 + tk) * BRW + h * 128 + wid * 16 + fq * 4) = o;
    }
  }
  float* so = p.out + (smp ? O_SHS + (((size_t)j * 128 + b) * 8 + h) * 16384 : O_SHP + (((size_t)j * 8 + b) * 8 + h) * 16384);
#pragma unroll
  for (int kt = 0; kt < 8; ++kt)
#pragma unroll
    for (int e = 0; e < 4; ++e) so[(kt * 16 + fq * 4 + e) * 128 + wid * 16 + fr] = S[kt][e];
  __syncthreads();
}

#define LDS_BARRIER() do { asm volatile("s_waitcnt lgkmcnt(0)" ::: "memory"); __builtin_amdgcn_s_barrier(); asm volatile("" ::: "memory"); } while (0)
typedef float f32x2 __attribute__((ext_vector_type(2)));
struct RwRaw { u32x2 r, k, v, gt, ew, a, vg, vf; };
constexpr int RW_SET = 7 * 1024;
struct RwCtx {
  const bfr* proj; const bfr* lup; const bfr* vfsrc; bfr* vdst; bfr* branch;
  int vgoff, vfld;
  int g0, T, tsl, cq4, C4;
  f32x4 kkw, kaw, rkw, lng, lnb;
};
__device__ __forceinline__ float sum16(float v) {
  v += dppf<0xB1>(v); v += dppf<0x4E>(v); v += dppf<0x141>(v); v += dppf<0x140>(v);
  return v;
}
__device__ __forceinline__ f32x4 unpk4(const u32x2 w) { return (f32x4){bflo(w.x), bfhi(w.x), bflo(w.y), bfhi(w.y)}; }
__device__ __forceinline__ void rw_load(RwRaw& raw, const RwCtx& c, const int tile) {
  int tok = tile * 16 + c.tsl; tok = tok < c.T ? tok : c.T - 1;
  const size_t g = (size_t)(c.g0 + tok);
  const bfr* pr = c.proj + g * INC + c.C4;
  raw.r = *(const u32x2*)pr; raw.k = *(const u32x2*)(pr + 1024); raw.v = *(const u32x2*)(pr + 2048); raw.gt = *(const u32x2*)(pr + 3584);
  const bfr* pl = c.lup + g * 3072 + c.C4;
  raw.ew = *(const u32x2*)pl; raw.a = *(const u32x2*)(pl + 1024); raw.vg = *(const u32x2*)(pl + c.vgoff);
  raw.vf = *(const u32x2*)(c.vfsrc + g * c.vfld + c.C4);
}
__device__ __forceinline__ void rw_prep(const RwRaw& raw, f32x4& bon, f32x4& gt, float* __restrict__ L, const RwCtx& c, const int tile) {
  int tok = tile * 16 + c.tsl; tok = tok < c.T ? tok : c.T - 1;
  const int tt = tok & 15;
  const size_t g = (size_t)(c.g0 + tok);
  const f32x4 r = unpk4(raw.r), k = unpk4(raw.k), ew = unpk4(raw.ew), a = unpk4(raw.a);
  f32x4 v = unpk4(raw.v);
  *(u32x2*)(c.vdst + g * DM + c.C4) = raw.v;
  v = v + (unpk4(raw.vf) - v) * unpk4(raw.vg);
  f32x4 dcy; dcy[0] = __expf(ew[0]); dcy[1] = __expf(ew[1]); dcy[2] = __expf(ew[2]); dcy[3] = __expf(ew[3]);
  f32x4 kk = k * c.kkw;
  const float n2 = sum16((kk[0] * kk[0] + kk[1] * kk[1]) + (kk[2] * kk[2] + kk[3] * kk[3]));
  const float inv = __builtin_amdgcn_rsqf(fmaxf(n2, 1e-24f));
  kk = kk * inv;
  const f32x4 k2 = k * (1.f + (a - 1.f) * c.kaw);
  const f32x4 rk = r * k2 * c.rkw;
  const float sb = sum16((rk[0] + rk[1]) + (rk[2] + rk[3]));
  bon = v * sb;
  gt = unpk4(raw.gt);
  const int o = tt * 64 + c.cq4;
  *(f32x4*)(L + 0 * 1024 + o) = r; *(f32x4*)(L + 1 * 1024 + o) = dcy; *(f32x4*)(L + 2 * 1024 + o) = k2; *(f32x4*)(L + 3 * 1024 + o) = v;
  *(f32x4*)(L + 4 * 1024 + o) = -kk; *(f32x4*)(L + 5 * 1024 + o) = kk * a;
}
__device__ __forceinline__ void rw_post(const f32x4 bon, const f32x4 gt, const float* __restrict__ L, const RwCtx& c, const int tile) {
  int tok = tile * 16 + c.tsl; tok = tok < c.T ? tok : c.T - 1;
  const int tt = tok & 15;
  const size_t g = (size_t)(c.g0 + tok);
  const f32x4 y = *(const f32x4*)(L + 6 * 1024 + tt * 64 + c.cq4);
  const float mean = sum16((y[0] + y[1]) + (y[2] + y[3])) * (1.f / 64.f);
  const f32x4 d = y - mean;
  const float var = sum16((d[0] * d[0] + d[1] * d[1]) + (d[2] * d[2] + d[3] * d[3])) * (1.f / 64.f);
  f32x4 o = d * rsqrtf(var + 64e-5f) * c.lng + c.lnb + bon;
  o[0] *= gt[0] * sigmoidf_(gt[0]); o[1] *= gt[1] * sigmoidf_(gt[1]); o[2] *= gt[2] * sigmoidf_(gt[2]); o[3] *= gt[3] * sigmoidf_(gt[3]);
  u32x2 w; w.x = cvt_pk(o[0], o[1]); w.y = cvt_pk(o[2], o[3]);
  *(u32x2*)(c.branch + g * BRW + c.C4) = w;
}
struct RwVec { f32x4 r0, r1, w0, w1, k0, k1, a0, a1, b0, b1; float v; };
__device__ __forceinline__ void rw_ldvec(RwVec& x, const float* __restrict__ L, const int t, const int row, const int c0) {
  x.r0 = *(const f32x4*)(L + 0 * 1024 + t * 64 + c0); x.r1 = *(const f32x4*)(L + 0 * 1024 + t * 64 + c0 + 4);
  x.w0 = *(const f32x4*)(L + 1 * 1024 + t * 64 + c0); x.w1 = *(const f32x4*)(L + 1 * 1024 + t * 64 + c0 + 4);
  x.k0 = *(const f32x4*)(L + 2 * 1024 + t * 64 + c0); x.k1 = *(const f32x4*)(L + 2 * 1024 + t * 64 + c0 + 4);
  x.v = L[3 * 1024 + t * 64 + row];
  x.a0 = *(const f32x4*)(L + 4 * 1024 + t * 64 + c0); x.a1 = *(const f32x4*)(L + 4 * 1024 + t * 64 + c0 + 4);
  x.b0 = *(const f32x4*)(L + 5 * 1024 + t * 64 + c0); x.b1 = *(const f32x4*)(L + 5 * 1024 + t * 64 + c0 + 4);
}
template <int NST>
__device__ __forceinline__ void rw_scan(f32x2 (&S)[4], float* __restrict__ L, const int row, const int c0, const int cg) {
  RwVec cur, nxt;
  rw_ldvec(cur, L, 0, row, c0);
  float yp[NST / 2], ra[NST / 2];
  const bool hi = (cg & 4) != 0, b1 = (cg & 2) != 0, b0 = (cg & 1) != 0;
#pragma unroll
  for (int t = 0; t < NST; ++t) {
    if (t + 1 < NST) rw_ldvec(nxt, L, t + 1, row, c0);
    const f32x2 av[4] = {{cur.a0[0], cur.a0[1]}, {cur.a0[2], cur.a0[3]}, {cur.a1[0], cur.a1[1]}, {cur.a1[2], cur.a1[3]}};
    const f32x2 wv[4] = {{cur.w0[0], cur.w0[1]}, {cur.w0[2], cur.w0[3]}, {cur.w1[0], cur.w1[1]}, {cur.w1[2], cur.w1[3]}};
    const f32x2 bv[4] = {{cur.b0[0], cur.b0[1]}, {cur.b0[2], cur.b0[3]}, {cur.b1[0], cur.b1[1]}, {cur.b1[2], cur.b1[3]}};
    const f32x2 kv[4] = {{cur.k0[0], cur.k0[1]}, {cur.k0[2], cur.k0[3]}, {cur.k1[0], cur.k1[1]}, {cur.k1[2], cur.k1[3]}};
    const f32x2 rv[4] = {{cur.r0[0], cur.r0[1]}, {cur.r0[2], cur.r0[3]}, {cur.r1[0], cur.r1[1]}, {cur.r1[2], cur.r1[3]}};
    const f32x2 vi2 = {cur.v, cur.v};
    f32x2 pa = S[0] * av[0] + S[1] * av[1];
    const f32x2 pb = S[2] * av[2] + S[3] * av[3];
    f32x2 n[4];
#pragma unroll
    for (int q = 0; q < 4; ++q) n[q] = S[q] * wv[q] + vi2 * kv[q];
    pa += pb;
    const float sa = sum8(pa[0] + pa[1]);
    const f32x2 sa2 = {sa, sa};
#pragma unroll
    for (int q = 0; q < 4; ++q) S[q] = sa2 * bv[q] + n[q];
    f32x2 ya = S[0] * rv[0] + S[1] * rv[1];
    const f32x2 yb = S[2] * rv[2] + S[3] * rv[3];
    ya += yb;
    if (t < NST / 2) yp[t] = ya[0] + ya[1];
    else { const float lo = yp[t - NST / 2], hv = ya[0] + ya[1]; const float mine = hi ? hv : lo, send = hi ? lo : hv; ra[t - NST / 2] = mine + dppf<0x141>(send); }
    cur = nxt;
  }
  float rb[NST / 4], rc[NST / 8];
#pragma unroll
  for (int k = 0; k < NST / 4; ++k) { const float mine = b1 ? ra[k + NST / 4] : ra[k], send = b1 ? ra[k] : ra[k + NST / 4]; rb[k] = mine + dppf<0x4E>(send); }
#pragma unroll
  for (int k = 0; k < NST / 8; ++k) { const float mine = b0 ? rb[k + NST / 8] : rb[k], send = b0 ? rb[k] : rb[k + NST / 8]; rc[k] = mine + dppf<0xB1>(send); }
  const int base = (hi ? NST / 2 : 0) + (b1 ? NST / 4 : 0) + (b0 ? NST / 8 : 0);
#pragma unroll
  for (int k = 0; k < NST / 8; ++k) L[6 * 1024 + (base + k) * 64 + row] = rc[k];
}

__device__ __forceinline__ void rwkv_unit(const Params& p, const int l, const bool smp, const int b, const int head) {
  extern __shared__ __attribute__((aligned(16))) char smem[];
  float* L0 = (float*)smem;
  float* L1 = L0 + RW_SET;
  RwCtx c;
  const int tid = tidx();
  const int wid = tid >> 6, lane = tid & 63;
  const int j = l >> 1;
  c.proj = (const bfr*)(p.ws + WS_PROJ);
  c.lup = (const bfr*)(p.ws + WS_LUP);
  c.vfsrc = (j == 0) ? c.proj + 2048 : (const bfr*)(p.ws + WS_VFIRST);
  c.vfld = (j == 0) ? INC : DM;
  c.vgoff = (j == 0) ? 1024 : 2048;
  c.vdst = (j == 0) ? (bfr*)(p.ws + WS_VFIRST) : (bfr*)(p.ws + WS_HA + 2 * HA_SZ * 2);
  c.branch = (bfr*)(p.ws + WS_BRANCH);
  c.g0 = smp ? NPR + b * 8 : b * 2048;
  c.T = smp ? 8 : 2048;
  c.tsl = 2 * wid + ((lane >> 4) & 1);
  c.cq4 = (lane & 15) * 4;
  c.C4 = head * 64 + c.cq4;
  const int cg = lane & 7, row = wid * 8 + (lane >> 3), c0 = cg * 8;
  f32x2 S[4];
  if (smp) {
    const float* s0 = pin(p, I_SR) + ((((size_t)j * 128 + b) * 16 + head) * 64 + row) * 64 + c0;
    const float4 a = *(const float4*)s0, bq = *(const float4*)(s0 + 4);
    S[0] = (f32x2){a.x, a.y}; S[1] = (f32x2){a.z, a.w}; S[2] = (f32x2){bq.x, bq.y}; S[3] = (f32x2){bq.z, bq.w};
  } else {
    S[0] = S[1] = S[2] = S[3] = (f32x2){0.f, 0.f};
  }
  c.kkw = *(const f32x4*)(pin(p, I_KK) + j * DM + c.C4); c.kaw = *(const f32x4*)(pin(p, I_KA) + j * DM + c.C4); c.rkw = *(const f32x4*)(pin(p, I_RK) + j * DM + c.C4);
  c.lng = *(const f32x4*)(pin(p, I_LG) + j * DM + c.C4); c.lnb = *(const f32x4*)(pin(p, I_LBI) + j * DM + c.C4);
  RwRaw rawA, rawB;
  f32x4 bonA, bonB, gtA, gtB;
  if (smp) {
    rw_load(rawA, c, 0);
    rw_prep(rawA, bonA, gtA, L0, c, 0);
    LDS_BARRIER();
    rw_scan<8>(S, L0, row, c0, cg);
    LDS_BARRIER();
    rw_post(bonA, gtA, L0, c, 0);
  } else {
    const int ntile = 128;
    rw_load(rawA, c, 0); rw_load(rawB, c, 1);
    rw_prep(rawA, bonA, gtA, L0, c, 0); rw_load(rawA, c, 2);
    LDS_BARRIER();
    rw_scan<16>(S, L0, row, c0, cg); rw_prep(rawB, bonB, gtB, L1, c, 1); rw_load(rawB, c, 3);
    LDS_BARRIER();
    for (int i = 1; i < ntile - 1; i += 2) {
      rw_post(bonA, gtA, L0, c, i - 1); rw_scan<16>(S, L1, row, c0, cg); rw_prep(rawA, bonA, gtA, L0, c, i + 1); rw_load(rawA, c, i + 3);
      LDS_BARRIER();
      rw_post(bonB, gtB, L1, c, i); rw_scan<16>(S, L0, row, c0, cg); rw_prep(rawB, bonB, gtB, L1, c, i + 2); rw_load(rawB, c, i + 4);
      LDS_BARRIER();
    }
    rw_post(bonA, gtA, L0, c, ntile - 2); rw_scan<16>(S, L1, row, c0, cg);
    LDS_BARRIER();
    rw_post(bonB, gtB, L1, c, ntile - 1);
  }
  float* so = p.out + (smp ? O_SRS + ((((size_t)j * 128 + b) * 16 + head) * 64 + row) * 64 + c0 : O_SRP + ((((size_t)j * 8 + b) * 16 + head) * 64 + row) * 64 + c0);
  *(float4*)so = make_float4(S[0][0], S[0][1], S[1][0], S[1][1]); *(float4*)(so + 4) = make_float4(S[2][0], S[2][1], S[3][0], S[3][1]);
  __syncthreads();
}

__device__ __forceinline__ void mix_phase(const Params& p, const int l, const int rep) {
  __shared__ int s_item;
  unsigned* ctr = (unsigned*)(p.ws + WS_CTRL) + l + 4 * rep;
  const bool rw = l & 1;
  const int nP = rw ? 128 : 64, nS = rw ? 2048 : 1024;
  const int nitems = nP + nS + 1024;
  for (;;) {
    __syncthreads();
    if (tidx() == 0) s_item = (int)atomicAdd(ctr, 1u);
    __syncthreads();
    int it = s_item;
    if (rep > 0 && PROBE_SUB == 1) { if (it >= nP) break; }
    if (rep > 0 && PROBE_SUB == 2) { it += nP; if (it >= nP + nS) break; }
    if (rep > 0 && PROBE_SUB == 3) { it += nP + nS; }
    if (it >= nitems) break;
    if (it < nP + nS) {
      const bool smp = it >= nP;
      if (smp) it -= nP;
      if (rw) rwkv_unit(p, l, smp, it >> 4, it & 15); else hgrn_unit(p, l, smp, it >> 3, it & 7);
    } else {
      it -= nP + nS;
      const float* kb; const float* vb; int g0, ntok, head;
      if (it < 512) {
        const int b = it >> 6, blk = it & 15; head = (it >> 4) & 3;
        const size_t off = ((size_t)(l * 8 + b) * 256) * 512 + head * 128;
        kb = p.out + O_MK + off; vb = p.out + O_MV + off; g0 = b * 2048 + blk * 128; ntok = 128;
      } else {
        it -= 512;
        const int b = it >> 2; head = it & 3;
        const size_t off = ((size_t)(l * 128 + b) * 256) * 512 + head * 128;
        kb = pin(p, I_CK) + off; vb = pin(p, I_CV) + off; g0 = NPR + b * 8; ntok = 8;
      }
      xattn_unit(p, kb, vb, g0, ntok, head);
    }
  }
}

#define XB_TMO      128
#define XB_XCNT(j)  (256  + 64 * (j))
#define XB_XSUB(j)  (1280 + 64 * (j))
#define XB_XGEN(j)  (2304 + 64 * (j))
#define XB_TOP      3328
#define XB_TOPGEN   3392
#define XB_SPIN_CAP (1u << 18)
#define XB_LAS __attribute__((address_space(3)))
__device__ __forceinline__ unsigned xb_ld(unsigned* p)              { return __hip_atomic_load(p, __ATOMIC_RELAXED, __HIP_MEMORY_SCOPE_AGENT); }
__device__ __forceinline__ unsigned xb_add(unsigned* p, unsigned v) { return __hip_atomic_fetch_add(p, v, __ATOMIC_RELAXED, __HIP_MEMORY_SCOPE_AGENT); }
__device__ __forceinline__ unsigned xb_xcc_id() { return (unsigned)__builtin_amdgcn_s_getreg((3 << 11) | 20) & 0xFu; }
#define XB_SPIN(cond, bar) do { unsigned _sp = 0; while (cond) { __builtin_amdgcn_s_sleep(1); \
    if ((++_sp & 255u) == 0u) { if (xb_ld(&(bar)[XB_TMO])) break; if (_sp > XB_SPIN_CAP) { atomicAdd(&(bar)[XB_TMO], 1u); break; } } } } while (0)
__device__ __forceinline__ void xcd_barrier_complete(unsigned* bar, unsigned x, unsigned& nloc, unsigned& nx) {
  const unsigned G = gridDim.x;
  unsigned sum, cnt, mine, sp = 0u;
  for (;;) {
    sum = 0u; cnt = 0u; mine = 0u;
#pragma unroll
    for (unsigned j = 0; j < 16; ++j) { const unsigned c = xb_ld(&bar[XB_XCNT(j)]); sum += c; cnt += (c > 0u) ? 1u : 0u; mine = (j == x) ? c : mine; }
    if (sum == G) break;
    __builtin_amdgcn_s_sleep(1);
    if ((++sp & 255u) == 0u) { if (xb_ld(&bar[XB_TMO])) break; if (sp > XB_SPIN_CAP) { atomicAdd(&bar[XB_TMO], 1u); break; } }
  }
  nloc = mine > 0u ? mine : 1u; nx = cnt > 0u ? cnt : 1u;
}
__device__ __forceinline__ void grid_barrier(unsigned* bar, volatile XB_LAS unsigned* st) {
  asm volatile("s_waitcnt vmcnt(0)" ::: "memory");
  __syncthreads();
  if (threadIdx.x == 0) {
    const unsigned x = xb_xcc_id();
    __builtin_amdgcn_s_waitcnt(0);
    unsigned nloc = st[0], nx = st[1];
    if (nloc == 0u) { xcd_barrier_complete(bar, x, nloc, nx); st[0] = nloc; st[1] = nx; }
    const unsigned old = xb_add(&bar[XB_XSUB(x)], 1u);
    const unsigned gen = old / nloc;
    if (old + 1u == (gen + 1u) * nloc) {
      __builtin_amdgcn_fence(__ATOMIC_RELEASE, "agent");
      asm volatile("s_waitcnt vmcnt(0)" ::: "memory");
      const unsigned og = xb_add(&bar[XB_TOP], 1u);
      const unsigned tg = og / nx;
      if (og + 1u == (tg + 1u) * nx) xb_add(&bar[XB_TOPGEN], 1u);
      else XB_SPIN(xb_ld(&bar[XB_TOPGEN]) == tg, bar);
      __builtin_amdgcn_fence(__ATOMIC_ACQUIRE, "agent");
      xb_add(&bar[XB_XGEN(x)], 1u);
      asm volatile("s_waitcnt vmcnt(0)" ::: "memory");
    } else {
      XB_SPIN(xb_ld(&bar[XB_XGEN(x)]) == gen, bar);
      __builtin_amdgcn_fence(__ATOMIC_ACQUIRE, "agent");
      asm volatile("s_waitcnt vmcnt(0)" ::: "memory");
    }
  }
  __syncthreads();
}
__device__ __forceinline__ void run_phase(const Params& p, const int ph, const int rep) {
  int code;
  switch (ph) {
    case 0: code = 0; break;
    case 1: code = 1 | (0 << 4) | (0 << 8); break;
    case 2: code = 2 | (0 << 8); break;
    case 3: code = 1 | (2 << 4) | (0 << 8); break;
    case 4: code = 3 | (1 << 8); break;
    case 5: code = 1 | (0 << 4) | (1 << 8); break;
    case 6: code = 1 | (1 << 4) | (1 << 8); break;
    case 7: code = 2 | (1 << 8); break;
    case 8: code = 1 | (2 << 4) | (1 << 8); break;
    case 9: code = 3 | (2 << 8); break;
    case 10: code = 1 | (0 << 4) | (2 << 8); break;
    case 11: code = 2 | (2 << 8); break;
    case 12: code = 1 | (2 << 4) | (2 << 8); break;
    case 13: code = 3 | (3 << 8); break;
    case 14: code = 1 | (0 << 4) | (3 << 8); break;
    case 15: code = 1 | (1 << 4) | (3 << 8); break;
    case 16: code = 2 | (3 << 8); break;
    case 17: code = 1 | (2 << 4) | (3 << 8); break;
    default: code = 4; break;
  }
  const int type = code & 15, kind = (code >> 4) & 15, l = code >> 8;
  if (type == 0) prologue(p);
  else if (type == 1) gemm_phase(p, kind, l);
  else if (type == 2) mix_phase(p, l, rep);
  else if (type == 3) prep_phase(p, l);
  else final_phase(p);
}
constexpr int NPHASE = 19;

__global__ void __launch_bounds__(512) mega(Params p) {
  __shared__ uint4 xb_words;
  if (threadIdx.x == 0) {
    xb_words = make_uint4(0u, 0u, 0u, 0u);
    (void)xb_add(&((unsigned*)(p.ws + WS_XBAR))[XB_XCNT(xb_xcc_id())], 1u);
  }
  __syncthreads();
  for (int ph = p.ph_lo; ph <= p.ph_hi; ++ph) {
    const int nrep = ((PROBE_MASK >> ph) & 1u) ? 2 : 1;
    for (int rep = 0; rep < nrep; ++rep) {
      run_phase(p, ph, rep);
      if (ph < p.ph_hi || rep + 1 < nrep) {
        if (p.ph_hi < 0) cg::this_grid().sync();
        grid_barrier((unsigned*)(p.ws + WS_XBAR), (volatile XB_LAS unsigned*)&xb_words);
      }
    }
  }
}

extern "C" void kernel_launch(void* const* d_in, const int* in_sizes, int n_in, void* d_out, int out_size, void* d_ws, size_t ws_size,
                              hipStream_t stream) {
  static int grid = 0;
  if (grid == 0) {
    if (n_in != 31 || ws_size < WS_END) { fprintf(stderr, "kernel_launch: unexpected n_in %d / ws %zu (need %zu)\n", n_in, ws_size, (size_t)WS_END); grid = -1; return; }
    int dev = 0, cus = 0, per_cu = 0;
    hipGetDevice(&dev);
    hipDeviceGetAttribute(&cus, hipDeviceAttributeMultiprocessorCount, dev);
    if (hipFuncSetAttribute((const void*)mega, hipFuncAttributeMaxDynamicSharedMemorySize, LDS_BYTES) != hipSuccess) { fprintf(stderr, "hipFuncSetAttribute failed\n"); grid = -1; return; }
    hipOccupancyMaxActiveBlocksPerMultiprocessor(&per_cu, (const void*)mega, 512, LDS_BYTES);
    if (per_cu < 1) { fprintf(stderr, "occupancy query says %d blocks/CU\n", per_cu); per_cu = 1; }
    (void)hipGetLastError();
    grid = cus * per_cu;
  }
  if (grid < 0) return;
  Params p{};
  for (int i = 0; i < 31; ++i) p.in[i] = (const float*)d_in[i];
  p.out = (float*)d_out; p.ws = (char*)d_ws;
  if (hipMemsetAsync((char*)d_ws + WS_CTRL, 0, 4096 + 16384, stream) != hipSuccess) { fprintf(stderr, "kernel_launch: control-word memset failed\n"); return; }
#if COOP
  p.ph_lo = 0; p.ph_hi = NPHASE - 1;
  void* args[] = {&p};
  hipError_t e = hipLaunchCooperativeKernel((const void*)mega, dim3(grid), dim3(512), args, LDS_BYTES, stream);
  if (e != hipSuccess) fprintf(stderr, "cooperative launch failed: %s (grid %d)\n", hipGetErrorString(e), grid);
#else
  for (int ph = 0; ph < NPHASE; ++ph) {
    p.ph_lo = ph; p.ph_hi = ph;
    hipLaunchKernelGGL(mega, dim3(grid), dim3(512), LDS_BYTES, stream, p);
  }
#endif
}
```

```cpp
#include <hip/hip_runtime.h>
#include <hip/hip_cooperative_groups.h>
#include <cstdio>
#include <cstdint>
namespace cg = cooperative_groups;

#ifndef COOP
#define COOP 1
#endif
#ifndef PROBE_SUB
#define PROBE_SUB 0
#endif
#ifndef PROBE_MASK
#define PROBE_MASK 0u
#endif

typedef unsigned short bfr;
typedef short bf16x8 __attribute__((ext_vector_type(8)));
typedef short bf16x4 __attribute__((ext_vector_type(4)));
typedef float f32x4 __attribute__((ext_vector_type(4)));
typedef unsigned u32x2 __attribute__((ext_vector_type(2)));
typedef unsigned u32x4 __attribute__((ext_vector_type(4)));

constexpr int NTOK = 17408, NPR = 16384, DM = 1024, INC = 5120, BRW = 1536;
constexpr int LDS_BYTES = 139264;
constexpr size_t O_YP = 0, O_SHP = 17825792, O_SRP = 19922944, O_SSP = 20971520, O_MK = 20987904, O_MV = 25182208,
                 O_SHS = 29376512, O_SRS = 62930944, O_SSS = 79708160;
constexpr size_t WS_CTRL = 0;
constexpr size_t WS_XBAR = 4096;
constexpr size_t WS_WTIN = 4096 + 16384;
constexpr size_t WTIN_L = (size_t)5888 * 1024;
constexpr size_t WS_WTOUT = WS_WTIN + 4 * WTIN_L * 2;
constexpr size_t WS_WTMEM = WS_WTOUT + (size_t)4 * 1024 * 1536 * 2;
constexpr size_t WS_W2T = WS_WTMEM + (size_t)4 * 1024 * 1024 * 2;
constexpr size_t WS_MEMN = WS_W2T + (size_t)2 * 3072 * 256 * 2;
constexpr size_t WS_XRES = WS_MEMN + (size_t)4 * 2048 * 1024 * 2;
constexpr size_t HA_SZ = (size_t)NTOK * 1024;
constexpr size_t WS_HA = WS_XRES + (size_t)NTOK * 1024 * 4;
constexpr size_t WS_PROJ = WS_HA + 6 * HA_SZ * 2;
constexpr size_t WS_ALORA = WS_PROJ + (size_t)NTOK * INC * 2;
constexpr size_t WS_LUP = WS_ALORA + (size_t)NTOK * 256 * 2;
constexpr size_t WS_VFIRST = WS_LUP + (size_t)NTOK * 3072 * 2;
constexpr size_t WS_BRANCH = WS_VFIRST + HA_SZ * 2;
constexpr size_t WS_PART = WS_BRANCH + (size_t)NTOK * BRW * 2;
constexpr size_t WS_END = WS_PART + (size_t)5 * 1024 * 1024 * 4;

struct Params {
  const float* in[31];
  float* out;
  char* ws;
  int ph_lo, ph_hi;
};
enum { I_XP = 0, I_XS, I_MEM, I_SH, I_SR, I_SS, I_CK, I_CV, I_NG, I_WIN, I_WOUT, I_MNG, I_WMEM, I_LB, I_ONG, I_MU, I_W0, I_W1, I_W2,
       I_A0, I_A1, I_A2, I_V0, I_V1, I_V2, I_KK, I_KA, I_RK, I_LG, I_LBI, I_FG };

__device__ __forceinline__ unsigned cvt_pk(float lo, float hi) { unsigned r; asm("v_cvt_pk_bf16_f32 %0, %1, %2" : "=v"(r) : "v"(lo), "v"(hi)); return r; }
__device__ __forceinline__ bfr f2bf(float f) { return (bfr)(cvt_pk(f, 0.f) & 0xffff); }
__device__ __forceinline__ float bf2f(unsigned h) { return __uint_as_float(h << 16); }
__device__ __forceinline__ float bflo(unsigned w) { return __uint_as_float(w << 16); }
__device__ __forceinline__ float bfhi(unsigned w) { return __uint_as_float(w & 0xffff0000u); }
__device__ __forceinline__ float frcp(float x) { return __builtin_amdgcn_rcpf(x); }
__device__ __forceinline__ float sigmoidf_(float x) { return frcp(1.f + __expf(-x)); }
template <int CTRL> __device__ __forceinline__ float dppf(float x) {
  return __builtin_bit_cast(float, __builtin_amdgcn_update_dpp(0, __builtin_bit_cast(int, x), CTRL, 0xf, 0xf, true));
}
__device__ __forceinline__ float wave_sum(float v) {
  v += dppf<0xB1>(v); v += dppf<0x4E>(v); v += dppf<0x141>(v); v += dppf<0x140>(v);
  const int iv = __builtin_bit_cast(int, v);
  float r = __builtin_bit_cast(float, __builtin_amdgcn_readlane(iv, 0));
  r += __builtin_bit_cast(float, __builtin_amdgcn_readlane(iv, 16));
  r += __builtin_bit_cast(float, __builtin_amdgcn_readlane(iv, 32));
  r += __builtin_bit_cast(float, __builtin_amdgcn_readlane(iv, 48));
  return r;
}
__device__ __forceinline__ float bperm(float v, int srclane) { return __builtin_bit_cast(float, __builtin_amdgcn_ds_bpermute(srclane << 2, __builtin_bit_cast(int, v))); }
__device__ __forceinline__ float sum8(float v) {
  v += dppf<0xB1>(v);
  v += dppf<0x4E>(v);
  v += dppf<0x141>(v);
  return v;
}
__device__ __forceinline__ const float* pin(const Params& p, int i) { asm volatile("" : "+s"(i)); return p.in[i]; }
__device__ __forceinline__ const float* xin_row(const Params& p, int g) {
  return g < NPR ? pin(p, I_XP) + (size_t)g * DM : pin(p, I_XS) + (size_t)(g - NPR) * DM;
}

__device__ __forceinline__ int tidx() { int t = threadIdx.x; asm volatile("" : "+v"(t)); return t; }
__device__ __forceinline__ int bidx() { int b = blockIdx.x; asm volatile("" : "+s"(b)); return b; }
__device__ __forceinline__ int wperm(int n) { const int c = n & 31; return (n & ~31) + ((c >> 2) & 1) * 16 + (c >> 3) * 4 + (c & 3); }

__device__ __forceinline__ void transpose_job(const float* __restrict__ src, int Ks, int Ns, bfr* __restrict__ dst, int ldd, int rot) {
  extern __shared__ __attribute__((aligned(16))) char smem[];
  bfr* T = (bfr*)smem;
  const int tid = tidx();
  const int tn = Ns >> 6, ntile = (Ks >> 6) * tn;
  const int G = gridDim.x;
  for (int tile = (bidx() + rot) % G; tile < ntile; tile += G) {
    const int k0 = (tile / tn) << 6, n0 = (tile % tn) << 6;
    const int kl = tid >> 3, nc = (tid & 7) << 3;
    const float* s = src + (size_t)(k0 + kl) * Ns + n0 + nc;
    const float4 a = *(const float4*)s, b = *(const float4*)(s + 4);
    __syncthreads();
    T[(nc + 0) * 72 + kl] = f2bf(a.x); T[(nc + 1) * 72 + kl] = f2bf(a.y); T[(nc + 2) * 72 + kl] = f2bf(a.z); T[(nc + 3) * 72 + kl] = f2bf(a.w);
    T[(nc + 4) * 72 + kl] = f2bf(b.x); T[(nc + 5) * 72 + kl] = f2bf(b.y); T[(nc + 6) * 72 + kl] = f2bf(b.z); T[(nc + 7) * 72 + kl] = f2bf(b.w);
    __syncthreads();
    const int nl = tid >> 3, kc = (tid & 7) << 3;
    const u32x4 v = *(const u32x4*)(T + nl * 72 + kc);
    *(u32x4*)(dst + (size_t)wperm(n0 + nl) * ldd + k0 + kc) = v;
  }
}

__device__ __forceinline__ void prologue(const Params& p) {
  const int tid = tidx(), wid = tid >> 6, lane = tid & 63;
  const int G = gridDim.x;
  char* ws = p.ws;
  int rot = 0;
  for (int l = 0; l < 4; ++l) {
    transpose_job(pin(p, I_WIN) + (size_t)l * DM * INC, DM, INC, (bfr*)(ws + WS_WTIN) + l * WTIN_L, DM, rot); rot = (rot + G - (1280 % G)) % G;
    transpose_job(pin(p, I_WOUT) + (size_t)l * BRW * DM, BRW, DM, (bfr*)(ws + WS_WTOUT) + (size_t)l * DM * BRW, BRW, rot); rot = (rot + G - (384 % G)) % G;
    transpose_job(pin(p, I_WMEM) + (size_t)l * DM * DM, DM, DM, (bfr*)(ws + WS_WTMEM) + (size_t)l * DM * DM, DM, rot); rot = (rot + G - (256 % G)) % G;
  }
  const int gt = bidx() * 512 + tid, nth = G * 512;
  for (int j = 0; j < 2; ++j) {
    bfr* dst = (bfr*)(ws + WS_WTIN) + (size_t)(2 * j + 1) * WTIN_L + (size_t)5120 * 1024;
    const float* w1 = pin(p, I_W1) + (size_t)j * 1024 * 64;
    const float* a1 = pin(p, I_A1) + (size_t)j * 1024 * 64;
    const float* v1 = pin(p, I_V1);
    for (int it = gt; it < 768 * 128; it += nth) {
      const int n = it % 768, kc = it / 768;
      const int seg = n >> 8, c = n & 255;
      float v[8];
#pragma unroll
      for (int e = 0; e < 8; ++e) {
        const int k = kc * 8 + e;
        float x = 0.f;
        if (seg == 0) { if (c < 64) x = w1[k * 64 + c]; }
        else if (seg == 1) { if (c < 64) x = a1[k * 64 + c]; }
        else { if (j == 1 && c < 32) x = v1[k * 32 + c]; }
        v[e] = x;
      }
      u32x4 o; o.x = cvt_pk(v[0], v[1]); o.y = cvt_pk(v[2], v[3]); o.z = cvt_pk(v[4], v[5]); o.w = cvt_pk(v[6], v[7]);
      *(u32x4*)(dst + (size_t)wperm(n) * 1024 + kc * 8) = o;
    }
    bfr* d2 = (bfr*)(ws + WS_W2T) + (size_t)j * 3072 * 256;
    const float* w2 = pin(p, I_W2) + (size_t)j * 64 * 1024;
    const float* a2 = pin(p, I_A2) + (size_t)j * 64 * 1024;
    const float* v2 = pin(p, I_V2);
    for (int it = gt; it < 3072 * 32; it += nth) {
      const int n = it % 3072, kc = it / 3072;
      const int seg = n >> 10, c = n & 1023;
      float v[8];
#pragma unroll
      for (int e = 0; e < 8; ++e) {
        const int k = kc * 8 + e;
        float x = 0.f;
        if (seg == 0) { if (k < 64) x = w2[k * 1024 + c]; }
        else if (seg == 1) { if (k >= 64 && k < 128) x = a2[(k - 64) * 1024 + c]; }
        else { if (j == 1 && k >= 128 && k < 160) x = v2[(k - 128) * 1024 + c]; }
        v[e] = x;
      }
      u32x4 o; o.x = cvt_pk(v[0], v[1]); o.y = cvt_pk(v[2], v[3]); o.z = cvt_pk(v[4], v[5]); o.w = cvt_pk(v[6], v[7]);
      *(u32x4*)(d2 + (size_t)wperm(n) * 256 + kc * 8) = o;
    }
  }
  const int gw = bidx() * 8 + wid, nw = G * 8;
  for (int row = gw; row < 2048 + NTOK; row += nw) {
    const bool ismem = row < 2048;
    const float* src = ismem ? pin(p, I_MEM) + (size_t)row * DM : xin_row(p, row - 2048);
    float4 x[4]; float ss = 0.f;
#pragma unroll
    for (int i = 0; i < 4; ++i) { x[i] = *(const float4*)(src + lane * 4 + i * 256); ss += x[i].x * x[i].x + x[i].y * x[i].y + x[i].z * x[i].z + x[i].w * x[i].w; }
    ss = wave_sum(ss);
    const float rs = rsqrtf(ss * (1.f / 1024.f) + 1e-6f);
    if (ismem) {
      for (int l = 0; l < 4; ++l) {
        bfr* dst = (bfr*)(ws + WS_MEMN) + ((size_t)l * 2048 + row) * DM;
#pragma unroll
        for (int i = 0; i < 4; ++i) {
          const float4 g = *(const float4*)(pin(p, I_MNG) + l * DM + lane * 4 + i * 256);
          u32x2 o; o.x = cvt_pk(x[i].x * rs * g.x, x[i].y * rs * g.y); o.y = cvt_pk(x[i].z * rs * g.z, x[i].w * rs * g.w);
          *(u32x2*)(dst + lane * 4 + i * 256) = o;
        }
      }
    } else {
      float* xr = (float*)(ws + WS_XRES) + (size_t)(row - 2048) * DM;
#pragma unroll
      for (int i = 0; i < 4; ++i) *(float4*)(xr + lane * 4 + i * 256) = x[i];
      bfr* dst = (bfr*)(ws + WS_HA) + (size_t)(row - 2048) * DM;
#pragma unroll
      for (int i = 0; i < 4; ++i) {
        const float4 g = *(const float4*)(pin(p, I_NG) + lane * 4 + i * 256);
        u32x2 o; o.x = cvt_pk(x[i].x * rs * g.x, x[i].y * rs * g.y); o.y = cvt_pk(x[i].z * rs * g.z, x[i].w * rs * g.w);
        *(u32x2*)(dst + lane * 4 + i * 256) = o;
      }
    }
  }
}

__device__ __forceinline__ void load_xrow(const Params& p, const int g, const int lane, float4 (&x)[4]) {
  const float* s = (const float*)(p.ws + WS_XRES) + (size_t)g * DM;
#pragma unroll
  for (int i = 0; i < 4; ++i) x[i] = *(const float4*)(s + lane * 4 + i * 256);
  if (g >= NPR) {
#pragma unroll
    for (int k = 0; k < 5; ++k) {
      const float* q = (const float*)(p.ws + WS_PART) + ((size_t)k * 1024 + (g - NPR)) * DM;
#pragma unroll
      for (int i = 0; i < 4; ++i) { const float4 t = *(const float4*)(q + lane * 4 + i * 256); x[i].x += t.x; x[i].y += t.y; x[i].z += t.z; x[i].w += t.w; }
    }
  }
}
__device__ __forceinline__ void prep_phase(const Params& p, int l) {
  const int tid = tidx(), wid = tid >> 6, lane = tid & 63;
  const bool rw = (l & 1);
  const int j = l >> 1;
  const float* xres = (const float*)(p.ws + WS_XRES);
  bfr* hA = (bfr*)(p.ws + WS_HA);
  const float* ng = pin(p, I_NG) + l * DM;
  const float* mu = pin(p, I_MU) + (size_t)j * 5 * DM;
  const int gw = bidx() * 8 + wid, nw = gridDim.x * 8;
  constexpr int NCH = 1920;
  for (int task = gw; task < NCH + 128; task += nw) {
    const bool smpt = (task & 15) == 15;
    const int ch = task - ((task + 1) >> 4);
    const int g0 = smpt ? NPR + (task >> 4) * 8 : (int)(((long)ch * NPR) / NCH);
    const int nrows = smpt ? 8 : (int)(((long)(ch + 1) * NPR) / NCH) - g0;
    float hp[16];
    if (rw) {
      const bool smp = g0 >= NPR;
      const int t0 = smp ? ((g0 - NPR) & 7) : (g0 & 2047);
      if (t0 == 0) {
        if (smp) {
          const float* s = pin(p, I_SS) + ((size_t)j * 128 + ((g0 - NPR) >> 3)) * DM;
#pragma unroll
          for (int i = 0; i < 4; ++i) { const float4 v = *(const float4*)(s + lane * 4 + i * 256); hp[i * 4] = v.x; hp[i * 4 + 1] = v.y; hp[i * 4 + 2] = v.z; hp[i * 4 + 3] = v.w; }
        } else {
#pragma unroll
          for (int i = 0; i < 16; ++i) hp[i] = 0.f;
        }
      } else {
        float4 x[4]; float ss = 0.f;
        load_xrow(p, g0 - 1, lane, x);
#pragma unroll
        for (int i = 0; i < 4; ++i) ss += x[i].x * x[i].x + x[i].y * x[i].y + x[i].z * x[i].z + x[i].w * x[i].w;
        ss = wave_sum(ss);
        const float rs = rsqrtf(ss * (1.f / 1024.f) + 1e-6f);
#pragma unroll
        for (int i = 0; i < 4; ++i) {
          const float4 g = *(const float4*)(ng + lane * 4 + i * 256);
          hp[i * 4] = x[i].x * rs * g.x; hp[i * 4 + 1] = x[i].y * rs * g.y; hp[i * 4 + 2] = x[i].z * rs * g.z; hp[i * 4 + 3] = x[i].w * rs * g.w;
        }
      }
    }
    for (int r = 0; r < nrows; ++r) {
      const int g = g0 + r;
      if (rw && r > 0 && g < NPR && (g & 2047) == 0) {
#pragma unroll
        for (int i = 0; i < 16; ++i) hp[i] = 0.f;
      }
      float4 x[4]; float ss = 0.f;
      load_xrow(p, g, lane, x);
      if (g >= NPR) {
        float* xw = (float*)(p.ws + WS_XRES) + (size_t)g * DM;
#pragma unroll
        for (int i = 0; i < 4; ++i) *(float4*)(xw + lane * 4 + i * 256) = x[i];
      }
#pragma unroll
      for (int i = 0; i < 4; ++i) ss += x[i].x * x[i].x + x[i].y * x[i].y + x[i].z * x[i].z + x[i].w * x[i].w;
      ss = wave_sum(ss);
      const float rs = rsqrtf(ss * (1.f / 1024.f) + 1e-6f);
      float h[16];
#pragma unroll
      for (int i = 0; i < 4; ++i) {
        const float4 gg = *(const float4*)(ng + lane * 4 + i * 256);
        h[i * 4] = x[i].x * rs * gg.x; h[i * 4 + 1] = x[i].y * rs * gg.y; h[i * 4 + 2] = x[i].z * rs * gg.z; h[i * 4 + 3] = x[i].w * rs * gg.w;
        u32x2 o; o.x = cvt_pk(h[i * 4], h[i * 4 + 1]); o.y = cvt_pk(h[i * 4 + 2], h[i * 4 + 3]);
        *(u32x2*)(hA + (size_t)g * DM + lane * 4 + i * 256) = o;
      }
      if (rw) {
#pragma unroll
        for (int m = 0; m < 5; ++m) {
          bfr* dst = hA + (size_t)(1 + m) * HA_SZ + (size_t)g * DM;
#pragma unroll
          for (int i = 0; i < 4; ++i) {
            const float4 mm = *(const float4*)(mu + m * DM + lane * 4 + i * 256);
            const float a0 = h[i * 4] + (hp[i * 4] - h[i * 4]) * mm.x, a1 = h[i * 4 + 1] + (hp[i * 4 + 1] - h[i * 4 + 1]) * mm.y;
            const float a2 = h[i * 4 + 2] + (hp[i * 4 + 2] - h[i * 4 + 2]) * mm.z, a3 = h[i * 4 + 3] + (hp[i * 4 + 3] - h[i * 4 + 3]) * mm.w;
            u32x2 o; o.x = cvt_pk(a0, a1); o.y = cvt_pk(a2, a3);
            *(u32x2*)(dst + lane * 4 + i * 256) = o;
          }
        }
        const bool smp = g >= NPR;
        const int t = smp ? ((g - NPR) & 7) : (g & 2047);
        if (t == (smp ? 7 : 2047)) {
          float* o = p.out + (smp ? O_SSS + ((size_t)j * 128 + ((g - NPR) >> 3)) * DM : O_SSP + ((size_t)j * 8 + (g >> 11)) * DM);
#pragma unroll
          for (int i = 0; i < 4; ++i) *(float4*)(o + lane * 4 + i * 256) = make_float4(h[i * 4], h[i * 4 + 1], h[i * 4 + 2], h[i * 4 + 3]);
        }
#pragma unroll
        for (int i = 0; i < 16; ++i) hp[i] = h[i];
      }
    }
  }
}

__device__ __forceinline__ void final_phase(const Params& p) {
  const int tid = tidx(), wid = tid >> 6, lane = tid & 63;
  const float* xres = (const float*)(p.ws + WS_XRES);
  const float* fg = pin(p, I_FG);
  const int gw = bidx() * 8 + wid, nw = gridDim.x * 8;
  for (int g = gw; g < NTOK; g += nw) {
    float4 x[4]; float ss = 0.f;
    load_xrow(p, g, lane, x);
#pragma unroll
    for (int i = 0; i < 4; ++i) ss += x[i].x * x[i].x + x[i].y * x[i].y + x[i].z * x[i].z + x[i].w * x[i].w;
    ss = wave_sum(ss);
    const float rs = rsqrtf(ss * (1.f / 1024.f) + 1e-6f);
    float* o = p.out + O_YP + (size_t)g * DM;
#pragma unroll
    for (int i = 0; i < 4; ++i) {
      const float4 gg = *(const float4*)(fg + lane * 4 + i * 256);
      *(float4*)(o + lane * 4 + i * 256) = make_float4(x[i].x * rs * gg.x, x[i].y * rs * gg.y, x[i].z * rs * gg.z, x[i].w * rs * gg.w);
    }
  }
}

constexpr int BM = 256, BK = 64, HALF = 128, HT = HALF * BK;
__device__ __forceinline__ int lds_byte(int r, int c) {
  int st = (r >> 4) * 2 + (c >> 5), rr = r & 15, cc = c & 31, ob = rr * 64 + cc * 2;
  return st * 1024 + (ob ^ (((ob >> 9) & 1) << 5));
}
__device__ __forceinline__ void stage_rc(int b, int& R, int& C) {
  int st = b / 1024, sb = b % 1024, swz = sb ^ (((sb >> 9) & 1) << 5);
  R = (st >> 1) * 16 + swz / 64; C = (st & 1) * 32 + (swz % 64) / 2;
}

enum { EM_PROJ = 0, EM_G1R, EM_MEM, EM_LUP, EM_OUT, EM_OUTA };

__device__ __forceinline__ void epilogue(const Params& p, const int mode, const int l, const f32x4 (&acc)[2][2][4][2],
                                         const int pm, const int pn, const int wr, const int wc, const int fr, const int fq) {
  const int j = (l & 255) >> 1;
#pragma unroll
  for (int ai = 0; ai < 2; ++ai)
#pragma unroll
    for (int m = 0; m < 4; ++m) {
      const int row = pm * BM + ai * HALF + wr * 64 + m * 16 + fr;
#pragma unroll
      for (int bj = 0; bj < 2; ++bj)
#pragma unroll
        for (int n = 0; n < 2; ++n) {
          const int col = pn * BM + bj * HALF + wc * 32 + fq * 8 + n * 4;
          const f32x4 v = acc[ai][bj][m][n];
          if (mode == EM_PROJ || (mode == EM_G1R && pn < 20)) {
            if (n == 0) {
              f32x4 v0 = v, v1 = acc[ai][bj][m][1];
              if (pn >= 14) {
#pragma unroll
                for (int e = 0; e < 4; ++e) { v0[e] *= sigmoidf_(v0[e]); v1[e] *= sigmoidf_(v1[e]); }
              }
              u32x4 o; o.x = cvt_pk(v0[0], v0[1]); o.y = cvt_pk(v0[2], v0[3]); o.z = cvt_pk(v1[0], v1[1]); o.w = cvt_pk(v1[2], v1[3]);
              *(u32x4*)((bfr*)(p.ws + WS_PROJ) + (size_t)row * INC + col) = o;
            }
          } else if (mode == EM_G1R) {
            bfr* al = (bfr*)(p.ws + WS_ALORA) + (size_t)row * 256;
            const int c = col & 255;
            if (pn == 20) {
              if (c < 64) {
                float t[4];
#pragma unroll
                for (int e = 0; e < 4; ++e) { const float ex = __expf(2.f * v[e]); t[e] = 1.f - 2.f * frcp(ex + 1.f); }
                u32x2 o; o.x = cvt_pk(t[0], t[1]); o.y = cvt_pk(t[2], t[3]);
                *(u32x2*)(al + c) = o;
              }
            } else if (pn == 21) {
              const int lim = (l == 3) ? 128 : 256;
              if (64 + c < lim) {
                u32x2 o; o.x = 0u; o.y = 0u;
                if (c < 64) { o.x = cvt_pk(v[0], v[1]); o.y = cvt_pk(v[2], v[3]); }
                *(u32x2*)(al + 64 + c) = o;
              }
            } else {
              if (128 + c < 256) {
                u32x2 o; o.x = 0u; o.y = 0u;
                if (c < 32) { o.x = cvt_pk(v[0], v[1]); o.y = cvt_pk(v[2], v[3]); }
                *(u32x2*)(al + 128 + c) = o;
              }
            }
          } else if (mode == EM_MEM) {
            const int lm = pm >> 3, r2 = row & 2047;
            float* o = p.out + (col < 512 ? O_MK : O_MV) + ((size_t)lm * 2048 + r2) * 512 + (col & 511);
            *(f32x4*)o = v;
          } else if (mode == EM_LUP) {
            const int seg = col >> 10, c = col & 1023;
            float t[4];
            if (seg == 0) {
              const float4 b = *(const float4*)(pin(p, I_W0) + j * DM + c);
              const float bb[4] = {b.x, b.y, b.z, b.w};
#pragma unroll
              for (int e = 0; e < 4; ++e) {
                const float x = bb[e] + v[e];
                t[e] = -0.6065306597126334f * sigmoidf_(x);
              }
            } else if (seg == 1) {
              const float4 b = *(const float4*)(pin(p, I_A0) + j * DM + c);
              t[0] = sigmoidf_(b.x + v[0]); t[1] = sigmoidf_(b.y + v[1]); t[2] = sigmoidf_(b.z + v[2]); t[3] = sigmoidf_(b.w + v[3]);
            } else {
              const float4 b = *(const float4*)(pin(p, I_V0) + c);
              t[0] = sigmoidf_(b.x + v[0]); t[1] = sigmoidf_(b.y + v[1]); t[2] = sigmoidf_(b.z + v[2]); t[3] = sigmoidf_(b.w + v[3]);
            }
            u32x2 o; o.x = cvt_pk(t[0], t[1]); o.y = cvt_pk(t[2], t[3]);
            *(u32x2*)((bfr*)(p.ws + WS_LUP) + (size_t)row * 3072 + col) = o;
          } else if (mode == EM_OUT) {
            float* xo = (float*)(p.ws + WS_XRES) + (size_t)row * DM + col;
            const f32x4 x = *(const f32x4*)xo;
            *(f32x4*)xo = x + v;
          } else {
            *(f32x4*)((float*)(p.ws + WS_PART) + ((size_t)((l >> 8) - 1) * 1024 + (row - NPR)) * DM + col) = v;
          }
        }
    }
}

__device__ __forceinline__ void gemm_unit(const Params& p, const bfr* __restrict__ A, const bfr* __restrict__ Bt, const int K, const int kt0, const int nt,
                                          const int pm, const int pn, const int mode, const int l) {
  extern __shared__ __attribute__((aligned(16))) char smem[];
  bfr* shm = (bfr*)smem;
#define SA(b, h) (shm + ((b) * 2 + (h)) * HT)
#define SB(b, h) (shm + (4 + (b) * 2 + (h)) * HT)
#define STAGE(P, BASE, br, kt) do { const bfr* _g = (BASE) + (size_t)(br) * K + (kt0 + (kt)) * BK + goff; \
    __builtin_amdgcn_global_load_lds((const unsigned*)_g, (unsigned*)((char*)(P) + tid * 16), 16, 0, 0); \
    __builtin_amdgcn_global_load_lds((const unsigned*)(_g + (size_t)64 * K), (unsigned*)((char*)(P) + tid * 16 + 8192), 16, 0, 0); } while (0)
#define LDA(dst, b, h) for (int m = 0; m < 4; ++m) for (int k = 0; k < 2; ++k) \
    dst[m][k] = *reinterpret_cast<const bf16x8*>((char*)SA(b, h) + lds_byte(wr * 64 + m * 16 + fr, k * 32 + fq * 8))
#define LDB(dst, b, h) for (int n = 0; n < 2; ++n) for (int k = 0; k < 2; ++k) \
    dst[n][k] = *reinterpret_cast<const bf16x8*>((char*)SB(b, h) + lds_byte(wc * 32 + n * 16 + fr, k * 32 + fq * 8))
#define MMA(ai, bj, At, Bt_) do { __builtin_amdgcn_s_setprio(1); \
    for (int m = 0; m < 4; ++m) for (int n = 0; n < 2; ++n) for (int k = 0; k < 2; ++k) \
      acc[ai][bj][m][n] = __builtin_amdgcn_mfma_f32_16x16x32_bf16(Bt_[n][k], At[m][k], acc[ai][bj][m][n], 0, 0, 0); \
    __builtin_amdgcn_s_setprio(0); } while (0)
#define WAIT_V(n) asm volatile("s_waitcnt vmcnt(" #n ")" ::: "memory")
#define WAIT_L(n) asm volatile("s_waitcnt lgkmcnt(" #n ")" ::: "memory")
#define BAR __builtin_amdgcn_s_barrier()
#define SCHED __builtin_amdgcn_sched_barrier(0)
  const int tid = tidx();
  const int brow = pm * BM, bcol = pn * BM;
  const int wid = tid >> 6, lane = tid & 63, wr = wid >> 2, wc = wid & 3, fr = lane & 15, fq = lane >> 4;
  int R0, C0; stage_rc(tid * 16, R0, C0);
  const int goff = R0 * K + C0;
  f32x4 acc[2][2][4][2] = {};
  bf16x8 At[4][2], B0[2][2], B1[2][2];
  STAGE(SB(0, 0), Bt, bcol, 0); STAGE(SA(0, 0), A, brow, 0);
  STAGE(SB(0, 1), Bt, bcol + HALF, 0); STAGE(SA(0, 1), A, brow + HALF, 0);
  if (wr == 1) BAR;
  WAIT_V(4); BAR;
  STAGE(SB(1, 0), Bt, bcol, 1); STAGE(SA(1, 0), A, brow, 1); STAGE(SB(1, 1), Bt, bcol + HALF, 1);
  WAIT_V(6); BAR;
  for (int t = 0; t < nt - 2; t += 2) {
    LDB(B0, 0, 0); SCHED; LDA(At, 0, 0); STAGE(SA(1, 1), A, brow + HALF, t + 1);
    WAIT_L(8); BAR; WAIT_L(0); MMA(0, 0, At, B0); BAR; SCHED;
    LDB(B1, 0, 1); STAGE(SB(0, 0), Bt, bcol, t + 2);
    BAR; WAIT_L(0); MMA(0, 1, At, B1); BAR;
    LDA(At, 0, 1); STAGE(SA(0, 0), A, brow, t + 2);
    BAR; WAIT_L(0); MMA(1, 0, At, B0); BAR; SCHED;
    STAGE(SB(0, 1), Bt, bcol + HALF, t + 2);
    WAIT_V(6); BAR; MMA(1, 1, At, B1); BAR;
    LDB(B0, 1, 0); SCHED; LDA(At, 1, 0); STAGE(SA(0, 1), A, brow + HALF, t + 2);
    WAIT_L(8); BAR; WAIT_L(0); MMA(0, 0, At, B0); BAR; SCHED;
    LDB(B1, 1, 1); STAGE(SB(1, 0), Bt, bcol, t + 3);
    BAR; WAIT_L(0); MMA(0, 1, At, B1); BAR;
    LDA(At, 1, 1); STAGE(SA(1, 0), A, brow, t + 3);
    BAR; WAIT_L(0); MMA(1, 0, At, B0); BAR; SCHED;
    STAGE(SB(1, 1), Bt, bcol + HALF, t + 3);
    WAIT_V(6); BAR; MMA(1, 1, At, B1); BAR;
  }
  { LDB(B0, 0, 0); LDA(At, 0, 0); STAGE(SA(1, 1), A, brow + HALF, nt - 1);
    BAR; WAIT_L(0); MMA(0, 0, At, B0); BAR;
    LDB(B1, 0, 1); BAR; WAIT_L(0); MMA(0, 1, At, B1); BAR;
    LDA(At, 0, 1); WAIT_V(4); BAR; WAIT_L(0); MMA(1, 0, At, B0); MMA(1, 1, At, B1); BAR; }
  { LDB(B0, 1, 0); LDA(At, 1, 0); WAIT_V(2); BAR; WAIT_L(0); MMA(0, 0, At, B0); BAR;
    LDB(B1, 1, 1); WAIT_V(0); BAR; WAIT_L(0); MMA(0, 1, At, B1); BAR;
    LDA(At, 1, 1); BAR; WAIT_L(0); MMA(1, 0, At, B0); MMA(1, 1, At, B1); BAR; }
  if (wr == 0) BAR;
  epilogue(p, mode, l, acc, pm, pn, wr, wc, fr, fq);
  WAIT_V(0);
#undef SA
#undef SB
}

__device__ __forceinline__ bool unit_order(int i, int c, int G, int nM, int nN, int& pm, int& pn) {
  const int nwg = nM * nN;
  const long L = (long)i * G + c; if (L >= nwg) return false;
  int wgid = (int)L; { const int q = nwg / 8, r = nwg % 8, xcd = wgid % 8, off = wgid / 8; wgid = (xcd < r ? xcd * (q + 1) : r * (q + 1) + (xcd - r) * q) + off; }
  const int nig = 8 * nN, gid = wgid / nig, fm = gid * 8, gsz = (nM - fm) < 8 ? (nM - fm) : 8;
  pm = fm + ((wgid % nig) % gsz); pn = (wgid % nig) / gsz; return true;
}

__device__ __forceinline__ void gemm_phase(const Params& p, const int kind, const int l) {
  const int G = gridDim.x;
  const int j = l >> 1;
  const bool rw = l & 1;
  char* ws = p.ws;
  const bfr* hA = (const bfr*)(ws + WS_HA);
  int nM = NTOK / BM, nN, K, mode;
  const bfr* Bt;
  if (kind == 0) { nN = rw ? (l == 3 ? 23 : 22) : 20; K = 1024; mode = rw ? EM_G1R : EM_PROJ; Bt = (const bfr*)(ws + WS_WTIN) + l * WTIN_L; }
  else if (kind == 1) { nN = (l == 3) ? 12 : 8; K = 256; mode = EM_LUP; Bt = (const bfr*)(ws + WS_W2T) + (size_t)j * 3072 * 256; }
  else { nN = 4; K = 1536; mode = EM_OUT; Bt = (const bfr*)(ws + WS_WTOUT) + (size_t)l * DM * BRW; }
  int pm, pn;
  const int nwg1 = nM * nN;
  const bool withmem = (kind == 0 && l == 0);
  const int c2 = (bidx() + G - (nwg1 % G)) % G;
  int seg = 0, i = 0;
  for (;;) {
    const bfr* A; const bfr* B = Bt; int KK = K, md = mode, kt0 = 0, nt = K / BK, lk = l;
    if (kind == 2) {
      const int t = bidx() + G * i;
      if (t >= 256 + 96) break;
      ++i;
      A = (const bfr*)(ws + WS_BRANCH);
      if (t < 256) { pm = (t & 7) * 8 + (t >> 5); pn = (t >> 3) & 3; }
      else { const int v = t - 256, rem = v % 24, ks = rem % 6; pm = 64 + v / 24; pn = rem / 6; kt0 = ks * 4; nt = 4; if (ks) { md = EM_OUTA; lk = l | (ks << 8); } }
    } else {
      bool ok;
      if (seg == 0) ok = unit_order(i, bidx(), G, nM, nN, pm, pn);
      else ok = unit_order(i, c2, G, 32, 4, pm, pn);
      if (!ok) { if (seg == 0 && withmem) { seg = 1; i = 0; continue; } break; }
      ++i;
      if (seg == 1) { A = (const bfr*)(ws + WS_MEMN); B = (const bfr*)(ws + WS_WTMEM) + (size_t)(pm >> 3) * DM * DM; KK = 1024; nt = 16; md = EM_MEM; }
      else if (kind == 0) {
        int sel = 0;
        if (rw) sel = pn < 4 ? 1 : pn < 8 ? 3 : pn < 12 ? 4 : pn < 20 ? 0 : pn == 20 ? 2 : pn == 21 ? 5 : 4;
        A = hA + (size_t)sel * HA_SZ;
      } else A = (const bfr*)(ws + WS_ALORA);
    }
    gemm_unit(p, A, B, KK, kt0, nt, pm, pn, md, lk);
  }
}

__device__ __forceinline__ void xattn_unit(const Params& p, const float* __restrict__ kb, const float* __restrict__ vb, const int g0, const int ntok, const int head) {
  extern __shared__ __attribute__((aligned(16))) char smem[];
  bfr* Ks = (bfr*)smem;
  bfr* Vt = Ks + 256 * 136;
  const int tid = tidx(), wid = tid >> 6, lane = tid & 63, fr = lane & 15, fq = lane >> 4;
#pragma unroll 4
  for (int i = 0; i < 16; ++i) {
    const int idx = tid + i * 512, row = idx >> 5, c4 = (idx & 31) << 2;
    const float4 v = *(const float4*)(kb + (size_t)row * 512 + c4);
    u32x2 o; o.x = cvt_pk(v.x, v.y); o.y = cvt_pk(v.z, v.w);
    *(u32x2*)(Ks + row * 136 + c4) = o;
  }
  {
    const int pp = lane & 7, dd = lane >> 3;
#pragma unroll 4
    for (int it = 0; it < 8; ++it) {
      const int wq = it * 8 + wid, mb = wq & 15, db = wq >> 4;
      const int m0 = mb * 16 + 2 * pp, d0 = db * 32 + dd * 4;
      const float4 a = *(const float4*)(vb + (size_t)m0 * 512 + d0);
      const float4 b = *(const float4*)(vb + (size_t)(m0 + 1) * 512 + d0);
      *(unsigned*)(Vt + (d0 + 0) * 260 + m0) = cvt_pk(a.x, b.x);
      *(unsigned*)(Vt + (d0 + 1) * 260 + m0) = cvt_pk(a.y, b.y);
      *(unsigned*)(Vt + (d0 + 2) * 260 + m0) = cvt_pk(a.z, b.z);
      *(unsigned*)(Vt + (d0 + 3) * 260 + m0) = cvt_pk(a.w, b.w);
    }
  }
  __syncthreads();
  if (wid * 16 < ntok) {
    const bfr* proj = (const bfr*)(p.ws + WS_PROJ);
    int tl = wid * 16 + fr; if (tl > ntok - 1) tl = ntok - 1;
    const bfr* qrow = proj + (size_t)(g0 + tl) * INC + 3072 + head * 128;
    bf16x8 qf[4];
#pragma unroll
    for (int ks = 0; ks < 4; ++ks) qf[ks] = *(const bf16x8*)(qrow + ks * 32 + fq * 8);
    f32x4 sc[16];
#pragma unroll
    for (int mt = 0; mt < 16; ++mt) {
      f32x4 a = {0.f, 0.f, 0.f, 0.f};
#pragma unroll
      for (int ks = 0; ks < 4; ++ks) {
        const bf16x8 kf = *(const bf16x8*)(Ks + (mt * 16 + fr) * 136 + ks * 32 + fq * 8);
        a = __builtin_amdgcn_mfma_f32_16x16x32_bf16(kf, qf[ks], a, 0, 0, 0);
      }
      sc[mt] = a;
    }
    float mx = -3.0e38f;
#pragma unroll
    for (int mt = 0; mt < 16; ++mt) mx = fmaxf(mx, fmaxf(fmaxf(sc[mt][0], sc[mt][1]), fmaxf(sc[mt][2], sc[mt][3])));
    mx = fmaxf(mx, bperm(mx, lane ^ 16)); mx = fmaxf(mx, bperm(mx, lane ^ 32));
    const float cs = 0.08838834764831845f * 1.4426950408889634f;
    float sum = 0.f;
#pragma unroll
    for (int mt = 0; mt < 16; ++mt)
#pragma unroll
      for (int e = 0; e < 4; ++e) { const float pe = exp2f((sc[mt][e] - mx) * cs); sc[mt][e] = pe; sum += pe; }
    sum += bperm(sum, lane ^ 16); sum += bperm(sum, lane ^ 32);
    const float inv = frcp(sum);
    bf16x8 pf[8];
#pragma unroll
    for (int u = 0; u < 8; ++u) {
      u32x4 w; w.x = cvt_pk(sc[2 * u][0], sc[2 * u][1]); w.y = cvt_pk(sc[2 * u][2], sc[2 * u][3]);
      w.z = cvt_pk(sc[2 * u + 1][0], sc[2 * u + 1][1]); w.w = cvt_pk(sc[2 * u + 1][2], sc[2 * u + 1][3]);
      pf[u] = __builtin_bit_cast(bf16x8, w);
    }
    const bool tvalid = (wid * 16 + fr) < ntok;
    const int g = g0 + tl;
    const bfr* gate = proj + (size_t)g * INC + 3584 + 1024 + head * 128;
    bfr* br = (bfr*)(p.ws + WS_BRANCH) + (size_t)g * BRW + 1024 + head * 128;
#pragma unroll
    for (int dt = 0; dt < 8; ++dt) {
      f32x4 a = {0.f, 0.f, 0.f, 0.f};
#pragma unroll
      for (int u = 0; u < 8; ++u) {
        const bfr* vr = Vt + (dt * 16 + fr) * 260 + fq * 4;
        u32x4 w;
        const u32x2 lo = *(const u32x2*)(vr + (2 * u) * 16), hi = *(const u32x2*)(vr + (2 * u + 1) * 16);
        w.x = lo.x; w.y = lo.y; w.z = hi.x; w.w = hi.y;
        a = __builtin_amdgcn_mfma_f32_16x16x32_bf16(__builtin_bit_cast(bf16x8, w), pf[u], a, 0, 0, 0);
      }
      if (tvalid) {
        const u32x2 gw = *(const u32x2*)(gate + dt * 16 + fq * 4);
        const float g0f = bflo(gw.x), g1f = bfhi(gw.x), g2f = bflo(gw.y), g3f = bfhi(gw.y);
        u32x2 o;
        o.x = cvt_pk(a[0] * inv * g0f, a[1] * inv * g1f);
        o.y = cvt_pk(a[2] * inv * g2f, a[3] * inv * g3f);
        *(u32x2*)(br + dt * 16 + fq * 4) = o;
      }
    }
  }
  __syncthreads();
}

struct HgRaw { u32x2 q, f, v, g; };
__device__ __forceinline__ void hg_load(HgRaw& r, const bfr* __restrict__ proj, const int g0, const int T, const int sbi, const int h,
                                        const int wid, const int fr, const int fq, const int tid) {
  const int t0 = sbi * 16;
  if (t0 + fr < T) {
    const bfr* pr = proj + (size_t)(g0 + t0 + fr) * INC + h * 128 + wid * 16 + fq * 4;
    r.q = *(const u32x2*)pr; r.f = *(const u32x2*)(pr + 1024); r.g = *(const u32x2*)(pr + 3584);
  }
  const int vt = tid >> 5, dv4 = (tid & 31) << 2;
  if (t0 + vt < T) r.v = *(const u32x2*)(proj + (size_t)(g0 + t0 + vt) * INC + 2048 + h * 128 + dv4);
}
constexpr int KTS = 18;
constexpr int HG_SET = 16 * 136 * 2 + 128 * KTS * 2;

__device__ __forceinline__ void hgrn_unit(const Params& p, const int l, const bool smp, const int b, const int h) {
  extern __shared__ __attribute__((aligned(16))) char smem[];
  bfr* lds0 = (bfr*)smem;
  float* decb = (float*)(lds0 + 2 * HG_SET);
  float* redb = decb + 256;
  const int tid = tidx(), wid = tid >> 6, lane = tid & 63, fr = lane & 15, fq = lane >> 4;
  const int j = l >> 1;
  const bfr* proj = (const bfr*)(p.ws + WS_PROJ);
  bfr* branch = (bfr*)(p.ws + WS_BRANCH);
  const int g0 = smp ? NPR + b * 8 : b * 2048;
  const int T = smp ? 8 : 2048;
  const int nsub = (T + 15) >> 4;
  f32x4 S[8];
  if (smp) {
    const float* s0 = pin(p, I_SH) + (((size_t)j * 128 + b) * 8 + h) * 16384;
#pragma unroll
    for (int kt = 0; kt < 8; ++kt)
#pragma unroll
      for (int e = 0; e < 4; ++e) S[kt][e] = s0[(kt * 16 + fq * 4 + e) * 128 + wid * 16 + fr];
  } else {
#pragma unroll
    for (int kt = 0; kt < 8; ++kt) S[kt] = (f32x4){0.f, 0.f, 0.f, 0.f};
  }
  const int dkp = wid * 16 + fq * 4;
  float lb[4];
#pragma unroll
  for (int e = 0; e < 4; ++e) {
    if (j == 0) lb[e] = 0.f;
    else { const int c = h * 128 + dkp + e; lb[e] = sigmoidf_(pin(p, I_LB)[1024 + c] - pin(p, I_LB)[c]); }
  }
  float og[4];
#pragma unroll
  for (int e = 0; e < 4; ++e) og[e] = pin(p, I_ONG)[j * 128 + wid * 16 + fq * 4 + e];

  HgRaw raw[4];
#pragma unroll
  for (int u = 0; u < 4; ++u) { raw[u].q = raw[u].f = raw[u].v = raw[u].g = (u32x2){0u, 0u}; hg_load(raw[u], proj, g0, T, u, h, wid, fr, fq, tid); }
  u32x2 gsave[2] = {(u32x2){0u, 0u}, (u32x2){0u, 0u}};
  f32x4 oprev = {0.f, 0.f, 0.f, 0.f};

  for (int i4 = 0; i4 < nsub; i4 += 4) {
#pragma unroll
    for (int u = 0; u < 4; ++u) {
      const int i = i4 + u;
      if (i < nsub) {
        const int s = u & 1;
        bfr* Qs = lds0 + s * HG_SET; bfr* Kh = Qs + 16 * 136; bfr* Kt = Kh + 16 * 136; bfr* Vt = Kt + 128 * KTS;
        float* dec = decb + s * 128; float* red = redb + s * 128;
        {
          const int sb = i * 16;
          const bool valid = (sb + fr) < T;
          float q[4], P[4], kv[4];
          const float qz[4] = {bflo(raw[u].q.x), bfhi(raw[u].q.x), bflo(raw[u].q.y), bfhi(raw[u].q.y)};
          const float fz[4] = {bflo(raw[u].f.x), bfhi(raw[u].f.x), bflo(raw[u].f.y), bfhi(raw[u].f.y)};
#pragma unroll
          for (int e = 0; e < 4; ++e) {
            const float sg = sigmoidf_(fz[e]);
            const float f = fmaxf(lb[e] + (1.f - lb[e]) * sg, 1e-30f);
            P[e] = valid ? f : 1.f;
            kv[e] = valid ? (1.f - lb[e]) * (1.f - sg) : 0.f;
            q[e] = valid ? qz[e] * sigmoidf_(qz[e]) : 0.f;
          }
#pragma unroll
          for (int e = 0; e < 4; ++e) {
            P[e] *= __builtin_bit_cast(float, __builtin_amdgcn_update_dpp(0x3f800000, __builtin_bit_cast(int, P[e]), 0x111, 0xf, 0xf, false));
            P[e] *= __builtin_bit_cast(float, __builtin_amdgcn_update_dpp(0x3f800000, __builtin_bit_cast(int, P[e]), 0x112, 0xf, 0xf, false));
            P[e] *= __builtin_bit_cast(float, __builtin_amdgcn_update_dpp(0x3f800000, __builtin_bit_cast(int, P[e]), 0x114, 0xf, 0xf, false));
            P[e] *= __builtin_bit_cast(float, __builtin_amdgcn_update_dpp(0x3f800000, __builtin_bit_cast(int, P[e]), 0x118, 0xf, 0xf, false));
          }
          float qt[4], kh[4], kt[4];
#pragma unroll
          for (int e = 0; e < 4; ++e) {
            const float Pl = bperm(P[e], lane | 15);
            const float inv = frcp(fmaxf(P[e], 1e-30f));
            qt[e] = q[e] * P[e]; kh[e] = kv[e] * inv; kt[e] = kh[e] * Pl;
          }
          if (fr == 15) *(f32x4*)(dec + dkp) = (f32x4){P[0], P[1], P[2], P[3]};
          const int kpos = (wid >> 1) * 32 + fq * 8 + (wid & 1) * 4;
          u32x2 o; o.x = cvt_pk(qt[0], qt[1]); o.y = cvt_pk(qt[2], qt[3]);
          *(u32x2*)(Qs + fr * 136 + kpos) = o;
          o.x = cvt_pk(kh[0], kh[1]); o.y = cvt_pk(kh[2], kh[3]);
          *(u32x2*)(Kh + fr * 136 + kpos) = o;
          { const unsigned k01 = cvt_pk(kt[0], kt[1]), k23 = cvt_pk(kt[2], kt[3]);
            Kt[(dkp + 0) * KTS + fr] = (bfr)(k01 & 0xffff); Kt[(dkp + 1) * KTS + fr] = (bfr)(k01 >> 16);
            Kt[(dkp + 2) * KTS + fr] = (bfr)(k23 & 0xffff); Kt[(dkp + 3) * KTS + fr] = (bfr)(k23 >> 16); }
          const int vt = tid >> 5, dv4 = (tid & 31) << 2;
          const bool vv = (sb + vt) < T;
          const unsigned vx = vv ? raw[u].v.x : 0u, vy = vv ? raw[u].v.y : 0u;
          Vt[(dv4 + 0) * KTS + vt] = (bfr)(vx & 0xffff); Vt[(dv4 + 1) * KTS + vt] = (bfr)(vx >> 16);
          Vt[(dv4 + 2) * KTS + vt] = (bfr)(vy & 0xffff); Vt[(dv4 + 3) * KTS + vt] = (bfr)(vy >> 16);
          gsave[s] = raw[u].g;
          hg_load(raw[u], proj, g0, T, i + 4, h, wid, fr, fq, tid);
        }
        __syncthreads();
        if (i > 0) {
          const float* redp = redb + (s ^ 1) * 128;
          float tot = 0.f;
#pragma unroll
          for (int w = 0; w < 8; ++w) tot += redp[fr * 8 + w];
          const float rs = rsqrtf(tot * (1.f / 128.f) + 1e-6f);
          const int tk = (i - 1) * 16 + fr;
          if (tk < T) {
            const u32x2 gw = gsave[s ^ 1];
            const float gg[4] = {bflo(gw.x), bfhi(gw.x), bflo(gw.y), bfhi(gw.y)};
            float r[4];
#pragma unroll
            for (int e = 0; e < 4; ++e) r[e] = oprev[e] * rs * og[e] * gg[e];
            u32x2 o; o.x = cvt_pk(r[0], r[1]); o.y = cvt_pk(r[2], r[3]);
            *(u32x2*)(branch + (size_t)(g0 + tk) * BRW + h * 128 + wid * 16 + fq * 4) = o;
          }
        }
        {
          bf16x8 qp[4], kp[4];
#pragma unroll
          for (int uu = 0; uu < 4; ++uu) {
            qp[uu] = *(const bf16x8*)(Qs + fr * 136 + uu * 32 + fq * 8);
            kp[uu] = *(const bf16x8*)(Kh + fr * 136 + uu * 32 + fq * 8);
          }
          f32x4 at = {0.f, 0.f, 0.f, 0.f};
#pragma unroll
          for (int uu = 0; uu < 4; ++uu) at = __builtin_amdgcn_mfma_f32_16x16x32_bf16(kp[uu], qp[uu], at, 0, 0, 0);
#pragma unroll
          for (int e = 0; e < 4; ++e) if (fq * 4 + e > fr) at[e] = 0.f;
          u32x2 aw; aw.x = cvt_pk(at[0], at[1]); aw.y = cvt_pk(at[2], at[3]);
          const bf16x4 a4 = __builtin_bit_cast(bf16x4, aw);
          u32x2 vfw; { const unsigned* q2 = (const unsigned*)(Vt + (wid * 16 + fr) * KTS + fq * 4); vfw.x = q2[0]; vfw.y = q2[1]; }
          const bf16x4 vf = __builtin_bit_cast(bf16x4, vfw);
          const bf16x8 vf8 = {vf[0], vf[1], vf[2], vf[3], 0, 0, 0, 0}, a8 = {a4[0], a4[1], a4[2], a4[3], 0, 0, 0, 0};
          f32x4 oacc = __builtin_amdgcn_mfma_f32_16x16x32_bf16(vf8, a8, (f32x4){0.f, 0.f, 0.f, 0.f}, 0, 0, 0);
#pragma unroll
          for (int uu = 0; uu < 4; ++uu) {
            u32x4 w; w.x = cvt_pk(S[2 * uu][0], S[2 * uu][1]); w.y = cvt_pk(S[2 * uu][2], S[2 * uu][3]);
            w.z = cvt_pk(S[2 * uu + 1][0], S[2 * uu + 1][1]); w.w = cvt_pk(S[2 * uu + 1][2], S[2 * uu + 1][3]);
            oacc = __builtin_amdgcn_mfma_f32_16x16x32_bf16(__builtin_bit_cast(bf16x8, w), qp[uu], oacc, 0, 0, 0);
          }
#pragma unroll
          for (int kt = 0; kt < 8; ++kt) {
            const f32x4 d = *(const f32x4*)(dec + kt * 16 + fq * 4);
            u32x2 kfw; { const unsigned* q2 = (const unsigned*)(Kt + (kt * 16 + fr) * KTS + fq * 4); kfw.x = q2[0]; kfw.y = q2[1]; }
            const bf16x4 kf = __builtin_bit_cast(bf16x4, kfw);
            const bf16x8 kf8 = {kf[0], kf[1], kf[2], kf[3], 0, 0, 0, 0};
            S[kt] = __builtin_amdgcn_mfma_f32_16x16x32_bf16(kf8, vf8, S[kt] * d, 0, 0, 0);
          }
          float ss = oacc[0] * oacc[0] + oacc[1] * oacc[1] + oacc[2] * oacc[2] + oacc[3] * oacc[3];
          ss += bperm(ss, lane ^ 16); ss += bperm(ss, lane ^ 32);
          if (fq == 0) red[fr * 8 + wid] = ss;
          oprev = oacc;
        }
      }
    }
  }
  __syncthreads();
  {
    const int i = nsub - 1, s = i & 1;
    const float* redp = redb + s * 128;
    float tot = 0.f;
#pragma unroll
    for (int w = 0; w < 8; ++w) tot += redp[fr * 8 + w];
    const float rs = rsqrtf(tot * (1.f / 128.f) + 1e-6f);
    const int tk = i * 16 + fr;
    if (tk < T) {
      const u32x2 gw = gsave[s];
      const float gg[4] = {bflo(gw.x), bfhi(gw.x), bflo(gw.y), bfhi(gw.y)};
      float r[4];
#pragma unroll
      for (int e = 0; e < 4; ++e) r[e] = oprev[e] * rs * og[e] * gg[e];
      u32x2 o; o.x = cvt_pk(r[0], r[1]); o.y = cvt_pk(r[2], r[3]);
      *(u32x2*)(branch + (size_t)(g0 + tk) * BRW + h * 128 + wid * 16 + fq * 4) = o;
    }
  }
  float* so = p.out + (smp ? O_SHS + (((size_t)j * 128 + b) * 8 + h) * 16384 : O_SHP + (((size_t)j * 8 + b) * 8 + h) * 16384);
#pragma unroll
  for (int kt = 0; kt < 8; ++kt)
#pragma unroll
    for (int e = 0; e < 4; ++e) so[(kt * 16 + fq * 4 + e) * 128 + wid * 16 + fr] = S[kt][e];
  __syncthreads();
}

#define LDS_BARRIER() do { asm volatile("s_waitcnt lgkmcnt(0)" ::: "memory"); __builtin_amdgcn_s_barrier(); asm volatile("" ::: "memory"); } while (0)
typedef float f32x2 __attribute__((ext_vector_type(2)));
struct RwRaw { u32x2 r, k, v, gt, ew, a, vg, vf; };
constexpr int RW_SET = 7 * 1024;
struct RwCtx {
  const bfr* proj; const bfr* lup; const bfr* vfsrc; bfr* vdst; bfr* branch;
  int vgoff, vfld;
  int g0, T, tsl, cq4, C4;
  f32x4 kkw, kaw, rkw, lng, lnb;
};
__device__ __forceinline__ float sum16(float v) {
  v += dppf<0xB1>(v); v += dppf<0x4E>(v); v += dppf<0x141>(v); v += dppf<0x140>(v);
  return v;
}
__device__ __forceinline__ f32x4 unpk4(const u32x2 w) { return (f32x4){bflo(w.x), bfhi(w.x), bflo(w.y), bfhi(w.y)}; }
__device__ __forceinline__ void rw_load(RwRaw& raw, const RwCtx& c, const int tile) {
  int tok = tile * 16 + c.tsl; tok = tok < c.T ? tok : c.T - 1;
  const size_t g = (size_t)(c.g0 + tok);
  const bfr* pr = c.proj + g * INC + c.C4;
  raw.r = *(const u32x2*)pr; raw.k = *(const u32x2*)(pr + 1024); raw.v = *(const u32x2*)(pr + 2048); raw.gt = *(const u32x2*)(pr + 3584);
  const bfr* pl = c.lup + g * 3072 + c.C4;
  raw.ew = *(const u32x2*)pl; raw.a = *(const u32x2*)(pl + 1024); raw.vg = *(const u32x2*)(pl + c.vgoff);
  raw.vf = *(const u32x2*)(c.vfsrc + g * c.vfld + c.C4);
}
__device__ __forceinline__ void rw_prep(const RwRaw& raw, f32x4& bon, f32x4& gt, float* __restrict__ L, const RwCtx& c, const int tile) {
  int tok = tile * 16 + c.tsl; tok = tok < c.T ? tok : c.T - 1;
  const int tt = tok & 15;
  const size_t g = (size_t)(c.g0 + tok);
  const f32x4 r = unpk4(raw.r), k = unpk4(raw.k), ew = unpk4(raw.ew), a = unpk4(raw.a);
  f32x4 v = unpk4(raw.v);
  *(u32x2*)(c.vdst + g * DM + c.C4) = raw.v;
  v = v + (unpk4(raw.vf) - v) * unpk4(raw.vg);
  f32x4 dcy; dcy[0] = __expf(ew[0]); dcy[1] = __expf(ew[1]); dcy[2] = __expf(ew[2]); dcy[3] = __expf(ew[3]);
  f32x4 kk = k * c.kkw;
  const float n2 = sum16((kk[0] * kk[0] + kk[1] * kk[1]) + (kk[2] * kk[2] + kk[3] * kk[3]));
  const float inv = __builtin_amdgcn_rsqf(fmaxf(n2, 1e-24f));
  kk = kk * inv;
  const f32x4 k2 = k * (1.f + (a - 1.f) * c.kaw);
  const f32x4 rk = r * k2 * c.rkw;
  const float sb = sum16((rk[0] + rk[1]) + (rk[2] + rk[3]));
  bon = v * sb;
  gt = unpk4(raw.gt);
  const int o = tt * 64 + c.cq4;
  *(f32x4*)(L + 0 * 1024 + o) = r; *(f32x4*)(L + 1 * 1024 + o) = dcy; *(f32x4*)(L + 2 * 1024 + o) = k2; *(f32x4*)(L + 3 * 1024 + o) = v;
  *(f32x4*)(L + 4 * 1024 + o) = -kk; *(f32x4*)(L + 5 * 1024 + o) = kk * a;
}
__device__ __forceinline__ void rw_post(const f32x4 bon, const f32x4 gt, const float* __restrict__ L, const RwCtx& c, const int tile) {
  int tok = tile * 16 + c.tsl; tok = tok < c.T ? tok : c.T - 1;
  const int tt = tok & 15;
  const size_t g = (size_t)(c.g0 + tok);
  const f32x4 y = *(const f32x4*)(L + 6 * 1024 + tt * 64 + c.cq4);
  const float mean = sum16((y[0] + y[1]) + (y[2] + y[3])) * (1.f / 64.f);
  const f32x4 d = y - mean;
  const float var = sum16((d[0] * d[0] + d[1] * d[1]) + (d[2] * d[2] + d[3] * d[3])) * (1.f / 64.f);
  f32x4 o = d * rsqrtf(var + 64e-5f) * c.lng + c.lnb + bon;
  o = o * gt;
  u32x2 w; w.x = cvt_pk(o[0], o[1]); w.y = cvt_pk(o[2], o[3]);
  *(u32x2*)(c.branch + g * BRW + c.C4) = w;
}
struct RwVec { f32x4 r0, r1, w0, w1, k0, k1, a0, a1, b0, b1; float v; };
__device__ __forceinline__ void rw_ldvec(RwVec& x, const float* __restrict__ L, const int t, const int row, const int c0) {
  x.r0 = *(const f32x4*)(L + 0 * 1024 + t * 64 + c0); x.r1 = *(const f32x4*)(L + 0 * 1024 + t * 64 + c0 + 4);
  x.w0 = *(const f32x4*)(L + 1 * 1024 + t * 64 + c0); x.w1 = *(const f32x4*)(L + 1 * 1024 + t * 64 + c0 + 4);
  x.k0 = *(const f32x4*)(L + 2 * 1024 + t * 64 + c0); x.k1 = *(const f32x4*)(L + 2 * 1024 + t * 64 + c0 + 4);
  x.v = L[3 * 1024 + t * 64 + row];
  x.a0 = *(const f32x4*)(L + 4 * 1024 + t * 64 + c0); x.a1 = *(const f32x4*)(L + 4 * 1024 + t * 64 + c0 + 4);
  x.b0 = *(const f32x4*)(L + 5 * 1024 + t * 64 + c0); x.b1 = *(const f32x4*)(L + 5 * 1024 + t * 64 + c0 + 4);
}
template <int NST>
__device__ __forceinline__ void rw_scan(f32x2 (&S)[4], float* __restrict__ L, const int row, const int c0, const int cg) {
  RwVec cur, nxt;
  rw_ldvec(cur, L, 0, row, c0);
  float yp[NST / 2], ra[NST / 2];
  const bool hi = (cg & 4) != 0, b1 = (cg & 2) != 0, b0 = (cg & 1) != 0;
#pragma unroll
  for (int t = 0; t < NST; ++t) {
    if (t + 1 < NST) rw_ldvec(nxt, L, t + 1, row, c0);
    const f32x2 av[4] = {{cur.a0[0], cur.a0[1]}, {cur.a0[2], cur.a0[3]}, {cur.a1[0], cur.a1[1]}, {cur.a1[2], cur.a1[3]}};
    const f32x2 wv[4] = {{cur.w0[0], cur.w0[1]}, {cur.w0[2], cur.w0[3]}, {cur.w1[0], cur.w1[1]}, {cur.w1[2], cur.w1[3]}};
    const f32x2 bv[4] = {{cur.b0[0], cur.b0[1]}, {cur.b0[2], cur.b0[3]}, {cur.b1[0], cur.b1[1]}, {cur.b1[2], cur.b1[3]}};
    const f32x2 kv[4] = {{cur.k0[0], cur.k0[1]}, {cur.k0[2], cur.k0[3]}, {cur.k1[0], cur.k1[1]}, {cur.k1[2], cur.k1[3]}};
    const f32x2 rv[4] = {{cur.r0[0], cur.r0[1]}, {cur.r0[2], cur.r0[3]}, {cur.r1[0], cur.r1[1]}, {cur.r1[2], cur.r1[3]}};
    const f32x2 vi2 = {cur.v, cur.v};
    f32x2 pa = S[0] * av[0] + S[1] * av[1];
    const f32x2 pb = S[2] * av[2] + S[3] * av[3];
    f32x2 n[4];
#pragma unroll
    for (int q = 0; q < 4; ++q) n[q] = S[q] * wv[q] + vi2 * kv[q];
    pa += pb;
    const float sa = sum8(pa[0] + pa[1]);
    const f32x2 sa2 = {sa, sa};
#pragma unroll
    for (int q = 0; q < 4; ++q) S[q] = sa2 * bv[q] + n[q];
    f32x2 ya = S[0] * rv[0] + S[1] * rv[1];
    const f32x2 yb = S[2] * rv[2] + S[3] * rv[3];
    ya += yb;
    if (t < NST / 2) yp[t] = ya[0] + ya[1];
    else { const float lo = yp[t - NST / 2], hv = ya[0] + ya[1]; const float mine = hi ? hv : lo, send = hi ? lo : hv; ra[t - NST / 2] = mine + dppf<0x141>(send); }
    cur = nxt;
  }
  float rb[NST / 4], rc[NST / 8];
#pragma unroll
  for (int k = 0; k < NST / 4; ++k) { const float mine = b1 ? ra[k + NST / 4] : ra[k], send = b1 ? ra[k] : ra[k + NST / 4]; rb[k] = mine + dppf<0x4E>(send); }
#pragma unroll
  for (int k = 0; k < NST / 8; ++k) { const float mine = b0 ? rb[k + NST / 8] : rb[k], send = b0 ? rb[k] : rb[k + NST / 8]; rc[k] = mine + dppf<0xB1>(send); }
  const int base = (hi ? NST / 2 : 0) + (b1 ? NST / 4 : 0) + (b0 ? NST / 8 : 0);
#pragma unroll
  for (int k = 0; k < NST / 8; ++k) L[6 * 1024 + (base + k) * 64 + row] = rc[k];
}

__device__ __forceinline__ void rwkv_unit(const Params& p, const int l, const bool smp, const int b, const int head) {
  extern __shared__ __attribute__((aligned(16))) char smem[];
  float* L0 = (float*)smem;
  float* L1 = L0 + RW_SET;
  RwCtx c;
  const int tid = tidx();
  const int wid = tid >> 6, lane = tid & 63;
  const int j = l >> 1;
  c.proj = (const bfr*)(p.ws + WS_PROJ);
  c.lup = (const bfr*)(p.ws + WS_LUP);
  c.vfsrc = (j == 0) ? c.proj + 2048 : (const bfr*)(p.ws + WS_VFIRST);
  c.vfld = (j == 0) ? INC : DM;
  c.vgoff = (j == 0) ? 1024 : 2048;
  c.vdst = (j == 0) ? (bfr*)(p.ws + WS_VFIRST) : (bfr*)(p.ws + WS_HA + 2 * HA_SZ * 2);
  c.branch = (bfr*)(p.ws + WS_BRANCH);
  c.g0 = smp ? NPR + b * 8 : b * 2048;
  c.T = smp ? 8 : 2048;
  c.tsl = 2 * wid + ((lane >> 4) & 1);
  c.cq4 = (lane & 15) * 4;
  c.C4 = head * 64 + c.cq4;
  const int cg = lane & 7, row = wid * 8 + (lane >> 3), c0 = cg * 8;
  f32x2 S[4];
  if (smp) {
    const float* s0 = pin(p, I_SR) + ((((size_t)j * 128 + b) * 16 + head) * 64 + row) * 64 + c0;
    const float4 a = *(const float4*)s0, bq = *(const float4*)(s0 + 4);
    S[0] = (f32x2){a.x, a.y}; S[1] = (f32x2){a.z, a.w}; S[2] = (f32x2){bq.x, bq.y}; S[3] = (f32x2){bq.z, bq.w};
  } else {
    S[0] = S[1] = S[2] = S[3] = (f32x2){0.f, 0.f};
  }
  c.kkw = *(const f32x4*)(pin(p, I_KK) + j * DM + c.C4); c.kaw = *(const f32x4*)(pin(p, I_KA) + j * DM + c.C4); c.rkw = *(const f32x4*)(pin(p, I_RK) + j * DM + c.C4);
  c.lng = *(const f32x4*)(pin(p, I_LG) + j * DM + c.C4); c.lnb = *(const f32x4*)(pin(p, I_LBI) + j * DM + c.C4);
  RwRaw rawA, rawB;
  f32x4 bonA, bonB, gtA, gtB;
  if (smp) {
    rw_load(rawA, c, 0);
    rw_prep(rawA, bonA, gtA, L0, c, 0);
    LDS_BARRIER();
    rw_scan<8>(S, L0, row, c0, cg);
    LDS_BARRIER();
    rw_post(bonA, gtA, L0, c, 0);
  } else {
    const int ntile = 128;
    rw_load(rawA, c, 0); rw_load(rawB, c, 1);
    rw_prep(rawA, bonA, gtA, L0, c, 0); rw_load(rawA, c, 2);
    LDS_BARRIER();
    rw_scan<16>(S, L0, row, c0, cg); rw_prep(rawB, bonB, gtB, L1, c, 1); rw_load(rawB, c, 3);
    LDS_BARRIER();
    for (int i = 1; i < ntile - 1; i += 2) {
      rw_post(bonA, gtA, L0, c, i - 1); rw_scan<16>(S, L1, row, c0, cg); rw_prep(rawA, bonA, gtA, L0, c, i + 1); rw_load(rawA, c, i + 3);
      LDS_BARRIER();
      rw_post(bonB, gtB, L1, c, i); rw_scan<16>(S, L0, row, c0, cg); rw_prep(rawB, bonB, gtB, L1, c, i + 2); rw_load(rawB, c, i + 4);
      LDS_BARRIER();
    }
    rw_post(bonA, gtA, L0, c, ntile - 2); rw_scan<16>(S, L1, row, c0, cg);
    LDS_BARRIER();
    rw_post(bonB, gtB, L1, c, ntile - 1);
  }
  float* so = p.out + (smp ? O_SRS + ((((size_t)j * 128 + b) * 16 + head) * 64 + row) * 64 + c0 : O_SRP + ((((size_t)j * 8 + b) * 16 + head) * 64 + row) * 64 + c0);
  *(float4*)so = make_float4(S[0][0], S[0][1], S[1][0], S[1][1]); *(float4*)(so + 4) = make_float4(S[2][0], S[2][1], S[3][0], S[3][1]);
  __syncthreads();
}

__device__ __forceinline__ void mix_phase(const Params& p, const int l, const int rep) {
  __shared__ int s_item;
  unsigned* ctr = (unsigned*)(p.ws + WS_CTRL) + l + 4 * rep;
  const bool rw = l & 1;
  const int nP = rw ? 128 : 64, nS = rw ? 2048 : 1024;
  const int nitems = nP + nS + 1024;
  for (;;) {
    __syncthreads();
    if (tidx() == 0) s_item = (int)atomicAdd(ctr, 1u);
    __syncthreads();
    int it = s_item;
    if (rep > 0 && PROBE_SUB == 1) { if (it >= nP) break; }
    if (rep > 0 && PROBE_SUB == 2) { it += nP; if (it >= nP + nS) break; }
    if (rep > 0 && PROBE_SUB == 3) { it += nP + nS; }
    if (it >= nitems) break;
    if (it < nP + nS) {
      const bool smp = it >= nP;
      if (smp) it -= nP;
      if (rw) rwkv_unit(p, l, smp, it >> 4, it & 15); else hgrn_unit(p, l, smp, it >> 3, it & 7);
    } else {
      it -= nP + nS;
      const float* kb; const float* vb; int g0, ntok, head;
      if (it < 512) {
        const int b = it >> 6, blk = it & 15; head = (it >> 4) & 3;
        const size_t off = ((size_t)(l * 8 + b) * 256) * 512 + head * 128;
        kb = p.out + O_MK + off; vb = p.out + O_MV + off; g0 = b * 2048 + blk * 128; ntok = 128;
      } else {
        it -= 512;
        const int b = it >> 2; head = it & 3;
        const size_t off = ((size_t)(l * 128 + b) * 256) * 512 + head * 128;
        kb = pin(p, I_CK) + off; vb = pin(p, I_CV) + off; g0 = NPR + b * 8; ntok = 8;
      }
      xattn_unit(p, kb, vb, g0, ntok, head);
    }
  }
}

#define XB_TMO      128
#define XB_XCNT(j)  (256  + 64 * (j))
#define XB_XSUB(j)  (1280 + 64 * (j))
#define XB_XGEN(j)  (2304 + 64 * (j))
#define XB_TOP      3328
#define XB_TOPGEN   3392
#define XB_SPIN_CAP (1u << 18)
#define XB_LAS __attribute__((address_space(3)))
__device__ __forceinline__ unsigned xb_ld(unsigned* p)              { return __hip_atomic_load(p, __ATOMIC_RELAXED, __HIP_MEMORY_SCOPE_AGENT); }
__device__ __forceinline__ unsigned xb_add(unsigned* p, unsigned v) { return __hip_atomic_fetch_add(p, v, __ATOMIC_RELAXED, __HIP_MEMORY_SCOPE_AGENT); }
__device__ __forceinline__ unsigned xb_xcc_id() { return (unsigned)__builtin_amdgcn_s_getreg((3 << 11) | 20) & 0xFu; }
#define XB_SPIN(cond, bar) do { unsigned _sp = 0; while (cond) { __builtin_amdgcn_s_sleep(1); \
    if ((++_sp & 255u) == 0u) { if (xb_ld(&(bar)[XB_TMO])) break; if (_sp > XB_SPIN_CAP) { atomicAdd(&(bar)[XB_TMO], 1u); break; } } } } while (0)
__device__ __forceinline__ void xcd_barrier_complete(unsigned* bar, unsigned x, unsigned& nloc, unsigned& nx) {
  const unsigned G = gridDim.x;
  unsigned sum, cnt, mine, sp = 0u;
  for (;;) {
    sum = 0u; cnt = 0u; mine = 0u;
#pragma unroll
    for (unsigned j = 0; j < 16; ++j) { const unsigned c = xb_ld(&bar[XB_XCNT(j)]); sum += c; cnt += (c > 0u) ? 1u : 0u; mine = (j == x) ? c : mine; }
    if (sum == G) break;
    __builtin_amdgcn_s_sleep(1);
    if ((++sp & 255u) == 0u) { if (xb_ld(&bar[XB_TMO])) break; if (sp > XB_SPIN_CAP) { atomicAdd(&bar[XB_TMO], 1u); break; } }
  }
  nloc = mine > 0u ? mine : 1u; nx = cnt > 0u ? cnt : 1u;
}
__device__ __forceinline__ void grid_barrier(unsigned* bar, volatile XB_LAS unsigned* st) {
  asm volatile("s_waitcnt vmcnt(0)" ::: "memory");
  __syncthreads();
  if (threadIdx.x == 0) {
    const unsigned x = xb_xcc_id();
    __builtin_amdgcn_s_waitcnt(0);
    unsigned nloc = st[0], nx = st[1];
    if (nloc == 0u) { xcd_barrier_complete(bar, x, nloc, nx); st[0] = nloc; st[1] = nx; }
    const unsigned old = xb_add(&bar[XB_XSUB(x)], 1u);
    const unsigned gen = old / nloc;
    if (old + 1u == (gen + 1u) * nloc) {
      __builtin_amdgcn_fence(__ATOMIC_RELEASE, "agent");
      asm volatile("s_waitcnt vmcnt(0)" ::: "memory");
      const unsigned og = xb_add(&bar[XB_TOP], 1u);
      const unsigned tg = og / nx;
      if (og + 1u == (tg + 1u) * nx) xb_add(&bar[XB_TOPGEN], 1u);
      else XB_SPIN(xb_ld(&bar[XB_TOPGEN]) == tg, bar);
      __builtin_amdgcn_fence(__ATOMIC_ACQUIRE, "agent");
      xb_add(&bar[XB_XGEN(x)], 1u);
      asm volatile("s_waitcnt vmcnt(0)" ::: "memory");
    } else {
      XB_SPIN(xb_ld(&bar[XB_XGEN(x)]) == gen, bar);
      __builtin_amdgcn_fence(__ATOMIC_ACQUIRE, "agent");
      asm volatile("s_waitcnt vmcnt(0)" ::: "memory");
    }
  }
  __syncthreads();
}
__device__ __forceinline__ void run_phase(const Params& p, const int ph, const int rep) {
  int code;
  switch (ph) {
    case 0: code = 0; break;
    case 1: code = 1 | (0 << 4) | (0 << 8); break;
    case 2: code = 2 | (0 << 8); break;
    case 3: code = 1 | (2 << 4) | (0 << 8); break;
    case 4: code = 3 | (1 << 8); break;
    case 5: code = 1 | (0 << 4) | (1 << 8); break;
    case 6: code = 1 | (1 << 4) | (1 << 8); break;
    case 7: code = 2 | (1 << 8); break;
    case 8: code = 1 | (2 << 4) | (1 << 8); break;
    case 9: code = 3 | (2 << 8); break;
    case 10: code = 1 | (0 << 4) | (2 << 8); break;
    case 11: code = 2 | (2 << 8); break;
    case 12: code = 1 | (2 << 4) | (2 << 8); break;
    case 13: code = 3 | (3 << 8); break;
    case 14: code = 1 | (0 << 4) | (3 << 8); break;
    case 15: code = 1 | (1 << 4) | (3 << 8); break;
    case 16: code = 2 | (3 << 8); break;
    case 17: code = 1 | (2 << 4) | (3 << 8); break;
    default: code = 4; break;
  }
  const int type = code & 15, kind = (code >> 4) & 15, l = code >> 8;
  if (type == 0) prologue(p);
  else if (type == 1) gemm_phase(p, kind, l);
  else if (type == 2) mix_phase(p, l, rep);
  else if (type == 3) prep_phase(p, l);
  else final_phase(p);
}
constexpr int NPHASE = 19;

__global__ void __launch_bounds__(512) mega(Params p) {
  __shared__ uint4 xb_words;
  if (threadIdx.x == 0) {
    xb_words = make_uint4(0u, 0u, 0u, 0u);
    (void)xb_add(&((unsigned*)(p.ws + WS_XBAR))[XB_XCNT(xb_xcc_id())], 1u);
  }
  __syncthreads();
  for (int ph = p.ph_lo; ph <= p.ph_hi; ++ph) {
    const int nrep = ((PROBE_MASK >> ph) & 1u) ? 2 : 1;
    for (int rep = 0; rep < nrep; ++rep) {
      run_phase(p, ph, rep);
      if (ph < p.ph_hi || rep + 1 < nrep) {
        if (p.ph_hi < 0) cg::this_grid().sync();
        grid_barrier((unsigned*)(p.ws + WS_XBAR), (volatile XB_LAS unsigned*)&xb_words);
      }
    }
  }
}

extern "C" void kernel_launch(void* const* d_in, const int* in_sizes, int n_in, void* d_out, int out_size, void* d_ws, size_t ws_size,
                              hipStream_t stream) {
  static int grid = 0;
  if (grid == 0) {
    if (n_in != 31 || ws_size < WS_END) { fprintf(stderr, "kernel_launch: unexpected n_in %d / ws %zu (need %zu)\n", n_in, ws_size, (size_t)WS_END); grid = -1; return; }
    int dev = 0, cus = 0, per_cu = 0;
    hipGetDevice(&dev);
    hipDeviceGetAttribute(&cus, hipDeviceAttributeMultiprocessorCount, dev);
    if (hipFuncSetAttribute((const void*)mega, hipFuncAttributeMaxDynamicSharedMemorySize, LDS_BYTES) != hipSuccess) { fprintf(stderr, "hipFuncSetAttribute failed\n"); grid = -1; return; }
    hipOccupancyMaxActiveBlocksPerMultiprocessor(&per_cu, (const void*)mega, 512, LDS_BYTES);
    if (per_cu < 1) { fprintf(stderr, "occupancy query says %d blocks/CU\n", per_cu); per_cu = 1; }
    (void)hipGetLastError();
    grid = cus * per_cu;
  }
  if (grid < 0) return;
  Params p{};
  for (int i = 0; i < 31; ++i) p.in[i] = (const float*)d_in[i];
  p.out = (float*)d_out; p.ws = (char*)d_ws;
  if (hipMemsetAsync((char*)d_ws + WS_CTRL, 0, 4096 + 16384, stream) != hipSuccess) { fprintf(stderr, "kernel_launch: control-word memset failed\n"); return; }
#if COOP
  p.ph_lo = 0; p.ph_hi = NPHASE - 1;
  void* args[] = {&p};
  hipError_t e = hipLaunchCooperativeKernel((const void*)mega, dim3(grid), dim3(512), args, LDS_BYTES, stream);
  if (e != hipSuccess) fprintf(stderr, "cooperative launch failed: %s (grid %d)\n", hipGetErrorString(e), grid);
#else
  for (int ph = 0; ph < NPHASE; ++ph) {
    p.ph_lo = ph; p.ph_hi = ph;
    hipLaunchKernelGGL(mega, dim3(grid), dim3(512), LDS_BYTES, stream, p);
  }
#endif
}
```
